# Optimizing an MI355X kernel written in HIP

```python
import jax, jax.numpy as jnp
from jax import lax
import numpy as np

D_MODEL = 1024
BATCH = 16
SEQ = 2048
DEPTH = 1

HEAD_DIM = 64
N_Q_HEADS = 8
N_KV_HEADS = 2
Q_PER_KV = N_Q_HEADS // N_KV_HEADS
ATTN_WIDTH = N_Q_HEADS * HEAD_DIM
KV_WIDTH = N_KV_HEADS * HEAD_DIM
WINDOW = 128
ATTN_BLOCK = WINDOW
CONV_WIDTH = D_MODEL // 2
CONV_KERNEL = 31
MIX_WIDTH = ATTN_WIDTH + CONV_WIDTH
IN_WIDTH = ATTN_WIDTH + 2 * KV_WIDTH + 2 * CONV_WIDTH
N_EXPERTS = 32
TOP_K = 4
D_EXPERT = D_MODEL
SWIGLU_LIMIT = 7.0
SWIGLU_ALPHA = 1.702
EXPERT_BLOCK = 128
RMS_EPS = 1e-5
LN_EPS = 1e-5

kernel_name = "hymba_conformer_swa_sink_moe"


def rms_norm(x, g):
    xf = x.astype(jnp.float32)
    y = xf * lax.rsqrt(jnp.mean(xf * xf, axis=-1, keepdims=True) + RMS_EPS)
    return (y * g.astype(jnp.float32)).astype(x.dtype)


def layer_norm(x, g, b):
    xf = x.astype(jnp.float32)
    mu = jnp.mean(xf, axis=-1, keepdims=True)
    xc = xf - mu
    y = xc * lax.rsqrt(jnp.mean(xc * xc, axis=-1, keepdims=True) + LN_EPS)
    return (y * g.astype(jnp.float32) + b.astype(jnp.float32)).astype(x.dtype)


def sliding_window_attention_with_sinks(q, k, v, sinks):
    b, s, _ = q.shape
    L = ATTN_BLOCK
    nb = s // L
    q = q.reshape(b, nb, L, N_KV_HEADS, Q_PER_KV, HEAD_DIM)
    k = k.reshape(b, nb, L, N_KV_HEADS, HEAD_DIM)
    v = v.reshape(b, nb, L, N_KV_HEADS, HEAD_DIM)

    def band(t):
        prev = jnp.concatenate([jnp.zeros_like(t[:, :1]), t[:, :-1]], axis=1)
        return jnp.concatenate([prev, t], axis=2)

    kb, vb = band(k), band(v)
    scores = jnp.einsum('bnqhgd,bnkhd->bnhgqk', q, kb).astype(jnp.float32) * (HEAD_DIM ** -0.5)
    blk = jnp.arange(nb)[:, None, None]
    q_pos = blk * L + jnp.arange(L)[None, :, None]
    k_pos = (blk - 1) * L + jnp.arange(2 * L)[None, None, :]
    valid = (k_pos <= q_pos) & (q_pos - k_pos < WINDOW) & (k_pos >= 0)
    scores = jnp.where(valid[None, :, None, None], scores, -jnp.inf)
    sink = sinks.astype(jnp.float32).reshape(1, 1, N_KV_HEADS, Q_PER_KV, 1, 1)
    sink = jnp.broadcast_to(sink, scores.shape[:-1] + (1,))
    probs = jax.nn.softmax(jnp.concatenate([scores, sink], axis=-1), axis=-1)[..., :-1]
    out = jnp.einsum('bnhgqk,bnkhd->bnqhgd', probs.astype(v.dtype), vb)
    return out.reshape(b, s, ATTN_WIDTH)


def conformer_conv(a, gate, w_dw, b_dw, ln_g, ln_b):
    u = a * jax.nn.sigmoid(gate)
    u = lax.conv_general_dilated(
        u, w_dw[:, None, :].astype(u.dtype), window_strides=(1,),
        padding=[(CONV_KERNEL - 1, 0)],
        dimension_numbers=('NWC', 'WIO', 'NWC'),
        feature_group_count=CONV_WIDTH) + b_dw
    u = layer_norm(u, ln_g, ln_b)
    return jax.nn.silu(u)


def moe_ffn(h, w_router, b_router, w1, b1, w2, b2):
    bsz, s, d = h.shape
    t = bsz * s
    xt = h.reshape(t, d)
    logits = (xt @ w_router + b_router).astype(jnp.float32)
    top_val, top_idx = lax.top_k(logits, TOP_K)
    gates = jax.nn.softmax(top_val, axis=-1)
    n_assign = t * TOP_K
    e_flat = top_idx.reshape(n_assign).astype(jnp.int32)
    tok_flat = jnp.arange(n_assign, dtype=jnp.int32) // TOP_K
    g_flat = gates.reshape(n_assign)
    order = jnp.argsort(e_flat, stable=True)
    e_s, tok_s, g_s = e_flat[order], tok_flat[order], g_flat[order]
    counts = jnp.bincount(e_flat, length=N_EXPERTS).astype(jnp.int32)
    starts = jnp.cumsum(counts) - counts
    padded = (counts + EXPERT_BLOCK - 1) // EXPERT_BLOCK * EXPERT_BLOCK
    pad_end = jnp.cumsum(padded)
    pad_start = pad_end - padded
    dest = pad_start[e_s] + (jnp.arange(n_assign, dtype=jnp.int32) - starts[e_s])
    n_blocks = (n_assign + EXPERT_BLOCK - 1) // EXPERT_BLOCK + N_EXPERTS
    n_rows = n_blocks * EXPERT_BLOCK
    row_tok = jnp.full((n_rows,), t, jnp.int32).at[dest].set(tok_s)
    row_gate = jnp.zeros((n_rows,), jnp.float32).at[dest].set(g_s)
    block_start = jnp.arange(n_blocks, dtype=jnp.int32) * EXPERT_BLOCK
    block_expert = jnp.minimum(jnp.searchsorted(pad_end, block_start, side='right'),
                               N_EXPERTS - 1).astype(jnp.int32)
    x_pad = jnp.concatenate([xt, jnp.zeros((1, d), xt.dtype)], axis=0)
    x_rows = x_pad[row_tok].reshape(n_blocks, EXPERT_BLOCK, d)

    def expert_block(args):
        xb, e = args
        hh = (xb @ w1[e] + b1[e]).reshape(EXPERT_BLOCK, D_EXPERT, 2)
        x_glu = jnp.minimum(hh[..., 0], SWIGLU_LIMIT)
        x_lin = jnp.clip(hh[..., 1], -SWIGLU_LIMIT, SWIGLU_LIMIT)
        act = x_glu * jax.nn.sigmoid(SWIGLU_ALPHA * x_glu) * (x_lin + 1)
        return act @ w2[e] + b2[e]

    y_rows = lax.map(expert_block, (x_rows, block_expert)).reshape(n_rows, d)
    y_rows = y_rows * row_gate[:, None].astype(y_rows.dtype)
    y = jax.ops.segment_sum(y_rows, row_tok, num_segments=t + 1)[:t]
    return y.reshape(bsz, s, d)


def setup_inputs(seed: int = 0) -> dict:
    key = jax.random.key(seed)
    ks = jax.random.split(key, 24)
    f32 = jnp.float32

    def nrm(k, shape, scale):
        return jax.random.normal(k, shape, f32) * scale

    L = DEPTH
    return {
        "x": nrm(ks[0], (BATCH, SEQ, D_MODEL), 1.0),
        "g_mix": 1.0 + nrm(ks[1], (L, D_MODEL), 0.02),
        "w_in": nrm(ks[2], (L, D_MODEL, IN_WIDTH), D_MODEL ** -0.5),
        "b_in": nrm(ks[3], (L, IN_WIDTH), 0.02),
        "sinks": nrm(ks[4], (L, N_Q_HEADS), 0.5),
        "w_dw": nrm(ks[5], (L, CONV_KERNEL, CONV_WIDTH), CONV_KERNEL ** -0.5),
        "b_dw": nrm(ks[6], (L, CONV_WIDTH), 0.02),
        "ln_g": 1.0 + nrm(ks[7], (L, CONV_WIDTH), 0.02),
        "ln_b": nrm(ks[8], (L, CONV_WIDTH), 0.02),
        "g_attn_out": 1.0 + nrm(ks[9], (L, ATTN_WIDTH), 0.02),
        "g_conv_out": 1.0 + nrm(ks[10], (L, CONV_WIDTH), 0.02),
        "w_out": nrm(ks[11], (L, MIX_WIDTH, D_MODEL), MIX_WIDTH ** -0.5),
        "b_out": nrm(ks[12], (L, D_MODEL), 0.02),
        "g_ffn": 1.0 + nrm(ks[13], (L, D_MODEL), 0.02),
        "w_router": nrm(ks[14], (L, D_MODEL, N_EXPERTS), D_MODEL ** -0.5),
        "b_router": nrm(ks[15], (L, N_EXPERTS), 0.01),
        "w1": nrm(ks[16], (L, N_EXPERTS, D_MODEL, 2 * D_EXPERT), D_MODEL ** -0.5),
        "b1": nrm(ks[17], (L, N_EXPERTS, 2 * D_EXPERT), 0.02),
        "w2": nrm(ks[18], (L, N_EXPERTS, D_EXPERT, D_MODEL), D_EXPERT ** -0.5),
        "b2": nrm(ks[19], (L, N_EXPERTS, D_MODEL), 0.02),
        "g_final": 1.0 + nrm(ks[20], (D_MODEL,), 0.02),
    }


def reference(x, g_mix, w_in, b_in, sinks, w_dw, b_dw, ln_g, ln_b, g_attn_out, g_conv_out,
              w_out, b_out, g_ffn, w_router, b_router, w1, b1, w2, b2, g_final):
    split_at = [ATTN_WIDTH, ATTN_WIDTH + KV_WIDTH, ATTN_WIDTH + 2 * KV_WIDTH,
                ATTN_WIDTH + 2 * KV_WIDTH + CONV_WIDTH]
    for l in range(DEPTH):
        u = rms_norm(x, g_mix[l])
        proj = u @ w_in[l] + b_in[l]
        q, k, v, conv_a, conv_gate = jnp.split(proj, split_at, axis=-1)
        attn = sliding_window_attention_with_sinks(q, k, v, sinks[l])
        conv = conformer_conv(conv_a, conv_gate, w_dw[l], b_dw[l], ln_g[l], ln_b[l])
        mixed = jnp.concatenate([rms_norm(attn, g_attn_out[l]),
                                 rms_norm(conv, g_conv_out[l])], axis=-1)
        x = x + (mixed @ w_out[l] + b_out[l])
        x = x + moe_ffn(rms_norm(x, g_ffn[l]), w_router[l], b_router[l],
                        w1[l], b1[l], w2[l], b2[l])
    return rms_norm(x, g_final)
```

```cpp
#include <hip/hip_runtime.h>
#include <cstdio>
#include <cstdint>

namespace pg8 {
#define PG8_LAS __attribute__((address_space(3)))
typedef unsigned short bf16_t;
typedef short bf16x8 __attribute__((ext_vector_type(8)));
typedef float f32x4 __attribute__((ext_vector_type(4)));
typedef unsigned u32x4 __attribute__((ext_vector_type(4)));
constexpr int BM = 256, BK = 64, HALF = 128, HTB = HALF * BK * 2, STAGE_BYTES = 8 * HTB, NXCD = 8, WGM = 8;

__host__ __device__ __forceinline__ int lds_byte(int r, int c) { const int st = (r >> 4) * 2 + (c >> 5), rr = r & 15, cc = c & 31, ob = rr * 64 + cc * 2; return st * 1024 + (ob ^ (((ob >> 9) & 1) << 5)); }
__host__ __device__ __forceinline__ void stage_rc(int b, int& R, int& C) { const int st = b / 1024, sb = b % 1024, swz = sb ^ (((sb >> 9) & 1) << 5); R = (st >> 1) * 16 + swz / 64; C = (st & 1) * 32 + (swz % 64) / 2; }
__host__ __device__ __forceinline__ int perm32(int rho) { const int n = rho >> 4, i = rho & 15; return 8 * (i >> 2) + 4 * n + (i & 3); }

struct Unit { int pm, pn, e, rb, cnt; };

__device__ __forceinline__ bool static_order(int i, int G, int c, int nM, int nN, int& pm, int& pn) {
    const int nwg = nM * nN; const long L = (long)i * G + c; if (L >= nwg) return false;
    int wgid = (int)L; { const int q = nwg / NXCD, r = nwg % NXCD, xcd = wgid % NXCD, off = wgid / NXCD; wgid = (xcd < r ? xcd * (q + 1) : r * (q + 1) + (xcd - r) * q) + off; }
    const int nig = WGM * nN, gid = wgid / nig, fm = gid * WGM, gsz = (nM - fm) < WGM ? (nM - fm) : WGM;
    pm = fm + ((wgid % nig) % gsz); pn = (wgid % nig) / gsz; return true;
}

__device__ __forceinline__ unsigned cvt_pk_bf16(float lo, float hi) { unsigned r; asm volatile("v_cvt_pk_bf16_f32 %0, %1, %2" : "=v"(r) : "v"(lo), "v"(hi)); return r; }

typedef int i32x8 __attribute__((ext_vector_type(8)));
typedef int i32x4v __attribute__((ext_vector_type(4)));
template <class Epi, class Sched, bool FP8>
__device__ __forceinline__ void gemm_phase(PG8_LAS unsigned char* lds, PG8_LAS unsigned char* epi, const char* Abase, const int rp, const Sched& S, const Epi& E) {
    int tid = threadIdx.x; asm volatile("" : "+v"(tid));
    const int wid = __builtin_amdgcn_readfirstlane(tid >> 6), lane = tid & 63, wr = wid >> 2, wc = wid & 3, fr = lane & 15, fq = lane >> 4;
    const int nt = rp / 128;
    int RA[2]; unsigned CA2[2], voffB[2];
#pragma unroll
    for (int i = 0; i < 2; ++i) { int R, C; stage_rc(tid * 16 + i * 8192, R, C); const int Rb = Epi::PERM ? ((R & ~31) + perm32(R & 31)) : R;
        RA[i] = R; CA2[i] = (unsigned)C * 2u; voffB[i] = (unsigned)(Rb * rp + C * 2); }
    const size_t kstep = (size_t)(BK * 2);
    const size_t hstepB = (size_t)HALF * rp;
    const unsigned ldsw = (unsigned)wid * 1024u;
    const int aoff = lds_byte(wr * 64 + fr, fq * 8), boff = lds_byte(wc * 32 + fr, fq * 8);
#define PG8_SA(b, h) (((b) * 2 + (h)) * HTB)
#define PG8_SB(b, h) ((4 + (b) * 2 + (h)) * HTB)
#define PG8_STAGE(bufoff, gbase, voff) do { _Pragma("unroll") for (int _i = 0; _i < 2; ++_i) { unsigned _vo = (voff)[_i]; asm volatile("" : "+v"(_vo));   \
        __builtin_amdgcn_global_load_lds((const unsigned*)((const char*)(gbase) + _vo), (PG8_LAS unsigned*)(lds + (bufoff) + ldsw + _i * 8192), 16, 0, 0); } } while (0)
#define PG8_LDA(dst, b, h) do { _Pragma("unroll") for (int m = 0; m < 4; ++m) _Pragma("unroll") for (int k = 0; k < 2; ++k) dst[m][k] = *(const PG8_LAS bf16x8*)(lds + PG8_SA(b, h) + aoff + m * 2048 + k * 1024); } while (0)
#define PG8_LDB(dst, b, h) do { _Pragma("unroll") for (int n = 0; n < 2; ++n) _Pragma("unroll") for (int k = 0; k < 2; ++k) dst[n][k] = *(const PG8_LAS bf16x8*)(lds + PG8_SB(b, h) + boff + n * 2048 + k * 1024); } while (0)
#define PG8_CAT8(x) __builtin_shufflevector(__builtin_bit_cast(i32x4v, x[0]), __builtin_bit_cast(i32x4v, x[1]), 0, 1, 2, 3, 4, 5, 6, 7)
#define PG8_MMA_(ai, bj, At, Bt, Z) do { __builtin_amdgcn_s_setprio(1); \
        if constexpr (FP8) { _Pragma("unroll") for (int m = 0; m < 4; ++m) _Pragma("unroll") for (int n = 0; n < 2; ++n) \
            { const i32x8 _b = PG8_CAT8(Bt[n]), _a = PG8_CAT8(At[m]);   \
              if (Z) asm volatile("v_mfma_f32_16x16x128_f8f6f4 %0, %1, %2, 0" : "=&v"(acc[ai][bj][m][n]) : "v"(_b), "v"(_a)); \
              else asm volatile("v_mfma_f32_16x16x128_f8f6f4 %0, %1, %2, %0" : "+v"(acc[ai][bj][m][n]) : "v"(_b), "v"(_a)); } } \
        else { _Pragma("unroll") for (int m = 0; m < 4; ++m) _Pragma("unroll") for (int n = 0; n < 2; ++n) _Pragma("unroll") for (int k = 0; k < 2; ++k) \
            acc[ai][bj][m][n] = __builtin_amdgcn_mfma_f32_16x16x32_bf16(Bt[n][k], At[m][k], acc[ai][bj][m][n], 0, 0, 0); } \
        __builtin_amdgcn_s_setprio(0); } while (0)
#define PG8_MMA(ai, bj, At, Bt) PG8_MMA_(ai, bj, At, Bt, false)
#define PG8_MMA0(ai, bj, At, Bt) do { if (FP8 && first) PG8_MMA_(ai, bj, At, Bt, true); else PG8_MMA_(ai, bj, At, Bt, false); } while (0)
#define PG8_WAIT_V(n) asm volatile("s_waitcnt vmcnt(" #n ")" ::: "memory")
#define PG8_WAIT_L(n) asm volatile("s_waitcnt lgkmcnt(" #n ")" ::: "memory")
#define PG8_BAR __builtin_amdgcn_s_barrier()
#define PG8_SCHED __builtin_amdgcn_sched_barrier(0)
#define PG8_ZERO() do { if constexpr (!FP8) { _Pragma("unroll") for (int a = 0; a < 2; ++a) _Pragma("unroll") for (int b = 0; b < 2; ++b) _Pragma("unroll") for (int m = 0; m < 4; ++m) _Pragma("unroll") for (int n = 0; n < 2; ++n) acc[a][b][m][n] = (f32x4){0.f, 0.f, 0.f, 0.f}; } } while (0)
#define PG8_VA(dst, u) do { _Pragma("unroll") for (int _h = 0; _h < 2; ++_h) _Pragma("unroll") for (int _i = 0; _i < 2; ++_i) dst[_h][_i] = S.a_off(u, _h * HALF + RA[_i]) + CA2[_i]; } while (0)
    Unit cur, nxt; int ui = 0;
    if (!S.next(0, cur)) return;
    f32x4 acc[2][2][4][2];
    PG8_ZERO();
    bf16x8 At[4][2], B0[2][2], B1[2][2];
    unsigned cvA[2][2], nvA[2][2];
    float rs[2][4];
    PG8_VA(cvA, cur);
    const char* cB = S.b_tile(cur);
    const char* cA = Abase + S.a_base(cur);
    E.side(cur, epi, wid, lane);
    PG8_STAGE(PG8_SB(0, 0), cB, voffB); PG8_STAGE(PG8_SB(0, 1), cB + hstepB, voffB); PG8_STAGE(PG8_SA(0, 0), cA, cvA[0]); PG8_STAGE(PG8_SA(0, 1), cA, cvA[1]);
    if (wr == 1) PG8_BAR;
    PG8_WAIT_V(2); PG8_BAR;
    PG8_STAGE(PG8_SB(1, 0), cB + kstep, voffB); PG8_STAGE(PG8_SA(1, 0), cA + kstep, cvA[0]); PG8_STAGE(PG8_SB(1, 1), cB + hstepB + kstep, voffB);
    PG8_WAIT_V(6); PG8_BAR;
    for (;;) {
        const bool has_next = S.next(ui + 1, nxt);
        if constexpr (Sched::GATHER) { if (has_next) S.gather_dma(nxt, epi + ((ui + 1) & 1) * 4096 + 3072, wid, lane); }
        const char* nB = has_next ? S.b_tile(nxt) : cB;
        const char* nA = has_next ? Abase + S.a_base(nxt) : cA;
        PG8_LAS unsigned char* area = epi + (ui & 1) * 4096;
        for (int t = 0; t < nt; t += 2) {
            const bool last = (t == nt - 2), first = (t == 0);
            if constexpr (Epi::MIDSCALE) { if (t == nt / 2) {
#pragma unroll
                for (int a = 0; a < 2; ++a)
#pragma unroll
                    for (int m = 0; m < 4; ++m) rs[a][m] = *(const PG8_LAS float*)(area + 1024 + 4 * (a * 128 + wr * 64 + m * 16 + fr));
#pragma unroll
                for (int a = 0; a < 2; ++a)
#pragma unroll
                    for (int b = 0; b < 2; ++b)
#pragma unroll
                        for (int m = 0; m < 4; ++m)
#pragma unroll
                            for (int n = 0; n < 2; ++n) acc[a][b][m][n] = acc[a][b][m][n] * rs[a][m]; } }
            const char* a1 = cA + (size_t)(t + 1) * kstep;
            const char* a2 = last ? nA : cA + (size_t)(t + 2) * kstep; const char* b2 = last ? nB : cB + (size_t)(t + 2) * kstep;
            const char* a3 = a2 + kstep; const char* b3 = b2 + kstep;
            if constexpr (Sched::GATHER) { if (last) {
#pragma unroll
                for (int h = 0; h < 2; ++h)
#pragma unroll
                    for (int i = 0; i < 2; ++i) nvA[h][i] = has_next ? S.a_fin(nxt, h * HALF + RA[i], *(const PG8_LAS int*)(epi + ((ui + 1) & 1) * 4096 + 3072 + 4 * (h * HALF + RA[i]))) + CA2[i] : cvA[h][i]; } }
            unsigned sA[2][2];
#pragma unroll
            for (int h = 0; h < 2; ++h)
#pragma unroll
                for (int i = 0; i < 2; ++i) sA[h][i] = (Sched::GATHER && last) ? nvA[h][i] : cvA[h][i];
            PG8_LDB(B0, 0, 0); PG8_LDB(B1, 0, 1); PG8_SCHED; PG8_LDA(At, 0, 0); PG8_STAGE(PG8_SA(1, 1), a1, cvA[1]);
            PG8_WAIT_V(8); PG8_WAIT_L(0); PG8_BAR; PG8_MMA0(0, 0, At, B0); PG8_MMA0(0, 1, At, B1); PG8_BAR; PG8_SCHED;
            PG8_LDA(At, 0, 1); PG8_STAGE(PG8_SB(0, 0), b2, voffB); PG8_STAGE(PG8_SB(0, 1), b2 + hstepB, voffB); PG8_STAGE(PG8_SA(0, 0), a2, sA[0]);
            PG8_WAIT_V(8); PG8_WAIT_L(0); PG8_BAR; PG8_MMA0(1, 0, At, B0); PG8_MMA0(1, 1, At, B1); PG8_BAR; PG8_SCHED;
            PG8_LDB(B0, 1, 0); PG8_LDB(B1, 1, 1); PG8_SCHED; PG8_LDA(At, 1, 0); PG8_STAGE(PG8_SA(0, 1), a2, sA[1]);
            PG8_WAIT_V(8); PG8_WAIT_L(0); PG8_BAR; PG8_MMA(0, 0, At, B0); PG8_MMA(0, 1, At, B1); PG8_BAR; PG8_SCHED;
            PG8_LDA(At, 1, 1); PG8_STAGE(PG8_SB(1, 0), b3, voffB); PG8_STAGE(PG8_SB(1, 1), b3 + hstepB, voffB); PG8_STAGE(PG8_SA(1, 0), a3, sA[0]);
            PG8_WAIT_V(8); PG8_WAIT_L(0); PG8_BAR; PG8_MMA(1, 0, At, B0); PG8_MMA(1, 1, At, B1); PG8_BAR; PG8_SCHED;
        }
        if (wr == 0) PG8_BAR;
        if constexpr (FP8) asm volatile("s_nop 15\n\ts_nop 15" ::: "memory");
        E(acc, cur, wr, wc, fr, fq, area);
        if (!has_next) break;
        PG8_ZERO();
        cur = nxt; cB = nB; cA = nA; ++ui;
        E.side(cur, epi + (ui & 1) * 4096, wid, lane);
        if constexpr (Sched::GATHER) {
#pragma unroll
            for (int h = 0; h < 2; ++h)
#pragma unroll
                for (int i = 0; i < 2; ++i) cvA[h][i] = nvA[h][i]; }
        if (wr == 1) PG8_BAR;
    }
    PG8_WAIT_V(0);
    PG8_BAR;
#undef PG8_SA
#undef PG8_SB
#undef PG8_STAGE
#undef PG8_LDA
#undef PG8_LDB
#undef PG8_MMA
#undef PG8_MMA_
#undef PG8_MMA0
#undef PG8_CAT8
#undef PG8_WAIT_V
#undef PG8_WAIT_L
#undef PG8_BAR
#undef PG8_SCHED
#undef PG8_ZERO
#undef PG8_VA
}
}

constexpr int NWAVES = 8;
constexpr int T = 32768, SEQ = 2048, D = 1024, INW = 1792, NEXP = 32, TOPK = 4;
constexpr int COL_K = 512, COL_V = 640, COL_A = 768, COL_G = 1280;
constexpr float RMS_EPS = 1e-5f, LN_EPS = 1e-5f;
constexpr float LOG2E = 1.4426950408889634f;
constexpr float QSCALE = 0.125f * LOG2E;
constexpr int LIST_CAP = 32768;
constexpr int MAX_RB = 544;

constexpr size_t MiB = 1u << 20;
constexpr size_t WS_CTL = 0, CTL_ZERO_BYTES = 16 * 1024;
constexpr size_t WS_WIN = 2 * MiB;
constexpr size_t WS_WOUT = 6 * MiB;
constexpr size_t WS_W1 = 8 * MiB;
constexpr size_t WS_W2 = 136 * MiB;
constexpr size_t WS_XN = 200 * MiB;
constexpr size_t WS_LTOK = 264 * MiB;
constexpr size_t WS_LGATE = 268 * MiB;
constexpr size_t WS_B1P = 272 * MiB;
constexpr size_t WS_RA = 272 * MiB + 512 * 1024;
constexpr size_t WS_WR = 273 * MiB;
constexpr size_t WS_ACT = 274 * MiB;
constexpr size_t WS_PROJ = 546 * MiB;
constexpr size_t WS_MIX = 658 * MiB;
constexpr size_t WS_Y = 546 * MiB;
constexpr size_t WS_XN8 = 674 * MiB;
constexpr size_t WS_END = 802 * MiB;
static_assert(WS_ACT + (size_t)MAX_RB * 256 * 1024 * 2 <= WS_PROJ && WS_MIX + (size_t)T * 1024 * 2 <= WS_END && WS_Y + (size_t)T * 4 * 1024 * 2 <= WS_END, "ws map");
constexpr int CW_BAR = 0;
constexpr int CW_GCNT = 3584;
static_assert((CW_BAR + 3456) * 4 <= (int)CTL_ZERO_BYTES && (CW_GCNT + 32 * 16) * 4 <= (int)CTL_ZERO_BYTES, "control words inside the per-call memset");

constexpr int RING_BYTES = 131072;
constexpr int MISC_OFF = RING_BYTES;
constexpr int TAB_OFF = MISC_OFF + 256;
constexpr int EPI_OFF = RING_BYTES + 2048;
constexpr int P4_G_OFF = EPI_OFF + 8 * 2112;
constexpr int LDS_BYTES = 154624;

#define GAS __attribute__((address_space(1)))
#define LAS __attribute__((address_space(3)))
typedef unsigned short bf16;
typedef unsigned v4u __attribute__((ext_vector_type(4)));
typedef unsigned v2u __attribute__((ext_vector_type(2)));
typedef float f32x4 __attribute__((ext_vector_type(4)));
typedef float f32x2 __attribute__((ext_vector_type(2)));
typedef short bf16x8 __attribute__((ext_vector_type(8)));
typedef short v4i16_t __attribute__((ext_vector_type(4)));
#define LDS_WAIT() asm volatile("s_waitcnt lgkmcnt(0)" ::: "memory")
#define VM_WAIT() asm volatile("s_waitcnt vmcnt(0)" ::: "memory")
__device__ __forceinline__ unsigned pk2(float lo, float hi) { return pg8::cvt_pk_bf16(lo, hi); }
__device__ __forceinline__ unsigned pk4_fp8(float a, float b, float c, float d) { int w = 0; w = __builtin_amdgcn_cvt_pk_fp8_f32(a, b, w, false); w = __builtin_amdgcn_cvt_pk_fp8_f32(c, d, w, true); return (unsigned)w; }
constexpr float W_SCALE = 64.0f, H_SCALE = 8.0f, ACT_SCALE = 4.0f, Y_SCALE = 16.0f;
__device__ __forceinline__ float bf_lo(unsigned w) { return __uint_as_float(w << 16); }
__device__ __forceinline__ float bf_hi(unsigned w) { return __uint_as_float(w & 0xffff0000u); }

#define XB_TMO      128
#define XB_XCNT(j)  (256  + 64 * (j))
#define XB_XSUB(j)  (1280 + 64 * (j))
#define XB_XGEN(j)  (2304 + 64 * (j))
#define XB_TOP      3328
#define XB_TOPGEN   3392
#define XCD_BAR_WORDS 3456
#define XB_SPIN_CAP (1u << 18)

__device__ __forceinline__ unsigned xb_ld(unsigned* p)              { return __hip_atomic_load(p, __ATOMIC_RELAXED, __HIP_MEMORY_SCOPE_AGENT); }
__device__ __forceinline__ unsigned xb_add(unsigned* p, unsigned v) { return __hip_atomic_fetch_add(p, v, __ATOMIC_RELAXED, __HIP_MEMORY_SCOPE_AGENT); }
__device__ __forceinline__ unsigned xb_xcc_id() { return (unsigned)__builtin_amdgcn_s_getreg((3 << 11) | 20) & 0xFu; }
#define XB_SPIN(cond, bar) do { unsigned _sp = 0; while (cond) { __builtin_amdgcn_s_sleep(1); \
    if ((++_sp & 255u) == 0u) { if (xb_ld(&(bar)[XB_TMO])) break; if (_sp > XB_SPIN_CAP) { atomicAdd(&(bar)[XB_TMO], 1u); break; } } } } while (0)

struct XcdBarrier { unsigned* bar; unsigned x; volatile LAS unsigned* st; };

__device__ __forceinline__ XcdBarrier xcd_barrier_post(unsigned* bar, volatile LAS unsigned* st) {
    XcdBarrier b; b.bar = bar; b.x = xb_xcc_id(); b.st = st;
    if (threadIdx.x == 0) (void)xb_add(&bar[XB_XCNT(b.x)], 1u);
    return b;
}
__device__ __forceinline__ void xcd_barrier_complete(unsigned* bar, unsigned x, unsigned& nloc, unsigned& nx) {
    const unsigned G = gridDim.x * gridDim.y * gridDim.z;
    unsigned sum, cnt, mine, sp = 0u;
    for (;;) {
        sum = 0u; cnt = 0u; mine = 0u;
#pragma unroll
        for (unsigned j = 0; j < 16; ++j) { const unsigned c = xb_ld(&bar[XB_XCNT(j)]); sum += c; cnt += (c > 0u) ? 1u : 0u; mine = (j == x) ? c : mine; }
        if (sum == G) break;
        __builtin_amdgcn_s_sleep(1);
        if ((++sp & 255u) == 0u) { if (xb_ld(&bar[XB_TMO])) break; if (sp > XB_SPIN_CAP) { atomicAdd(&bar[XB_TMO], 1u); break; } }
    }
    nloc = mine > 0u ? mine : 1u; nx = cnt > 0u ? cnt : 1u;
}
__device__ __forceinline__ void xcd_barrier(const XcdBarrier& b) {
    asm volatile("s_waitcnt vmcnt(0)" ::: "memory");
    __syncthreads();
    if (threadIdx.x == 0) {
        unsigned* bar = b.bar;
        __builtin_amdgcn_s_waitcnt(0);
        unsigned nloc = b.st[0], nx = b.st[1];
        if (nloc == 0u) { xcd_barrier_complete(bar, b.x, nloc, nx); b.st[0] = nloc; b.st[1] = nx; }
        const unsigned old = xb_add(&bar[XB_XSUB(b.x)], 1u);
        const unsigned gen = old / nloc;
        if (old + 1u == (gen + 1u) * nloc) {
            __builtin_amdgcn_fence(__ATOMIC_RELEASE, "agent");
            asm volatile("s_waitcnt vmcnt(0)" ::: "memory");
            const unsigned og = xb_add(&bar[XB_TOP], 1u);
            const unsigned tg = og / nx;
            if (og + 1u == (tg + 1u) * nx) xb_add(&bar[XB_TOPGEN], 1u);
            else XB_SPIN(xb_ld(&bar[XB_TOPGEN]) == tg, bar);
            __builtin_amdgcn_fence(__ATOMIC_ACQUIRE, "agent");
            xb_add(&bar[XB_XGEN(b.x)], 1u);
            asm volatile("s_waitcnt vmcnt(0)" ::: "memory");
        } else {
            XB_SPIN(xb_ld(&bar[XB_XGEN(b.x)]) == gen, bar);
            __builtin_amdgcn_fence(__ATOMIC_ACQUIRE, "agent");
            asm volatile("s_waitcnt vmcnt(0)" ::: "memory");
        }
    }
    __syncthreads();
}

template <int CTRL, int RMASK> __device__ __forceinline__ float dpp_add(float v) { return v + __builtin_bit_cast(float, __builtin_amdgcn_update_dpp(0, __builtin_bit_cast(int, v), CTRL, RMASK, 0xf, false)); }
__device__ __forceinline__ float wave_sum_dpp(float v) {
    v = dpp_add<0xB1, 0xf>(v); v = dpp_add<0x4E, 0xf>(v); v = dpp_add<0x141, 0xf>(v); v = dpp_add<0x140, 0xf>(v);
    v = dpp_add<0x142, 0xa>(v); v = dpp_add<0x143, 0xc>(v);
    return __builtin_bit_cast(float, __builtin_amdgcn_readlane(__builtin_bit_cast(int, v), 63));
}
__device__ __forceinline__ float wave_sum(float v) {
#pragma unroll
    for (int o = 1; o < 64; o <<= 1) v += __shfl_xor(v, o);
    return v;
}

struct DenseSched {
    static constexpr bool GATHER = false;
    const char* Bt; int nM, nN, G, c, rp, ibeg, iend;
    __device__ __forceinline__ size_t a_base(const pg8::Unit& u) const { return (size_t)u.pm * 256 * (size_t)rp; }
    __device__ __forceinline__ bool next(int i, pg8::Unit& u) const { u.e = 0; u.rb = 0; u.cnt = 0; if (i + ibeg >= iend) return false; return pg8::static_order(i + ibeg, G, c, nM, nN, u.pm, u.pn); }
    __device__ __forceinline__ const char* b_tile(const pg8::Unit& u) const { return Bt + (size_t)u.pn * 256 * rp; }
    __device__ __forceinline__ unsigned a_off(const pg8::Unit&, int r) const { return (unsigned)r * (unsigned)rp; }
    __device__ __forceinline__ int a_raw(const pg8::Unit&, int) const { return 0; }
    __device__ __forceinline__ unsigned a_fin(const pg8::Unit&, int r, int) const { return (unsigned)r * (unsigned)rp; }
};
template <bool GATHER_> struct MoeSched {
    static constexpr bool GATHER = GATHER_;
    const char* Bt; size_t bexp;
    const int* ltok; const LAS int* rbs; const LAS int* cnt; int nM, nN, G, c, rp;
    __device__ __forceinline__ size_t a_base(const pg8::Unit& u) const { return GATHER_ ? (size_t)0 : (size_t)u.pm * 256 * (size_t)rp; }
    __device__ __forceinline__ bool next(int i, pg8::Unit& u) const {
        if (!pg8::static_order(i, G, c, nM, nN, u.pm, u.pn)) return false;
        const int lane = threadIdx.x & 63;
        const int v = (lane < 32) ? rbs[lane + 1] : 0x7fffffff;
        const unsigned long long m = __ballot(v <= u.pm);
        const int e = __builtin_amdgcn_readfirstlane((int)__popcll(m));
        u.e = e; u.rb = u.pm - __builtin_amdgcn_readfirstlane(rbs[e]); u.cnt = __builtin_amdgcn_readfirstlane(cnt[e]);
        return true;
    }
    __device__ __forceinline__ const char* b_tile(const pg8::Unit& u) const { return Bt + (size_t)u.e * bexp + (size_t)u.pn * 256 * rp; }
    __device__ __forceinline__ unsigned a_off(const pg8::Unit& u, int r) const {
        return a_fin(u, r, a_raw(u, r));
    }
    __device__ __forceinline__ int a_raw(const pg8::Unit& u, int r) const { if constexpr (GATHER_) return ltok[u.e * LIST_CAP + u.rb * 256 + r]; else return 0; }
    __device__ __forceinline__ void gather_dma(const pg8::Unit& u, LAS unsigned char* dst, int wid, int lane) const {
        if (wid < 4) __builtin_amdgcn_global_load_lds((const unsigned*)(ltok + (size_t)u.e * LIST_CAP + u.rb * 256 + wid * 64 + lane), (LAS unsigned*)(dst + wid * 256), 4, 0, 0); }
    __device__ __forceinline__ unsigned a_fin(const pg8::Unit& u, int r, int raw) const {
        if constexpr (GATHER_) { const int t4 = (u.rb * 256 + r < u.cnt) ? raw : 0; return (unsigned)(t4 >> 2) * (unsigned)rp; }
        else return (unsigned)r * (unsigned)rp;
    }
};

__device__ __forceinline__ void side_dma(const void* src_lane, LAS unsigned char* dst_wave) { __builtin_amdgcn_global_load_lds((const unsigned*)src_lane, (LAS unsigned*)dst_wave, 4, 0, 0); }

struct EpiProj {
    static constexpr bool PERM = true, MIDSCALE = false;
    bf16* O; const float* bias; const float* rowscale;
    __device__ __forceinline__ void side(const pg8::Unit& u, LAS unsigned char* area, int wid, int lane) const {
        if (wid < 4) side_dma(bias + u.pn * 256 + wid * 64 + lane, area + wid * 256);
        else side_dma(rowscale + u.pm * 256 + (wid - 4) * 64 + lane, area + 1024 + (wid - 4) * 256); }
    __device__ __forceinline__ void operator()(const f32x4 (&acc)[2][2][4][2], const pg8::Unit& u, int wr, int wc, int fr, int fq, const LAS unsigned char* area) const {
        const int row0 = u.pm * 256 + wr * 64 + fr, col0 = u.pn * 256 + wc * 32 + 8 * fq;
        const float sc = (u.pn < 2) ? QSCALE : 1.0f;
        f32x4 bv[2][2];
#pragma unroll
        for (int bj = 0; bj < 2; ++bj)
#pragma unroll
            for (int n = 0; n < 2; ++n) bv[bj][n] = *(const LAS f32x4*)(area + 4 * (wc * 32 + 8 * fq + bj * 128 + 4 * n));
#pragma unroll
        for (int ai = 0; ai < 2; ++ai)
#pragma unroll
            for (int m = 0; m < 4; ++m) { bf16* rowp = O + (size_t)(row0 + ai * 128 + m * 16) * INW + col0;
                const float rs = *(const LAS float*)(area + 1024 + 4 * (ai * 128 + wr * 64 + m * 16 + fr));
#pragma unroll
                for (int bj = 0; bj < 2; ++bj) { const f32x4 v0 = (acc[ai][bj][m][0] * rs + bv[bj][0]) * sc, v1 = (acc[ai][bj][m][1] * rs + bv[bj][1]) * sc;
                    v4u w; w.x = pk2(v0[0], v0[1]); w.y = pk2(v0[2], v0[3]); w.z = pk2(v1[0], v1[1]); w.w = pk2(v1[2], v1[3]);
                    *(v4u*)(rowp + bj * 128) = w; } }
    }
};
struct EpiRes {
    static constexpr bool PERM = true, MIDSCALE = true;
    const bf16* base; bf16* out; const float* bias; const float* rowscale;
    __device__ __forceinline__ void side(const pg8::Unit& u, LAS unsigned char* area, int wid, int lane) const {
        if (wid < 4) side_dma(bias + u.pn * 256 + wid * 64 + lane, area + wid * 256);
        else side_dma(rowscale + u.pm * 256 + (wid - 4) * 64 + lane, area + 1024 + (wid - 4) * 256); }
    __device__ __forceinline__ void operator()(const f32x4 (&acc)[2][2][4][2], const pg8::Unit& u, int wr, int wc, int fr, int fq, const LAS unsigned char* area) const {
        const int col0 = u.pn * 256 + wc * 32 + 8 * fq;
        f32x4 bv[2][2];
#pragma unroll
        for (int bj = 0; bj < 2; ++bj)
#pragma unroll
            for (int n = 0; n < 2; ++n) bv[bj][n] = *(const LAS f32x4*)(area + 4 * (wc * 32 + 8 * fq + bj * 128 + 4 * n));
#pragma unroll
        for (int ai = 0; ai < 2; ++ai) {
            v4u xr[4][2];
#pragma unroll
            for (int m = 0; m < 4; ++m) { const size_t off = (size_t)(u.pm * 256 + ai * 128 + wr * 64 + m * 16 + fr) * D + col0;
#pragma unroll
                for (int bj = 0; bj < 2; ++bj) xr[m][bj] = *(const v4u*)(base + off + bj * 128); }
            __builtin_amdgcn_sched_barrier(0);
#pragma unroll
            for (int m = 0; m < 4; ++m) { const size_t off = (size_t)(u.pm * 256 + ai * 128 + wr * 64 + m * 16 + fr) * D + col0;
#pragma unroll
                for (int bj = 0; bj < 2; ++bj) { const v4u xw = xr[m][bj];
                    const f32x4 v0 = (f32x4){bf_lo(xw.x), bf_hi(xw.x), bf_lo(xw.y), bf_hi(xw.y)} + acc[ai][bj][m][0] + bv[bj][0], v1 = (f32x4){bf_lo(xw.z), bf_hi(xw.z), bf_lo(xw.w), bf_hi(xw.w)} + acc[ai][bj][m][1] + bv[bj][1];
                    v4u w; w.x = pk2(v0[0], v0[1]); w.y = pk2(v0[2], v0[3]); w.z = pk2(v1[0], v1[1]); w.w = pk2(v1[2], v1[3]);
                    *(v4u*)(out + off + bj * 128) = w; } }
        }
    }
};
struct EpiSwiglu {
    static constexpr bool PERM = true, MIDSCALE = false;
    unsigned char* O; const float* b1p;
    __device__ __forceinline__ void side(const pg8::Unit& u, LAS unsigned char* area, int wid, int lane) const { if (wid < 4) side_dma(b1p + (size_t)u.e * 2048 + u.pn * 256 + wid * 64 + lane, area + wid * 256); }
    __device__ __forceinline__ void operator()(const f32x4 (&acc)[2][2][4][2], const pg8::Unit& u, int wr, int wc, int fr, int fq, const LAS unsigned char* area) const {
        const int row0 = u.pm * 256 + wr * 64 + fr, ocol0 = u.pn * 128 + wc * 32 + 8 * fq;
        f32x4 bg[2], bl[2];
#pragma unroll
        for (int n = 0; n < 2; ++n) { bg[n] = *(const LAS f32x4*)(area + 4 * (wc * 32 + 8 * fq + 4 * n)); bl[n] = *(const LAS f32x4*)(area + 4 * (128 + wc * 32 + 8 * fq + 4 * n)); }
        constexpr float SI = 1.0f / (H_SCALE * W_SCALE);
#pragma unroll
        for (int ai = 0; ai < 2; ++ai)
#pragma unroll
            for (int m = 0; m < 4; ++m) { unsigned char* rowp = O + (size_t)(row0 + ai * 128 + m * 16) * 1024 + ocol0;
                f32x2 a[4];
#pragma unroll
                for (int n = 0; n < 2; ++n)
#pragma unroll
                    for (int p = 0; p < 2; ++p) {
                        const f32x2 gv = (f32x2){acc[ai][0][m][n][2 * p], acc[ai][0][m][n][2 * p + 1]} * SI + (f32x2){bg[n][2 * p], bg[n][2 * p + 1]};
                        const f32x2 lv = (f32x2){acc[ai][1][m][n][2 * p], acc[ai][1][m][n][2 * p + 1]} * SI + (f32x2){bl[n][2 * p], bl[n][2 * p + 1]};
                        const f32x2 gg = (f32x2){fminf(gv.x, 7.0f), fminf(gv.y, 7.0f)};
                        const f32x2 ll = (f32x2){__builtin_amdgcn_fmed3f(lv.x, -7.0f, 7.0f), __builtin_amdgcn_fmed3f(lv.y, -7.0f, 7.0f)};
                        const f32x2 z = gg * (-1.702f * LOG2E);
                        const f32x2 d = (f32x2){__builtin_amdgcn_exp2f(z.x), __builtin_amdgcn_exp2f(z.y)} + 1.0f;
                        const f32x2 r = (f32x2){__builtin_amdgcn_rcpf(d.x), __builtin_amdgcn_rcpf(d.y)};
                        a[2 * n + p] = (gg * r) * (ll * ACT_SCALE + ACT_SCALE); }
                v2u w; w.x = pk4_fp8(a[0].x, a[0].y, a[1].x, a[1].y); w.y = pk4_fp8(a[2].x, a[2].y, a[3].x, a[3].y);
                *(v2u*)rowp = w; }
    }
};
struct EpiMoeOut {
    static constexpr bool PERM = true, MIDSCALE = false;
    unsigned char* Y; const float* b2; const int* ltok; const float* lgate;
    __device__ __forceinline__ void side(const pg8::Unit& u, LAS unsigned char* area, int wid, int lane) const {
        if (wid < 4) { side_dma(b2 + (size_t)u.e * 1024 + u.pn * 256 + wid * 64 + lane, area + wid * 256); side_dma(ltok + (size_t)u.e * LIST_CAP + u.rb * 256 + wid * 64 + lane, area + 1024 + wid * 256); }
        else side_dma(lgate + (size_t)u.e * LIST_CAP + u.rb * 256 + (wid - 4) * 64 + lane, area + 2048 + (wid - 4) * 256); }
    __device__ __forceinline__ void operator()(const f32x4 (&acc)[2][2][4][2], const pg8::Unit& u, int wr, int wc, int fr, int fq, const LAS unsigned char* area) const {
        const int col0 = u.pn * 256 + wc * 32 + 8 * fq;
        f32x4 bv[2][2];
#pragma unroll
        for (int bj = 0; bj < 2; ++bj)
#pragma unroll
            for (int n = 0; n < 2; ++n) bv[bj][n] = *(const LAS f32x4*)(area + 4 * (wc * 32 + 8 * fq + bj * 128 + 4 * n));
#pragma unroll
        for (int ai = 0; ai < 2; ++ai)
#pragma unroll
            for (int m = 0; m < 4; ++m) { const int r = ai * 128 + wr * 64 + m * 16 + fr, pos = u.rb * 256 + r;
                const int t4 = *(const LAS int*)(area + 1024 + 4 * r); const float gt = *(const LAS float*)(area + 2048 + 4 * r) * Y_SCALE;
                if (pos < u.cnt) {
                    unsigned char* rowp = Y + (size_t)t4 * 1024 + col0;
#pragma unroll
                    for (int bj = 0; bj < 2; ++bj) { const f32x4 v0 = (acc[ai][bj][m][0] * (1.0f / (ACT_SCALE * W_SCALE)) + bv[bj][0]) * gt, v1 = (acc[ai][bj][m][1] * (1.0f / (ACT_SCALE * W_SCALE)) + bv[bj][1]) * gt;
                        v2u w; w.x = pk4_fp8(v0[0], v0[1], v0[2], v0[3]); w.y = pk4_fp8(v1[0], v1[1], v1[2], v1[3]);
                        *(v2u*)(rowp + bj * 128) = w; } } }
    }
};

template <int ESZ, int MODE  >
__device__ __forceinline__ void p0_item(const float* W, int N, unsigned char* WT, size_t rowpitch, LAS unsigned* scr, int kb, int nb, int lane, float scale, const float* kscale = nullptr, const float* kscale_hi = nullptr) {
    constexpr int KT = (ESZ == 2) ? 64 : 128, NT = (ESZ == 2) ? 64 : 32, LPR = NT / 4;
    const int k0 = KT * kb, n0 = NT * nb, lg = lane / LPR, nc = lane % LPR;
    const float* src = W + (size_t)(k0 + 16 * lg) * N + n0 + 4 * nc;
    f32x4 v[16];
#pragma unroll
    for (int i = 0; i < 16; ++i) v[i] = *(const f32x4*)(src + (size_t)i * N);
    if (kscale) {
#pragma unroll
        for (int i = 0; i < 16; ++i) { const int k = k0 + 16 * lg + i; v[i] = v[i] * ((kscale_hi && k >= 512) ? kscale_hi[k - 512] : kscale[k]); } }
#pragma unroll
    for (int e = 0; e < 4; ++e) {
        LAS unsigned* row = scr + (4 * nc + e) * 36;
        if (ESZ == 2) {
            v4u a, b;
            a.x = pk2(v[0][e] * scale, v[1][e] * scale); a.y = pk2(v[2][e] * scale, v[3][e] * scale); a.z = pk2(v[4][e] * scale, v[5][e] * scale); a.w = pk2(v[6][e] * scale, v[7][e] * scale);
            b.x = pk2(v[8][e] * scale, v[9][e] * scale); b.y = pk2(v[10][e] * scale, v[11][e] * scale); b.z = pk2(v[12][e] * scale, v[13][e] * scale); b.w = pk2(v[14][e] * scale, v[15][e] * scale);
            *(LAS v4u*)(row + 8 * lg) = a; *(LAS v4u*)(row + 8 * lg + 4) = b;
        } else {
            v4u a;
            a.x = pk4_fp8(v[0][e] * scale, v[1][e] * scale, v[2][e] * scale, v[3][e] * scale); a.y = pk4_fp8(v[4][e] * scale, v[5][e] * scale, v[6][e] * scale, v[7][e] * scale);
            a.z = pk4_fp8(v[8][e] * scale, v[9][e] * scale, v[10][e] * scale, v[11][e] * scale); a.w = pk4_fp8(v[12][e] * scale, v[13][e] * scale, v[14][e] * scale, v[15][e] * scale);
            *(LAS v4u*)(row + 4 * lg) = a;
        }
    }
    LDS_WAIT(); asm volatile("" ::: "memory");
    const int c = lane & 7;
#pragma unroll
    for (int j = 0; j < NT / 8; ++j) { const int n = (lane >> 3) + 8 * j; const v4u o = *(const LAS v4u*)(scr + n * 36 + 4 * c);
        const int col = n0 + n; const int row = (MODE == 1) ? ((col & ~255) + 128 * (col & 1) + ((col >> 1) & 127)) : col;
        *(GAS v4u*)(WT + (size_t)row * rowpitch + (size_t)k0 * ESZ + 16 * c) = o; }
    LDS_WAIT(); asm volatile("" ::: "memory");
}

struct W8Item { const float* src; unsigned char* dst; int N, k0, n0, mode; };
__device__ __forceinline__ W8Item w8_item(int r, const float* w1, const float* w2, unsigned char* W1_t, unsigned char* W2_t) {
    W8Item it;
    if (r < 32 * 8 * 64) { const int e = r >> 9, q = r & 511; it.src = w1 + (size_t)e * 1024 * 2048; it.dst = W1_t + (size_t)e * 2048 * 1024; it.N = 2048; it.k0 = 128 * (q >> 6); it.n0 = 32 * (q & 63); it.mode = 1; }
    else { r -= 32 * 8 * 64; const int e = r >> 8, q = r & 255; it.src = w2 + (size_t)e * 1024 * 1024; it.dst = W2_t + (size_t)e * 1024 * 1024; it.N = 1024; it.k0 = 128 * (q >> 5); it.n0 = 32 * (q & 31); it.mode = 0; }
    return it;
}
__device__ __forceinline__ void w8_load(const W8Item& it, f32x4 (&v)[16], int lane) {
    const float* src = it.src + (size_t)(it.k0 + 16 * (lane >> 3)) * it.N + it.n0 + 4 * (lane & 7);
#pragma unroll
    for (int i = 0; i < 16; ++i) v[i] = __builtin_nontemporal_load((const f32x4*)(src + (size_t)i * it.N));
}
__device__ __forceinline__ void w8_store(const W8Item& it, const f32x4 (&v)[16], LAS unsigned* scr, int lane) {
    const int lg = lane >> 3, nc = lane & 7;
#pragma unroll
    for (int e = 0; e < 4; ++e) { v4u a;
        a.x = pk4_fp8(v[0][e] * W_SCALE, v[1][e] * W_SCALE, v[2][e] * W_SCALE, v[3][e] * W_SCALE); a.y = pk4_fp8(v[4][e] * W_SCALE, v[5][e] * W_SCALE, v[6][e] * W_SCALE, v[7][e] * W_SCALE);
        a.z = pk4_fp8(v[8][e] * W_SCALE, v[9][e] * W_SCALE, v[10][e] * W_SCALE, v[11][e] * W_SCALE); a.w = pk4_fp8(v[12][e] * W_SCALE, v[13][e] * W_SCALE, v[14][e] * W_SCALE, v[15][e] * W_SCALE);
        *(LAS v4u*)(scr + (4 * nc + e) * 36 + 4 * lg) = a; }
    LDS_WAIT(); asm volatile("" ::: "memory");
    const int c = lane & 7;
#pragma unroll
    for (int j = 0; j < 4; ++j) { const int n = (lane >> 3) + 8 * j; const v4u o = *(const LAS v4u*)(scr + n * 36 + 4 * c);
        const int col = it.n0 + n; const int row = it.mode ? ((col & ~255) + 128 * (col & 1) + ((col >> 1) & 127)) : col;
        *(GAS v4u*)(it.dst + (size_t)row * 1024 + it.k0 + 16 * c) = o; }
    LDS_WAIT(); asm volatile("" ::: "memory");
}

struct Args { const float* in[21]; float* out; unsigned char* ws; };

__global__ void __launch_bounds__(NWAVES * 64, 2) hymba_fwd(Args args) {
    extern __shared__ __attribute__((aligned(16))) unsigned char lds_raw[];
    LAS unsigned char* lds = (LAS unsigned char*)lds_raw;
    volatile LAS unsigned* MISC = (volatile LAS unsigned*)(lds + MISC_OFF);
    LAS int* TAB = (LAS int*)(lds + TAB_OFF);
    LAS int* t_rbs = TAB; LAS int* t_cnt = TAB + 40; LAS int* t_lcnt = TAB + 72; LAS int* t_gbase = TAB + 104;
#define PHASE_IDS() int tid = threadIdx.x; asm volatile("" : "+v"(tid)); const int lane = tid & 63, wave = __builtin_amdgcn_readfirstlane(tid >> 6); (void)lane; (void)wave
    const int G = gridDim.x;
    const int vcu = (G % 8 == 0) ? ((int)blockIdx.x % 8) * (G / 8) + (int)blockIdx.x / 8 : (int)blockIdx.x;

    const float* x = args.in[0]; const float* g_mix = args.in[1]; const float* w_in = args.in[2]; const float* b_in = args.in[3];
    const float* sinks = args.in[4]; const float* w_dw = args.in[5]; const float* b_dw = args.in[6]; const float* ln_g = args.in[7]; const float* ln_b = args.in[8];
    const float* g_attn = args.in[9]; const float* g_conv = args.in[10]; const float* w_out = args.in[11]; const float* b_out = args.in[12];
    const float* g_ffn = args.in[13]; const float* w_router = args.in[14]; const float* b_router = args.in[15];
    const float* w1 = args.in[16]; const float* b1 = args.in[17]; const float* w2 = args.in[18]; const float* b2 = args.in[19]; const float* g_final = args.in[20];
    float* out = args.out; unsigned char* ws = args.ws;
    unsigned* ctl = (unsigned*)(ws + WS_CTL);
    bf16* Win_t = (bf16*)(ws + WS_WIN); bf16* Wout_t = (bf16*)(ws + WS_WOUT); unsigned char* W1_t = ws + WS_W1; unsigned char* W2_t = ws + WS_W2; unsigned char* XN8 = ws + WS_XN8; bf16* X1B = (bf16*)(ws + WS_XN);
    bf16* XN = (bf16*)(ws + WS_XN); int* ltok = (int*)(ws + WS_LTOK); float* lgate = (float*)(ws + WS_LGATE); float* b1p = (float*)(ws + WS_B1P);
    float* RA = (float*)(ws + WS_RA); float* RS = RA + T; bf16* WrHi = (bf16*)(ws + WS_WR); bf16* WrLo = WrHi + 32 * 1024;
    unsigned char* ACT = ws + WS_ACT; bf16* PROJ = (bf16*)(ws + WS_PROJ); bf16* MIX = (bf16*)(ws + WS_MIX); unsigned char* YB = ws + WS_Y;
    unsigned* gcnt = ctl + CW_GCNT;

    for (int u = threadIdx.x; u < (LDS_BYTES - MISC_OFF) / 4; u += NWAVES * 64) ((LAS unsigned*)(lds + MISC_OFF))[u] = 0u;
    __syncthreads();
    XcdBarrier bar = xcd_barrier_post(ctl + CW_BAR, MISC + 8);

    {
        PHASE_IDS();
        LAS unsigned* scr = (LAS unsigned*)(lds + wave * 16384);
        const int gw = vcu * NWAVES + wave, NGW = G * NWAVES;
        constexpr int I_IN = 16 * 28, I_OUT = 16 * 16;
        for (int it = gw; it < I_IN + I_OUT; it += NGW) {
            int r = it;
            if (r < I_IN) { p0_item<2, 0>(w_in, INW, (unsigned char*)Win_t, 2048, scr, r / 28, r % 28, lane, 1.0f, g_mix); continue; } r -= I_IN;
            p0_item<2, 0>(w_out, 1024, (unsigned char*)Wout_t, 2048, scr, r >> 4, r & 15, lane, 1.0f, g_attn, g_conv);
        }
        for (int m = 2 * gw; m < T; m += 2 * NGW) {
            const GAS f32x4* xr = (const GAS f32x4*)(x + (size_t)m * D) + lane;
            f32x4 v[2][4]; float s[2] = {0.f, 0.f};
#pragma unroll
            for (int q = 0; q < 2; ++q)
#pragma unroll
                for (int j = 0; j < 4; ++j) v[q][j] = __builtin_nontemporal_load(xr + q * 256 + 64 * j);
#pragma unroll
            for (int q = 0; q < 2; ++q)
#pragma unroll
                for (int j = 0; j < 4; ++j) s[q] += (v[q][j].x * v[q][j].x + v[q][j].y * v[q][j].y) + (v[q][j].z * v[q][j].z + v[q][j].w * v[q][j].w);
#pragma unroll
            for (int q = 0; q < 2; ++q) {
                const float rstd = 1.0f / sqrtf(wave_sum(s[q]) * (1.0f / D) + RMS_EPS);
                if (lane == 0) RS[m + q] = rstd;
                GAS v2u* o8 = (GAS v2u*)(XN + (size_t)(m + q) * D) + lane;
#pragma unroll
                for (int j = 0; j < 4; ++j) { v2u o; o.x = pk2(v[q][j].x, v[q][j].y); o.y = pk2(v[q][j].z, v[q][j].w); o8[64 * j] = o; }
            }
        }
        const int gt = vcu * (NWAVES * 64) + tid, NGT = G * NWAVES * 64;
        for (int i = gt; i < 32 * 2048; i += NGT) { const int e = i >> 11, col = i & 2047; const int row = (col & ~255) + 128 * (col & 1) + ((col >> 1) & 127); b1p[e * 2048 + row] = b1[i]; }
        for (int i = gt; i < 32 * 1024; i += NGT) { const int e = i >> 10, k = i & 1023; const float v = w_router[k * 32 + e];
            const unsigned h = pk2(v, 0.f) & 0xffffu; const float lo = v - __uint_as_float(h << 16);
            const int fi = ((((e >> 4) * 32 + (k >> 5)) * 64 + 16 * ((k >> 3) & 3) + (e & 15)) * 8) + (k & 7);
            WrHi[fi] = (bf16)h; WrLo[fi] = (bf16)(pk2(lo, 0.f) & 0xffffu); }
    }
    xcd_barrier(bar);

    {
        const int grp = ((int)blockIdx.x >> 3) & 3;
        EpiProj E{PROJ, b_in, RS};
        {
            DenseSched S{(const char*)Win_t, T / 256, INW / 256, G, (int)blockIdx.x, 2048, 0, grp};
            pg8::gemm_phase<EpiProj, DenseSched, false>(lds, lds + EPI_OFF, (const char*)XN, 2048, S, E);
        }
        {
            PHASE_IDS();
            __syncthreads();
            LAS unsigned* scr = (LAS unsigned*)(lds + wave * 16384);
            const int gw = vcu * NWAVES + wave, NGW = G * NWAVES;
            constexpr int NIT_ALL = 32 * 8 * 64;
            int it = gw, NIT = NIT_ALL, NGW_ = NGW;
            if (G == 256) { const int c = (int)blockIdx.x; NGW_ = 1024;
                if (c >= 128) { it = (c - 128) * NWAVES + wave; NIT = 10240; } else { it = 10240 + c * NWAVES + wave; NIT = NIT_ALL; } }
            f32x4 va[16], vb[16];
            W8Item ia = w8_item(it < NIT ? it : 0, w1, w2, W1_t, W2_t), ib = ia;
            if (it < NIT) w8_load(ia, va, lane);
            while (it < NIT) {
                const int itb = it + NGW_;
                if (itb < NIT) { ib = w8_item(itb, w1, w2, W1_t, W2_t); w8_load(ib, vb, lane); }
                w8_store(ia, va, scr, lane);
                if (itb >= NIT) break;
                const int ita = itb + NGW_;
                if (ita < NIT) { ia = w8_item(ita, w1, w2, W1_t, W2_t); w8_load(ia, va, lane); }
                w8_store(ib, vb, scr, lane);
                it = ita;
            }
            __syncthreads();
        }
        {
            DenseSched S{(const char*)Win_t, T / 256, INW / 256, G, (int)blockIdx.x, 2048, grp, 1 << 30};
            pg8::gemm_phase<EpiProj, DenseSched, false>(lds, lds + EPI_OFF, (const char*)XN, 2048, S, E);
        }
    }
    xcd_barrier(bar);

    for (int unit = blockIdx.x; unit < T / 128; unit += G) {
        const int b = unit >> 4, n = unit & 15, t0 = b * SEQ + n * 128;
        {
            PHASE_IDS();
            constexpr int KOFF = 0, VOFF = 36864;
            const int i16 = lane & 15, g = lane >> 4;
            const int vq = i16 >> 2, vp = i16 & 3;
            float ssq = 0.f;
            const bf16* qrow = PROJ + (size_t)(t0 + 16 * wave + i16) * INW + 8 * g;
            bf16* orow = MIX + (size_t)(t0 + 16 * wave + i16) * D + 4 * g;
            bf16x8 q0n = *(const bf16x8*)qrow, q1n = *(const bf16x8*)(qrow + 32);
            v4u kpre[4], vpre[4];
#define KV_LOAD(kvh) do { _Pragma("unroll") for (int c4 = 0; c4 < 4; ++c4) { const int c = tid + 512 * c4, row = c >> 3, ch = c & 7; kpre[c4] = (v4u){0u, 0u, 0u, 0u}; vpre[c4] = kpre[c4]; \
                if (n > 0 || row >= 128) { const bf16* p = PROJ + (size_t)(t0 - 128 + row) * INW + (kvh) * 64 + ch * 8; kpre[c4] = *(const v4u*)(p + COL_K); vpre[c4] = *(const v4u*)(p + COL_V); } } } while (0)
#define KV_WRITE() do { _Pragma("unroll") for (int c4 = 0; c4 < 4; ++c4) { const int c = tid + 512 * c4, row = c >> 3, ch = c & 7; \
                *(LAS v4u*)(lds + KOFF + row * 144 + ch * 16) = kpre[c4]; *(LAS v4u*)(lds + VOFF + row * 144 + ch * 16) = vpre[c4]; } } while (0)
            KV_LOAD(0);
            __syncthreads();
            KV_WRITE();
            KV_LOAD(1);
            __syncthreads();
            for (int h = 0; h < 8; ++h) {
                if (h == 4) { __syncthreads(); KV_WRITE(); __syncthreads(); }
                const bf16x8 q0 = q0n, q1 = q1n;
                if (h < 7) { q0n = *(const bf16x8*)(qrow + (h + 1) * 64); q1n = *(const bf16x8*)(qrow + (h + 1) * 64 + 32); }
                f32x4 st[9];
#pragma unroll
                for (int j = 0; j < 9; ++j) { const LAS unsigned char* kp = lds + KOFF + (16 * (wave + j) + i16) * 144 + 16 * g;
                    const bf16x8 k0 = *(const LAS bf16x8*)kp, k1 = *(const LAS bf16x8*)(kp + 64);
                    st[j] = __builtin_amdgcn_mfma_f32_16x16x32_bf16(k0, q0, (f32x4){0.f, 0.f, 0.f, 0.f}, 0, 0, 0);
                    st[j] = __builtin_amdgcn_mfma_f32_16x16x32_bf16(k1, q1, st[j], 0, 0, 0); }
                const float NEG = -INFINITY;
#pragma unroll
                for (int j = 0; j < 9; ++j) { const bool dead = (n == 0) && (wave + j < 8);
#pragma unroll
                    for (int r = 0; r < 4; ++r) { const int kr = 4 * g + r; bool ok = !dead; if (j == 0) ok = ok && (kr > i16); if (j == 8) ok = ok && (kr <= i16); if (!ok) st[j][r] = NEG; } }
                const float sink2 = sinks[h] * LOG2E;
                float mx = sink2;
#pragma unroll
                for (int j = 0; j < 9; ++j) mx = fmaxf(fmaxf(mx, fmaxf(st[j][0], st[j][1])), fmaxf(st[j][2], st[j][3]));
                mx = fmaxf(mx, __shfl_xor(mx, 16)); mx = fmaxf(mx, __shfl_xor(mx, 32));
                float ls = 0.f;
#pragma unroll
                for (int j = 0; j < 9; ++j)
#pragma unroll
                    for (int r = 0; r < 4; ++r) { st[j][r] = __builtin_amdgcn_exp2f(st[j][r] - mx); ls += st[j][r]; }
                ls += __shfl_xor(ls, 16); ls += __shfl_xor(ls, 32);
                ls += __builtin_amdgcn_exp2f(sink2 - mx);
                const float inv = 1.0f / ls;
                bf16x8 pf[5];
#pragma unroll
                for (int kk = 0; kk < 5; ++kk) { v4u w; w.x = pk2(st[2 * kk][0], st[2 * kk][1]); w.y = pk2(st[2 * kk][2], st[2 * kk][3]);
                    if (kk < 4) { w.z = pk2(st[2 * kk + 1][0], st[2 * kk + 1][1]); w.w = pk2(st[2 * kk + 1][2], st[2 * kk + 1][3]); } else { w.z = 0u; w.w = 0u; }
                    pf[kk] = __builtin_bit_cast(bf16x8, w); }
#pragma unroll
                for (int dt = 0; dt < 4; ++dt) { f32x4 o = (f32x4){0.f, 0.f, 0.f, 0.f};
#pragma unroll
                    for (int kk = 0; kk < 5; ++kk) { const int kta = wave + 2 * kk, ktb = (kk < 4) ? wave + 2 * kk + 1 : wave + 8;
                        const LAS unsigned char* pa = lds + VOFF + (16 * kta + 4 * g + vq) * 144 + (16 * dt + 4 * vp) * 2;
                        const LAS unsigned char* pb = lds + VOFF + (16 * ktb + 4 * g + vq) * 144 + (16 * dt + 4 * vp) * 2;
                        const v4i16_t va = __builtin_amdgcn_ds_read_tr16_b64_v4i16((LAS v4i16_t*)pa), vb = __builtin_amdgcn_ds_read_tr16_b64_v4i16((LAS v4i16_t*)pb);
                        const bf16x8 vf = (bf16x8){va[0], va[1], va[2], va[3], vb[0], vb[1], vb[2], vb[3]};
                        o = __builtin_amdgcn_mfma_f32_16x16x32_bf16(vf, pf[kk], o, 0, 0, 0); }
                    o = o * inv; ssq += (o[0] * o[0] + o[1] * o[1]) + (o[2] * o[2] + o[3] * o[3]);
                    v2u w; w.x = pk2(o[0], o[1]); w.y = pk2(o[2], o[3]);
                    *(v2u*)(orow + h * 64 + 16 * dt) = w; }
            }
#undef KV_LOAD
#undef KV_WRITE
            ssq += __shfl_xor(ssq, 16); ssq += __shfl_xor(ssq, 32);
            if (g == 0) RA[t0 + 16 * wave + i16] = 1.0f / sqrtf(ssq * (1.0f / 512.0f) + RMS_EPS);
        }
        __syncthreads();
        {
            PHASE_IDS();
            const int cp = tid & 255, th = tid >> 8, c0 = 2 * cp;
            LAS float* tile = (LAS float*)lds;
            f32x2 wk[31];
#pragma unroll
            for (int j = 0; j < 31; ++j) wk[j] = *(const f32x2*)(w_dw + j * 512 + c0);
            const f32x2 bdw = *(const f32x2*)(b_dw + c0);
            const int s0 = n * 128 + 64 * th;
            const bf16* pbase = PROJ + (size_t)(b * SEQ) * INW + c0;
            f32x2 uu[38];
            unsigned ra_[8], rg_[8];
#define GLU_CVT(aw, gw_, dst) do { const float g0 = bf_lo(gw_), g1 = bf_hi(gw_); \
                dst.x = bf_lo(aw) * __builtin_amdgcn_rcpf(1.0f + __builtin_amdgcn_exp2f(-g0 * LOG2E)); dst.y = bf_hi(aw) * __builtin_amdgcn_rcpf(1.0f + __builtin_amdgcn_exp2f(-g1 * LOG2E)); } while (0)
#pragma unroll
            for (int i = 0; i < 30; ++i) { const int pos = s0 - 30 + i; unsigned aw = 0u, gw_ = 0u;
                if (pos >= 0) { aw = *(const unsigned*)(pbase + (size_t)pos * INW + COL_A); gw_ = *(const unsigned*)(pbase + (size_t)pos * INW + COL_G); }
                GLU_CVT(aw, gw_, uu[i]); }
#pragma unroll
            for (int tt = 0; tt < 8; ++tt) { const int pos = s0 + tt; ra_[tt] = *(const unsigned*)(pbase + (size_t)pos * INW + COL_A); rg_[tt] = *(const unsigned*)(pbase + (size_t)pos * INW + COL_G); }
            LAS float* prm = tile + 16 * 512;
            prm[tid] = ln_g[tid]; prm[512 + tid] = ln_b[tid];
            for (int chunk = 0; chunk < 8; ++chunk) {
#pragma unroll
                for (int tt = 0; tt < 8; ++tt) GLU_CVT(ra_[tt], rg_[tt], uu[30 + tt]);
                if (chunk < 7) {
#pragma unroll
                    for (int tt = 0; tt < 8; ++tt) { const int pos = s0 + 8 * (chunk + 1) + tt; ra_[tt] = *(const unsigned*)(pbase + (size_t)pos * INW + COL_A); rg_[tt] = *(const unsigned*)(pbase + (size_t)pos * INW + COL_G); }
                }
#pragma unroll
                for (int tt = 0; tt < 8; ++tt) { f32x2 a = bdw;
#pragma unroll
                    for (int j = 0; j < 31; ++j) a = a + wk[j] * uu[tt + j];
                    *(LAS f32x2*)(tile + (th * 8 + tt) * 512 + c0) = a; }
#pragma unroll
                for (int i = 0; i < 30; ++i) uu[i] = uu[i + 8];
                LDS_WAIT(); __builtin_amdgcn_s_barrier(); asm volatile("" ::: "memory");
#pragma unroll
                for (int q = 0; q < 2; ++q) { const int row = 2 * wave + q, rth = row >> 3, rtt = row & 7; const int tok = t0 + 64 * rth + 8 * chunk + rtt;
                    const f32x4 a0 = *(const LAS f32x4*)(tile + row * 512 + 8 * lane), a1 = *(const LAS f32x4*)(tile + row * 512 + 8 * lane + 4);
                    float v[8] = {a0[0], a0[1], a0[2], a0[3], a1[0], a1[1], a1[2], a1[3]};
                    float s = 0.f;
#pragma unroll
                    for (int j = 0; j < 8; ++j) s += v[j];
                    const float mean = wave_sum_dpp(s) * (1.0f / 512.0f);
                    float s2 = 0.f;
#pragma unroll
                    for (int j = 0; j < 8; ++j) { v[j] -= mean; s2 += v[j] * v[j]; }
                    const float rstd = 1.0f / sqrtf(wave_sum_dpp(s2) * (1.0f / 512.0f) + LN_EPS);
                    const f32x4 lg0 = *(const LAS f32x4*)(prm + 8 * lane), lg1 = *(const LAS f32x4*)(prm + 8 * lane + 4), lb0 = *(const LAS f32x4*)(prm + 512 + 8 * lane), lb1 = *(const LAS f32x4*)(prm + 512 + 8 * lane + 4);
                    const float lgv[8] = {lg0[0], lg0[1], lg0[2], lg0[3], lg1[0], lg1[1], lg1[2], lg1[3]}, lbv[8] = {lb0[0], lb0[1], lb0[2], lb0[3], lb1[0], lb1[1], lb1[2], lb1[3]};
                    float s3 = 0.f;
#pragma unroll
                    for (int j = 0; j < 8; ++j) { const float y = v[j] * rstd * lgv[j] + lbv[j]; const float z = y * __builtin_amdgcn_rcpf(1.0f + __builtin_amdgcn_exp2f(-y * LOG2E)); v[j] = z; s3 += z * z; }
                    const float rc = 1.0f / sqrtf(wave_sum_dpp(s3) * (1.0f / 512.0f) + RMS_EPS);
                    v4u w; w.x = pk2(v[0] * rc, v[1] * rc); w.y = pk2(v[2] * rc, v[3] * rc); w.z = pk2(v[4] * rc, v[5] * rc); w.w = pk2(v[6] * rc, v[7] * rc);
                    *(v4u*)(MIX + (size_t)tok * D + 512 + 8 * lane) = w; }
                LDS_WAIT(); __builtin_amdgcn_s_barrier(); asm volatile("" ::: "memory");
            }
#undef GLU_CVT
        }
    }
    xcd_barrier(bar);

    {
        const int grp = ((int)blockIdx.x >> 3) % 3;
        EpiRes E{XN, X1B, b_out, RA};
        {
            DenseSched S{(const char*)Wout_t, T / 256, D / 256, G, (int)blockIdx.x, 2048, 0, grp};
            pg8::gemm_phase<EpiRes, DenseSched, false>(lds, lds + EPI_OFF, (const char*)MIX, 2048, S, E);
        }
        {
            PHASE_IDS();
            __syncthreads();
            LAS unsigned* scr = (LAS unsigned*)(lds + wave * 16384);
            const int gw = vcu * NWAVES + wave, NGW = G * NWAVES;
            constexpr int NIT0 = 32 * 8 * 64, NIT = NIT0 + 32 * 8 * 32;
            f32x4 va[16], vb[16];
            int it = NIT0 + gw;
            W8Item ia = w8_item(it < NIT ? it : NIT0, w1, w2, W1_t, W2_t), ib = ia;
            if (it < NIT) w8_load(ia, va, lane);
            while (it < NIT) {
                const int itb = it + NGW;
                if (itb < NIT) { ib = w8_item(itb, w1, w2, W1_t, W2_t); w8_load(ib, vb, lane); }
                w8_store(ia, va, scr, lane);
                if (itb >= NIT) break;
                const int ita = itb + NGW;
                if (ita < NIT) { ia = w8_item(ita, w1, w2, W1_t, W2_t); w8_load(ia, va, lane); }
                w8_store(ib, vb, scr, lane);
                it = ita;
            }
            __syncthreads();
        }
        {
            DenseSched S{(const char*)Wout_t, T / 256, D / 256, G, (int)blockIdx.x, 2048, grp, 1 << 30};
            pg8::gemm_phase<EpiRes, DenseSched, false>(lds, lds + EPI_OFF, (const char*)MIX, 2048, S, E);
        }
    }
    xcd_barrier(bar);

    {
        PHASE_IDS();
        if (wave < 4) __builtin_amdgcn_global_load_lds((const unsigned*)((const char*)g_ffn + wave * 1024 + lane * 16), (LAS unsigned*)(lds + P4_G_OFF + wave * 1024), 16, 0, 0);
#pragma unroll
        for (int i = 0; i < 16; ++i) __builtin_amdgcn_global_load_lds((const unsigned*)((const char*)WrHi + (size_t)(wave * 16 + i) * 1024 + lane * 16), (LAS unsigned*)(lds + (wave * 16 + i) * 1024), 16, 0, 0);
        VM_WAIT(); __syncthreads();
    }
    for (int unit = blockIdx.x; unit < T / 128; unit += G) {
        PHASE_IDS();
        const int i16 = lane & 15, g = lane >> 4;
        if (tid < 32) t_lcnt[tid] = 0;
        __syncthreads();
        const int tok = unit * 128 + wave * 16 + i16;
        const bf16* xr = X1B + (size_t)tok * D + 8 * g;
        float ss = 0.f;
#pragma unroll 8
        for (int s = 0; s < 32; ++s) { const v4u a = *(const v4u*)(xr + 32 * s);
            const float a0 = bf_lo(a.x), a1 = bf_hi(a.x), a2 = bf_lo(a.y), a3 = bf_hi(a.y), a4 = bf_lo(a.z), a5 = bf_hi(a.z), a6 = bf_lo(a.w), a7 = bf_hi(a.w);
            ss += (a0 * a0 + a1 * a1) + (a2 * a2 + a3 * a3) + (a4 * a4 + a5 * a5) + (a6 * a6 + a7 * a7); }
        ss += __shfl_xor(ss, 16); ss += __shfl_xor(ss, 32);
        const float rstd = 1.0f / sqrtf(ss * (1.0f / D) + RMS_EPS);
        f32x4 acc0 = (f32x4){0.f, 0.f, 0.f, 0.f}, acc1 = acc0;
        {
        unsigned char* hrow = XN8 + (size_t)tok * D + 8 * g;
        const bf16* wh0 = WrHi + lane * 8; const bf16* wl0 = WrLo + lane * 8;
        for (int s8 = 0; s8 < 4; ++s8) {
            v4u xc[8];
#pragma unroll
            for (int q = 0; q < 8; ++q) xc[q] = *(const v4u*)(xr + 32 * (8 * s8 + q));
            __builtin_amdgcn_sched_barrier(0);
#pragma unroll
            for (int q = 0; q < 8; ++q) { const int s = 8 * s8 + q; const v4u xa = xc[q];
            const f32x4 a = (f32x4){bf_lo(xa.x), bf_hi(xa.x), bf_lo(xa.y), bf_hi(xa.y)} * rstd * *(const LAS f32x4*)((const LAS float*)(lds + P4_G_OFF) + 8 * g + 32 * s), b = (f32x4){bf_lo(xa.z), bf_hi(xa.z), bf_lo(xa.w), bf_hi(xa.w)} * rstd * *(const LAS f32x4*)((const LAS float*)(lds + P4_G_OFF) + 8 * g + 32 * s + 4);
            v4u hp; hp.x = pk2(a[0], a[1]); hp.y = pk2(a[2], a[3]); hp.z = pk2(b[0], b[1]); hp.w = pk2(b[2], b[3]);
            v4u lp; lp.x = pk2(a[0] - bf_lo(hp.x), a[1] - bf_hi(hp.x)); lp.y = pk2(a[2] - bf_lo(hp.y), a[3] - bf_hi(hp.y)); lp.z = pk2(b[0] - bf_lo(hp.z), b[1] - bf_hi(hp.z)); lp.w = pk2(b[2] - bf_lo(hp.w), b[3] - bf_hi(hp.w));
            const bf16x8 hh = __builtin_bit_cast(bf16x8, hp), hl = __builtin_bit_cast(bf16x8, lp);
            const LAS unsigned char* wf = lds + lane * 16; const bf16x8 whA = *(const LAS bf16x8*)(wf + (0 * 32 + s) * 1024), whB = *(const LAS bf16x8*)(wf + (1 * 32 + s) * 1024), wlA = *(const LAS bf16x8*)(wf + (2 * 32 + s) * 1024), wlB = *(const LAS bf16x8*)(wf + (3 * 32 + s) * 1024);
            acc0 = __builtin_amdgcn_mfma_f32_16x16x32_bf16(whA, hh, acc0, 0, 0, 0); acc0 = __builtin_amdgcn_mfma_f32_16x16x32_bf16(whA, hl, acc0, 0, 0, 0); acc0 = __builtin_amdgcn_mfma_f32_16x16x32_bf16(wlA, hh, acc0, 0, 0, 0);
            acc1 = __builtin_amdgcn_mfma_f32_16x16x32_bf16(whB, hh, acc1, 0, 0, 0); acc1 = __builtin_amdgcn_mfma_f32_16x16x32_bf16(whB, hl, acc1, 0, 0, 0); acc1 = __builtin_amdgcn_mfma_f32_16x16x32_bf16(wlB, hh, acc1, 0, 0, 0); }
        }
        }
        {
            unsigned char* hrow = XN8 + (size_t)tok * D + 8 * g;
            const float rs8 = rstd * H_SCALE;
            for (int s8 = 0; s8 < 4; ++s8) {
                v4u xc[8];
#pragma unroll
                for (int q = 0; q < 8; ++q) xc[q] = *(const v4u*)(xr + 32 * (8 * s8 + q));
                __builtin_amdgcn_sched_barrier(0);
#pragma unroll
                for (int q = 0; q < 8; ++q) { const int s = 8 * s8 + q; const v4u xa = xc[q];
                    const f32x4 a = (f32x4){bf_lo(xa.x), bf_hi(xa.x), bf_lo(xa.y), bf_hi(xa.y)} * rs8 * *(const LAS f32x4*)((const LAS float*)(lds + P4_G_OFF) + 8 * g + 32 * s), b = (f32x4){bf_lo(xa.z), bf_hi(xa.z), bf_lo(xa.w), bf_hi(xa.w)} * rs8 * *(const LAS f32x4*)((const LAS float*)(lds + P4_G_OFF) + 8 * g + 32 * s + 4);
                    v2u h8; h8.x = pk4_fp8(a[0], a[1], a[2], a[3]); h8.y = pk4_fp8(b[0], b[1], b[2], b[3]); *(v2u*)(hrow + 32 * s) = h8; }
            }
        }
        LAS float* sc = (LAS float*)(lds + EPI_OFF + wave * 2112);
#pragma unroll
        for (int r = 0; r < 4; ++r) { sc[i16 * 33 + 4 * g + r] = acc0[r] + b_router[4 * g + r]; sc[i16 * 33 + 16 + 4 * g + r] = acc1[r] + b_router[16 + 4 * g + r]; }
        LDS_WAIT(); asm volatile("" ::: "memory");
        int idx[4], rank[4]; float gate[4];
        if (lane < 16) {
            float v[32];
#pragma unroll
            for (int e = 0; e < 32; ++e) v[e] = sc[lane * 33 + e];
            float val[4];
#pragma unroll
            for (int k = 0; k < 4; ++k) { float best = -INFINITY; int bi = 0;
#pragma unroll
                for (int e = 0; e < 32; ++e) if (v[e] > best) { best = v[e]; bi = e; }
                val[k] = best; idx[k] = bi;
#pragma unroll
                for (int e = 0; e < 32; ++e) v[e] = (e == bi) ? -INFINITY : v[e]; }
            float den = 0.f;
#pragma unroll
            for (int k = 0; k < 4; ++k) { gate[k] = __expf(val[k] - val[0]); den += gate[k]; }
            const float rden = 1.0f / den;
#pragma unroll
            for (int k = 0; k < 4; ++k) { gate[k] *= rden; rank[k] = atomicAdd((int*)(t_lcnt + idx[k]), 1); }
        }
        __syncthreads();
        if (tid < 32) { const int c = t_lcnt[tid]; t_gbase[tid] = c ? (int)__hip_atomic_fetch_add(gcnt + 16 * tid, (unsigned)c, __ATOMIC_RELAXED, __HIP_MEMORY_SCOPE_AGENT) : 0; }
        __syncthreads();
        if (lane < 16) {
            const int tk = unit * 128 + wave * 16 + lane;
#pragma unroll
            for (int k = 0; k < 4; ++k) { const int pos = t_gbase[idx[k]] + rank[k]; ltok[idx[k] * LIST_CAP + pos] = tk * 4 + k; lgate[idx[k] * LIST_CAP + pos] = gate[k]; }
        }
        __syncthreads();
    }
    xcd_barrier(bar);

    if (threadIdx.x < 32) t_cnt[threadIdx.x] = (int)__hip_atomic_load(gcnt + 16 * threadIdx.x, __ATOMIC_RELAXED, __HIP_MEMORY_SCOPE_AGENT);
    __syncthreads();
    if (threadIdx.x == 0) { int s = 0; for (int e = 0; e < 32; ++e) { t_rbs[e] = s; s += (t_cnt[e] + 255) >> 8; } t_rbs[32] = s; }
    __syncthreads();
    const int NB = __builtin_amdgcn_readfirstlane(t_rbs[32]);

    {
        MoeSched<true> S{(const char*)W1_t, (size_t)2048 * 1024, ltok, t_rbs, t_cnt, NB, 8, G, (int)blockIdx.x, 1024};
        EpiSwiglu E{ACT, b1p};
        pg8::gemm_phase<EpiSwiglu, MoeSched<true>, true>(lds, lds + EPI_OFF, (const char*)XN8, 1024, S, E);
    }
    xcd_barrier(bar);

    {
        MoeSched<false> S{(const char*)W2_t, (size_t)1024 * 1024, ltok, t_rbs, t_cnt, NB, 4, G, (int)blockIdx.x, 1024};
        EpiMoeOut E{YB, b2, ltok, lgate};
        pg8::gemm_phase<EpiMoeOut, MoeSched<false>, true>(lds, lds + EPI_OFF, (const char*)ACT, 1024, S, E);
    }
    xcd_barrier(bar);

    {
        PHASE_IDS();
        const int gw = vcu * NWAVES + wave, NGW = G * NWAVES;
        f32x4 gfin[4];
#pragma unroll
        for (int j = 0; j < 4; ++j) gfin[j] = *((const f32x4*)g_final + lane + 64 * j);
        for (int m0 = 2 * gw; m0 < T; m0 += 2 * NGW) {
            v2u xw_[2][4]; unsigned yw[2][4][4];
#pragma unroll
            for (int q = 0; q < 2; ++q) { const GAS v2u* xr = (const GAS v2u*)(X1B + (size_t)(m0 + q) * D) + lane;
#pragma unroll
                for (int j = 0; j < 4; ++j) xw_[q][j] = __builtin_nontemporal_load(xr + 64 * j);
#pragma unroll
                for (int k = 0; k < 4; ++k) { const GAS unsigned* yr = (const GAS unsigned*)(YB + ((size_t)(m0 + q) * 4 + k) * D) + lane;
#pragma unroll
                    for (int j = 0; j < 4; ++j) yw[q][k][j] = __builtin_nontemporal_load(yr + 64 * j); } }
#pragma unroll
            for (int q = 0; q < 2; ++q) {
                f32x4 v[4];
#pragma unroll
                for (int j = 0; j < 4; ++j) v[j] = (f32x4){bf_lo(xw_[q][j].x), bf_hi(xw_[q][j].x), bf_lo(xw_[q][j].y), bf_hi(xw_[q][j].y)};
#pragma unroll
                for (int k = 0; k < 4; ++k)
#pragma unroll
                    for (int j = 0; j < 4; ++j) { const f32x2 lo = __builtin_amdgcn_cvt_pk_f32_fp8((int)yw[q][k][j], false), hi = __builtin_amdgcn_cvt_pk_f32_fp8((int)yw[q][k][j], true);
                        v[j].x += lo.x * (1.0f / Y_SCALE); v[j].y += lo.y * (1.0f / Y_SCALE); v[j].z += hi.x * (1.0f / Y_SCALE); v[j].w += hi.y * (1.0f / Y_SCALE); }
                float s = 0.f;
#pragma unroll
                for (int j = 0; j < 4; ++j) s += (v[j].x * v[j].x + v[j].y * v[j].y) + (v[j].z * v[j].z + v[j].w * v[j].w);
                const float rstd = 1.0f / sqrtf(wave_sum_dpp(s) * (1.0f / D) + RMS_EPS);
                GAS f32x4* xw = (GAS f32x4*)(out + (size_t)(m0 + q) * D) + lane;
#pragma unroll
                for (int j = 0; j < 4; ++j) __builtin_nontemporal_store(v[j] * rstd * gfin[j], xw + 64 * j);
            }
        }
    }
}

extern "C" void kernel_launch(void* const* d_in, const int* in_sizes, int n_in, void* d_out, int out_size, void* d_ws, size_t ws_size, hipStream_t stream) {
    static int grid = 0;
    if (grid == 0) {
        if (n_in != 21 || in_sizes[0] != T * D || out_size != T * D || ws_size < WS_END) { fprintf(stderr, "kernel_launch: unexpected shapes (n_in %d, in0 %d, out %d, ws %zu)\n", n_in, n_in > 0 ? in_sizes[0] : -1, out_size, ws_size); grid = -1; return; }
        int dev = 0, cus = 0, per_cu = 0;
        if (hipGetDevice(&dev) != hipSuccess || hipDeviceGetAttribute(&cus, hipDeviceAttributeMultiprocessorCount, dev) != hipSuccess) { grid = -1; return; }
        if (hipFuncSetAttribute((const void*)hymba_fwd, hipFuncAttributeMaxDynamicSharedMemorySize, LDS_BYTES) != hipSuccess) { fprintf(stderr, "kernel_launch: hipFuncSetAttribute failed\n"); grid = -1; return; }
        if (hipOccupancyMaxActiveBlocksPerMultiprocessor(&per_cu, (const void*)hymba_fwd, NWAVES * 64, LDS_BYTES) != hipSuccess || per_cu < 1)
            fprintf(stderr, "kernel_launch: occupancy query reports %d workgroups per CU\n", per_cu);
        (void)hipGetLastError();
        grid = cus;
    }
    if (grid < 0) return;
    if (hipMemsetAsync((char*)d_ws + WS_CTL, 0, CTL_ZERO_BYTES, stream) != hipSuccess) return;
    Args a{};
    for (int i = 0; i < 21; ++i) a.in[i] = (const float*)d_in[i];
    a.out = (float*)d_out; a.ws = (unsigned char*)d_ws;
    hipLaunchKernelGGL(hymba_fwd, dim3(grid), dim3(NWAVES * 64), LDS_BYTES, stream, a);
}
```

```cpp
#include <hip/hip_runtime.h>
#include <cstdio>
#include <cstdint>

namespace pg8 {
#define PG8_LAS __attribute__((address_space(3)))
typedef unsigned short bf16_t;
typedef short bf16x8 __attribute__((ext_vector_type(8)));
typedef float f32x4 __attribute__((ext_vector_type(4)));
typedef unsigned u32x4 __attribute__((ext_vector_type(4)));
constexpr int BM = 256, BK = 64, HALF = 128, HTB = HALF * BK * 2, STAGE_BYTES = 8 * HTB, NXCD = 8, WGM = 8;

__host__ __device__ __forceinline__ int lds_byte(int r, int c) { const int st = (r >> 4) * 2 + (c >> 5), rr = r & 15, cc = c & 31, ob = rr * 64 + cc * 2; return st * 1024 + (ob ^ (((ob >> 9) & 1) << 5)); }
__host__ __device__ __forceinline__ void stage_rc(int b, int& R, int& C) { const int st = b / 1024, sb = b % 1024, swz = sb ^ (((sb >> 9) & 1) << 5); R = (st >> 1) * 16 + swz / 64; C = (st & 1) * 32 + (swz % 64) / 2; }
__host__ __device__ __forceinline__ int perm32(int rho) { const int n = rho >> 4, i = rho & 15; return 8 * (i >> 2) + 4 * n + (i & 3); }

struct Unit { int pm, pn, e, rb, cnt; };

__device__ __forceinline__ bool static_order(int i, int G, int c, int nM, int nN, int& pm, int& pn) {
    const int nwg = nM * nN; const long L = (long)i * G + c; if (L >= nwg) return false;
    int wgid = (int)L; { const int q = nwg / NXCD, r = nwg % NXCD, xcd = wgid % NXCD, off = wgid / NXCD; wgid = (xcd < r ? xcd * (q + 1) : r * (q + 1) + (xcd - r) * q) + off; }
    const int nig = WGM * nN, gid = wgid / nig, fm = gid * WGM, gsz = (nM - fm) < WGM ? (nM - fm) : WGM;
    pm = fm + ((wgid % nig) % gsz); pn = (wgid % nig) / gsz; return true;
}

__device__ __forceinline__ unsigned cvt_pk_bf16(float lo, float hi) { unsigned r; asm volatile("v_cvt_pk_bf16_f32 %0, %1, %2" : "=v"(r) : "v"(lo), "v"(hi)); return r; }

typedef int i32x8 __attribute__((ext_vector_type(8)));
typedef int i32x4v __attribute__((ext_vector_type(4)));
template <class Epi, class Sched, bool FP8, bool ALIGN = true>
__device__ __forceinline__ void gemm_phase(PG8_LAS unsigned char* lds, PG8_LAS unsigned char* epi, const char* Abase, const int rp, const Sched& S, const Epi& E) {
    int tid = threadIdx.x; asm volatile("" : "+v"(tid));
    const int wid = __builtin_amdgcn_readfirstlane(tid >> 6), lane = tid & 63, wr = wid >> 2, wc = wid & 3, fr = lane & 15, fq = lane >> 4;
    const int nt = rp / 128;
    int RA[2]; unsigned CA2[2], voffB[2];
#pragma unroll
    for (int i = 0; i < 2; ++i) { int R, C; stage_rc(tid * 16 + i * 8192, R, C); const int Rb = Epi::PERM ? ((R & ~31) + perm32(R & 31)) : R;
        RA[i] = R; CA2[i] = (unsigned)C * 2u; voffB[i] = (unsigned)(Rb * rp + C * 2); }
    const size_t kstep = (size_t)(BK * 2);
    const size_t hstepB = (size_t)HALF * rp;
    const unsigned ldsw = (unsigned)wid * 1024u;
    const int aoff = lds_byte(wr * 64 + fr, fq * 8), boff = lds_byte(wc * 32 + fr, fq * 8);
#define PG8_SA(b, h) (((b) * 2 + (h)) * HTB)
#define PG8_SB(b, h) ((4 + (b) * 2 + (h)) * HTB)
#define PG8_STAGE(bufoff, gbase, voff) do { _Pragma("unroll") for (int _i = 0; _i < 2; ++_i) { unsigned _vo = (voff)[_i]; asm volatile("" : "+v"(_vo));   \
        __builtin_amdgcn_global_load_lds((const unsigned*)((const char*)(gbase) + _vo), (PG8_LAS unsigned*)(lds + (bufoff) + ldsw + _i * 8192), 16, 0, 0); } } while (0)
#define PG8_LDA(dst, b, h) do { _Pragma("unroll") for (int m = 0; m < 4; ++m) _Pragma("unroll") for (int k = 0; k < 2; ++k) dst[m][k] = *(const PG8_LAS bf16x8*)(lds + PG8_SA(b, h) + aoff + m * 2048 + k * 1024); } while (0)
#define PG8_LDB(dst, b, h) do { _Pragma("unroll") for (int n = 0; n < 2; ++n) _Pragma("unroll") for (int k = 0; k < 2; ++k) dst[n][k] = *(const PG8_LAS bf16x8*)(lds + PG8_SB(b, h) + boff + n * 2048 + k * 1024); } while (0)
#define PG8_CAT8(x) __builtin_shufflevector(__builtin_bit_cast(i32x4v, x[0]), __builtin_bit_cast(i32x4v, x[1]), 0, 1, 2, 3, 4, 5, 6, 7)
#define PG8_MMA_(ai, bj, At, Bt, Z) do { __builtin_amdgcn_s_setprio(1); \
        if constexpr (FP8) { _Pragma("unroll") for (int m = 0; m < 4; ++m) _Pragma("unroll") for (int n = 0; n < 2; ++n) \
            { const i32x8 _b = PG8_CAT8(Bt[n]), _a = PG8_CAT8(At[m]);   \
              if (Z) asm volatile("v_mfma_f32_16x16x128_f8f6f4 %0, %1, %2, 0" : "=&v"(acc[ai][bj][m][n]) : "v"(_b), "v"(_a)); \
              else asm volatile("v_mfma_f32_16x16x128_f8f6f4 %0, %1, %2, %0" : "+v"(acc[ai][bj][m][n]) : "v"(_b), "v"(_a)); } } \
        else { _Pragma("unroll") for (int m = 0; m < 4; ++m) _Pragma("unroll") for (int n = 0; n < 2; ++n) _Pragma("unroll") for (int k = 0; k < 2; ++k) \
            acc[ai][bj][m][n] = __builtin_amdgcn_mfma_f32_16x16x32_bf16(Bt[n][k], At[m][k], acc[ai][bj][m][n], 0, 0, 0); } \
        __builtin_amdgcn_s_setprio(0); } while (0)
#define PG8_MMA(ai, bj, At, Bt) PG8_MMA_(ai, bj, At, Bt, false)
#define PG8_MMA0(ai, bj, At, Bt) do { if (FP8 && first) PG8_MMA_(ai, bj, At, Bt, true); else PG8_MMA_(ai, bj, At, Bt, false); } while (0)
#define PG8_WAIT_V(n) asm volatile("s_waitcnt vmcnt(" #n ")" ::: "memory")
#define PG8_WAIT_L(n) asm volatile("s_waitcnt lgkmcnt(" #n ")" ::: "memory")
#define PG8_BAR __builtin_amdgcn_s_barrier()
#define PG8_SCHED __builtin_amdgcn_sched_barrier(0)
#define PG8_ZERO() do { if constexpr (!FP8) { _Pragma("unroll") for (int a = 0; a < 2; ++a) _Pragma("unroll") for (int b = 0; b < 2; ++b) _Pragma("unroll") for (int m = 0; m < 4; ++m) _Pragma("unroll") for (int n = 0; n < 2; ++n) acc[a][b][m][n] = (f32x4){0.f, 0.f, 0.f, 0.f}; } } while (0)
#define PG8_VA(dst, u) do { _Pragma("unroll") for (int _h = 0; _h < 2; ++_h) _Pragma("unroll") for (int _i = 0; _i < 2; ++_i) dst[_h][_i] = S.a_off(u, _h * HALF + RA[_i]) + CA2[_i]; } while (0)
    Unit cur, nxt; int ui = 0;
    if (!S.next(0, cur)) return;
    f32x4 acc[2][2][4][2];
    PG8_ZERO();
    bf16x8 At[4][2], B0[2][2], B1[2][2];
    unsigned cvA[2][2], nvA[2][2];
    float rs[2][4];
    PG8_VA(cvA, cur);
    const char* cB = S.b_tile(cur);
    const char* cA = Abase + S.a_base(cur);
    E.side(cur, epi, wid, lane);
    PG8_STAGE(PG8_SB(0, 0), cB, voffB); PG8_STAGE(PG8_SB(0, 1), cB + hstepB, voffB); PG8_STAGE(PG8_SA(0, 0), cA, cvA[0]); PG8_STAGE(PG8_SA(0, 1), cA, cvA[1]);
    if (wr == 1) PG8_BAR;
    PG8_WAIT_V(2); PG8_BAR;
    PG8_STAGE(PG8_SB(1, 0), cB + kstep, voffB); PG8_STAGE(PG8_SA(1, 0), cA + kstep, cvA[0]); PG8_STAGE(PG8_SB(1, 1), cB + hstepB + kstep, voffB);
    PG8_WAIT_V(6); PG8_BAR;
    for (;;) {
        const bool has_next = S.next(ui + 1, nxt);
        if constexpr (Sched::GATHER) { if (has_next) S.gather_dma(nxt, epi + ((ui + 1) & 1) * 4096 + 3072, wid, lane); }
        const char* nB = has_next ? S.b_tile(nxt) : cB;
        const char* nA = has_next ? Abase + S.a_base(nxt) : cA;
        PG8_LAS unsigned char* area = epi + (ui & 1) * 4096;
        for (int t = 0; t < nt; t += 2) {
            const bool last = (t == nt - 2), first = (t == 0);
            if constexpr (Epi::MIDSCALE) { if (t == nt / 2) {
#pragma unroll
                for (int a = 0; a < 2; ++a)
#pragma unroll
                    for (int m = 0; m < 4; ++m) rs[a][m] = *(const PG8_LAS float*)(area + 1024 + 4 * (a * 128 + wr * 64 + m * 16 + fr));
#pragma unroll
                for (int a = 0; a < 2; ++a)
#pragma unroll
                    for (int b = 0; b < 2; ++b)
#pragma unroll
                        for (int m = 0; m < 4; ++m)
#pragma unroll
                            for (int n = 0; n < 2; ++n) acc[a][b][m][n] = acc[a][b][m][n] * rs[a][m]; } }
            const char* a1 = cA + (size_t)(t + 1) * kstep;
            const char* a2 = last ? nA : cA + (size_t)(t + 2) * kstep; const char* b2 = last ? nB : cB + (size_t)(t + 2) * kstep;
            const char* a3 = a2 + kstep; const char* b3 = b2 + kstep;
            if constexpr (Sched::GATHER) { if (last) {
#pragma unroll
                for (int h = 0; h < 2; ++h)
#pragma unroll
                    for (int i = 0; i < 2; ++i) nvA[h][i] = has_next ? S.a_fin(nxt, h * HALF + RA[i], *(const PG8_LAS int*)(epi + ((ui + 1) & 1) * 4096 + 3072 + 4 * (h * HALF + RA[i]))) + CA2[i] : cvA[h][i]; } }
            unsigned sA[2][2];
#pragma unroll
            for (int h = 0; h < 2; ++h)
#pragma unroll
                for (int i = 0; i < 2; ++i) sA[h][i] = (Sched::GATHER && last) ? nvA[h][i] : cvA[h][i];
            PG8_LDB(B0, 0, 0); PG8_LDB(B1, 0, 1); PG8_SCHED; PG8_LDA(At, 0, 0); PG8_STAGE(PG8_SA(1, 1), a1, cvA[1]);
            PG8_WAIT_V(8); PG8_WAIT_L(0); PG8_BAR; PG8_MMA0(0, 0, At, B0); PG8_MMA0(0, 1, At, B1); PG8_BAR; PG8_SCHED;
            PG8_LDA(At, 0, 1); PG8_STAGE(PG8_SB(0, 0), b2, voffB); PG8_STAGE(PG8_SB(0, 1), b2 + hstepB, voffB); PG8_STAGE(PG8_SA(0, 0), a2, sA[0]);
            PG8_WAIT_V(8); PG8_WAIT_L(0); PG8_BAR; PG8_MMA0(1, 0, At, B0); PG8_MMA0(1, 1, At, B1); PG8_BAR; PG8_SCHED;
            PG8_LDB(B0, 1, 0); PG8_LDB(B1, 1, 1); PG8_SCHED; PG8_LDA(At, 1, 0); PG8_STAGE(PG8_SA(0, 1), a2, sA[1]);
            PG8_WAIT_V(8); PG8_WAIT_L(0); PG8_BAR; PG8_MMA(0, 0, At, B0); PG8_MMA(0, 1, At, B1); PG8_BAR; PG8_SCHED;
            PG8_LDA(At, 1, 1); PG8_STAGE(PG8_SB(1, 0), b3, voffB); PG8_STAGE(PG8_SB(1, 1), b3 + hstepB, voffB); PG8_STAGE(PG8_SA(1, 0), a3, sA[0]);
            PG8_WAIT_V(8); PG8_WAIT_L(0); PG8_BAR; PG8_MMA(1, 0, At, B0); PG8_MMA(1, 1, At, B1); PG8_BAR; PG8_SCHED;
        }
        if constexpr (ALIGN) { if (wr == 0) PG8_BAR; }
        if constexpr (FP8) asm volatile("s_nop 15\n\ts_nop 15" ::: "memory");
        E(acc, cur, wr, wc, fr, fq, area);
        if (!has_next) break;
        PG8_ZERO();
        cur = nxt; cB = nB; cA = nA; ++ui;
        E.side(cur, epi + (ui & 1) * 4096, wid, lane);
        if constexpr (Sched::GATHER) {
#pragma unroll
            for (int h = 0; h < 2; ++h)
#pragma unroll
                for (int i = 0; i < 2; ++i) cvA[h][i] = nvA[h][i]; }
        if constexpr (ALIGN) { if (wr == 1) PG8_BAR; }
    }
    PG8_WAIT_V(0);
    if constexpr (!ALIGN) { if (wr == 0) PG8_BAR; }
    PG8_BAR;
#undef PG8_SA
#undef PG8_SB
#undef PG8_STAGE
#undef PG8_LDA
#undef PG8_LDB
#undef PG8_MMA
#undef PG8_MMA_
#undef PG8_MMA0
#undef PG8_CAT8
#undef PG8_WAIT_V
#undef PG8_WAIT_L
#undef PG8_BAR
#undef PG8_SCHED
#undef PG8_ZERO
#undef PG8_VA
}
}

constexpr int NWAVES = 8;
constexpr int T = 32768, SEQ = 2048, D = 1024, INW = 1792, NEXP = 32, TOPK = 4;
constexpr int COL_K = 512, COL_V = 640, COL_A = 768, COL_G = 1280;
constexpr float RMS_EPS = 1e-5f, LN_EPS = 1e-5f;
constexpr float LOG2E = 1.4426950408889634f;
constexpr float QSCALE = 0.125f * LOG2E;
constexpr int LIST_CAP = 32768;
constexpr int MAX_RB = 544;

constexpr size_t MiB = 1u << 20;
constexpr size_t WS_CTL = 0, CTL_ZERO_BYTES = 16 * 1024;
constexpr size_t WS_WIN = 2 * MiB;
constexpr size_t WS_WOUT = 6 * MiB;
constexpr size_t WS_W1 = 8 * MiB;
constexpr size_t WS_W2 = 136 * MiB;
constexpr size_t WS_XN = 200 * MiB;
constexpr size_t WS_LTOK = 264 * MiB;
constexpr size_t WS_LGATE = 268 * MiB;
constexpr size_t WS_B1P = 272 * MiB;
constexpr size_t WS_RA = 272 * MiB + 512 * 1024;
constexpr size_t WS_WR = 273 * MiB;
constexpr size_t WS_ACT = 274 * MiB;
constexpr size_t WS_PROJ = 546 * MiB;
constexpr size_t WS_MIX = 658 * MiB;
constexpr size_t WS_Y = 546 * MiB;
constexpr size_t WS_XN8 = 674 * MiB;
constexpr size_t WS_END = 802 * MiB;
static_assert(WS_ACT + (size_t)MAX_RB * 256 * 1024 * 2 <= WS_PROJ && WS_MIX + (size_t)T * 1024 * 2 <= WS_END && WS_Y + (size_t)T * 4 * 1024 * 2 <= WS_END, "ws map");
constexpr int CW_BAR = 0;
constexpr int CW_GCNT = 3584;
static_assert((CW_BAR + 3456) * 4 <= (int)CTL_ZERO_BYTES && (CW_GCNT + 32 * 16) * 4 <= (int)CTL_ZERO_BYTES, "control words inside the per-call memset");

constexpr int RING_BYTES = 131072;
constexpr int MISC_OFF = RING_BYTES;
constexpr int TAB_OFF = MISC_OFF + 256;
constexpr int EPI_OFF = RING_BYTES + 2048;
constexpr int P4_G_OFF = EPI_OFF + 8 * 2112;
constexpr int LDS_BYTES = 154624;

#define GAS __attribute__((address_space(1)))
#define LAS __attribute__((address_space(3)))
typedef unsigned short bf16;
typedef unsigned v4u __attribute__((ext_vector_type(4)));
typedef unsigned v2u __attribute__((ext_vector_type(2)));
typedef float f32x4 __attribute__((ext_vector_type(4)));
typedef float f32x2 __attribute__((ext_vector_type(2)));
typedef short bf16x8 __attribute__((ext_vector_type(8)));
typedef short v4i16_t __attribute__((ext_vector_type(4)));
#define LDS_WAIT() asm volatile("s_waitcnt lgkmcnt(0)" ::: "memory")
#define VM_WAIT() asm volatile("s_waitcnt vmcnt(0)" ::: "memory")
__device__ __forceinline__ unsigned pk2(float lo, float hi) { return pg8::cvt_pk_bf16(lo, hi); }
__device__ __forceinline__ unsigned pk4_fp8(float a, float b, float c, float d) { int w = 0; w = __builtin_amdgcn_cvt_pk_fp8_f32(a, b, w, false); w = __builtin_amdgcn_cvt_pk_fp8_f32(c, d, w, true); return (unsigned)w; }
constexpr float W_SCALE = 64.0f, H_SCALE = 8.0f, ACT_SCALE = 4.0f, Y_SCALE = 16.0f;
__device__ __forceinline__ float bf_lo(unsigned w) { return __uint_as_float(w << 16); }
__device__ __forceinline__ float bf_hi(unsigned w) { return __uint_as_float(w & 0xffff0000u); }

#define XB_TMO      128
#define XB_XCNT(j)  (256  + 64 * (j))
#define XB_XSUB(j)  (1280 + 64 * (j))
#define XB_XGEN(j)  (2304 + 64 * (j))
#define XB_TOP      3328
#define XB_TOPGEN   3392
#define XCD_BAR_WORDS 3456
#define XB_SPIN_CAP (1u << 18)

__device__ __forceinline__ unsigned xb_ld(unsigned* p)              { return __hip_atomic_load(p, __ATOMIC_RELAXED, __HIP_MEMORY_SCOPE_AGENT); }
__device__ __forceinline__ unsigned xb_add(unsigned* p, unsigned v) { return __hip_atomic_fetch_add(p, v, __ATOMIC_RELAXED, __HIP_MEMORY_SCOPE_AGENT); }
__device__ __forceinline__ unsigned xb_xcc_id() { return (unsigned)__builtin_amdgcn_s_getreg((3 << 11) | 20) & 0xFu; }
#define XB_SPIN(cond, bar) do { unsigned _sp = 0; while (cond) { __builtin_amdgcn_s_sleep(1); \
    if ((++_sp & 255u) == 0u) { if (xb_ld(&(bar)[XB_TMO])) break; if (_sp > XB_SPIN_CAP) { atomicAdd(&(bar)[XB_TMO], 1u); break; } } } } while (0)

struct XcdBarrier { unsigned* bar; unsigned x; volatile LAS unsigned* st; };

__device__ __forceinline__ XcdBarrier xcd_barrier_post(unsigned* bar, volatile LAS unsigned* st) {
    XcdBarrier b; b.bar = bar; b.x = xb_xcc_id(); b.st = st;
    if (threadIdx.x == 0) (void)xb_add(&bar[XB_XCNT(b.x)], 1u);
    return b;
}
__device__ __forceinline__ void xcd_barrier_complete(unsigned* bar, unsigned x, unsigned& nloc, unsigned& nx) {
    const unsigned G = gridDim.x * gridDim.y * gridDim.z;
    unsigned sum, cnt, mine, sp = 0u;
    for (;;) {
        sum = 0u; cnt = 0u; mine = 0u;
#pragma unroll
        for (unsigned j = 0; j < 16; ++j) { const unsigned c = xb_ld(&bar[XB_XCNT(j)]); sum += c; cnt += (c > 0u) ? 1u : 0u; mine = (j == x) ? c : mine; }
        if (sum == G) break;
        __builtin_amdgcn_s_sleep(1);
        if ((++sp & 255u) == 0u) { if (xb_ld(&bar[XB_TMO])) break; if (sp > XB_SPIN_CAP) { atomicAdd(&bar[XB_TMO], 1u); break; } }
    }
    nloc = mine > 0u ? mine : 1u; nx = cnt > 0u ? cnt : 1u;
}
__device__ __forceinline__ void xcd_barrier(const XcdBarrier& b) {
    asm volatile("s_waitcnt vmcnt(0)" ::: "memory");
    __syncthreads();
    if (threadIdx.x == 0) {
        unsigned* bar = b.bar;
        __builtin_amdgcn_s_waitcnt(0);
        unsigned nloc = b.st[0], nx = b.st[1];
        if (nloc == 0u) { xcd_barrier_complete(bar, b.x, nloc, nx); b.st[0] = nloc; b.st[1] = nx; }
        const unsigned old = xb_add(&bar[XB_XSUB(b.x)], 1u);
        const unsigned gen = old / nloc;
        if (old + 1u == (gen + 1u) * nloc) {
            __builtin_amdgcn_fence(__ATOMIC_RELEASE, "agent");
            asm volatile("s_waitcnt vmcnt(0)" ::: "memory");
            const unsigned og = xb_add(&bar[XB_TOP], 1u);
            const unsigned tg = og / nx;
            if (og + 1u == (tg + 1u) * nx) xb_add(&bar[XB_TOPGEN], 1u);
            else XB_SPIN(xb_ld(&bar[XB_TOPGEN]) == tg, bar);
            __builtin_amdgcn_fence(__ATOMIC_ACQUIRE, "agent");
            xb_add(&bar[XB_XGEN(b.x)], 1u);
            asm volatile("s_waitcnt vmcnt(0)" ::: "memory");
        } else {
            XB_SPIN(xb_ld(&bar[XB_XGEN(b.x)]) == gen, bar);
            __builtin_amdgcn_fence(__ATOMIC_ACQUIRE, "agent");
            asm volatile("s_waitcnt vmcnt(0)" ::: "memory");
        }
    }
    __syncthreads();
}

template <int CTRL, int RMASK> __device__ __forceinline__ float dpp_add(float v) { return v + __builtin_bit_cast(float, __builtin_amdgcn_update_dpp(0, __builtin_bit_cast(int, v), CTRL, RMASK, 0xf, false)); }
__device__ __forceinline__ float wave_sum_dpp(float v) {
    v = dpp_add<0xB1, 0xf>(v); v = dpp_add<0x4E, 0xf>(v); v = dpp_add<0x141, 0xf>(v); v = dpp_add<0x140, 0xf>(v);
    v = dpp_add<0x142, 0xa>(v); v = dpp_add<0x143, 0xc>(v);
    return __builtin_bit_cast(float, __builtin_amdgcn_readlane(__builtin_bit_cast(int, v), 63));
}
__device__ __forceinline__ float wave_sum(float v) {
#pragma unroll
    for (int o = 1; o < 64; o <<= 1) v += __shfl_xor(v, o);
    return v;
}

struct DenseSched {
    static constexpr bool GATHER = false;
    const char* Bt; int nM, nN, G, c, rp, ibeg, iend;
    __device__ __forceinline__ size_t a_base(const pg8::Unit& u) const { return (size_t)u.pm * 256 * (size_t)rp; }
    __device__ __forceinline__ bool next(int i, pg8::Unit& u) const { u.e = 0; u.rb = 0; u.cnt = 0; if (i + ibeg >= iend) return false; return pg8::static_order(i + ibeg, G, c, nM, nN, u.pm, u.pn); }
    __device__ __forceinline__ const char* b_tile(const pg8::Unit& u) const { return Bt + (size_t)u.pn * 256 * rp; }
    __device__ __forceinline__ unsigned a_off(const pg8::Unit&, int r) const { return (unsigned)r * (unsigned)rp; }
    __device__ __forceinline__ int a_raw(const pg8::Unit&, int) const { return 0; }
    __device__ __forceinline__ unsigned a_fin(const pg8::Unit&, int r, int) const { return (unsigned)r * (unsigned)rp; }
};
template <bool GATHER_> struct MoeSched {
    static constexpr bool GATHER = GATHER_;
    const char* Bt; size_t bexp;
    const int* ltok; const LAS int* rbs; const LAS int* cnt; int nM, nN, G, c, rp;
    __device__ __forceinline__ size_t a_base(const pg8::Unit& u) const { return GATHER_ ? (size_t)0 : (size_t)u.pm * 256 * (size_t)rp; }
    __device__ __forceinline__ bool next(int i, pg8::Unit& u) const {
        if (!pg8::static_order(i, G, c, nM, nN, u.pm, u.pn)) return false;
        const int lane = threadIdx.x & 63;
        const int v = (lane < 32) ? rbs[lane + 1] : 0x7fffffff;
        const unsigned long long m = __ballot(v <= u.pm);
        const int e = __builtin_amdgcn_readfirstlane((int)__popcll(m));
        u.e = e; u.rb = u.pm - __builtin_amdgcn_readfirstlane(rbs[e]); u.cnt = __builtin_amdgcn_readfirstlane(cnt[e]);
        return true;
    }
    __device__ __forceinline__ const char* b_tile(const pg8::Unit& u) const { return Bt + (size_t)u.e * bexp + (size_t)u.pn * 256 * rp; }
    __device__ __forceinline__ unsigned a_off(const pg8::Unit& u, int r) const {
        return a_fin(u, r, a_raw(u, r));
    }
    __device__ __forceinline__ int a_raw(const pg8::Unit& u, int r) const { if constexpr (GATHER_) return ltok[u.e * LIST_CAP + u.rb * 256 + r]; else return 0; }
    __device__ __forceinline__ void gather_dma(const pg8::Unit& u, LAS unsigned char* dst, int wid, int lane) const {
        if (wid < 4) __builtin_amdgcn_global_load_lds((const unsigned*)(ltok + (size_t)u.e * LIST_CAP + u.rb * 256 + wid * 64 + lane), (LAS unsigned*)(dst + wid * 256), 4, 0, 0); }
    __device__ __forceinline__ unsigned a_fin(const pg8::Unit& u, int r, int raw) const {
        if constexpr (GATHER_) { const int t4 = (u.rb * 256 + r < u.cnt) ? raw : 0; return (unsigned)(t4 >> 2) * (unsigned)rp; }
        else return (unsigned)r * (unsigned)rp;
    }
};

__device__ __forceinline__ void side_dma(const void* src_lane, LAS unsigned char* dst_wave) { __builtin_amdgcn_global_load_lds((const unsigned*)src_lane, (LAS unsigned*)dst_wave, 4, 0, 0); }

struct EpiProj {
    static constexpr bool PERM = true, MIDSCALE = false;
    bf16* O; const float* bias; const float* rowscale;
    __device__ __forceinline__ void side(const pg8::Unit& u, LAS unsigned char* area, int wid, int lane) const {
        if (wid < 4) side_dma(bias + u.pn * 256 + wid * 64 + lane, area + wid * 256);
        else side_dma(rowscale + u.pm * 256 + (wid - 4) * 64 + lane, area + 1024 + (wid - 4) * 256); }
    __device__ __forceinline__ void operator()(const f32x4 (&acc)[2][2][4][2], const pg8::Unit& u, int wr, int wc, int fr, int fq, const LAS unsigned char* area) const {
        const int row0 = u.pm * 256 + wr * 64 + fr, col0 = u.pn * 256 + wc * 32 + 8 * fq;
        const float sc = (u.pn < 2) ? QSCALE : 1.0f;
        f32x4 bv[2][2];
#pragma unroll
        for (int bj = 0; bj < 2; ++bj)
#pragma unroll
            for (int n = 0; n < 2; ++n) bv[bj][n] = *(const LAS f32x4*)(area + 4 * (wc * 32 + 8 * fq + bj * 128 + 4 * n));
#pragma unroll
        for (int ai = 0; ai < 2; ++ai)
#pragma unroll
            for (int m = 0; m < 4; ++m) { bf16* rowp = O + (size_t)(row0 + ai * 128 + m * 16) * INW + col0;
                const float rs = *(const LAS float*)(area + 1024 + 4 * (ai * 128 + wr * 64 + m * 16 + fr));
#pragma unroll
                for (int bj = 0; bj < 2; ++bj) { const f32x4 v0 = (acc[ai][bj][m][0] * rs + bv[bj][0]) * sc, v1 = (acc[ai][bj][m][1] * rs + bv[bj][1]) * sc;
                    v4u w; w.x = pk2(v0[0], v0[1]); w.y = pk2(v0[2], v0[3]); w.z = pk2(v1[0], v1[1]); w.w = pk2(v1[2], v1[3]);
                    *(v4u*)(rowp + bj * 128) = w; } }
    }
};
struct EpiRes {
    static constexpr bool PERM = true, MIDSCALE = true;
    const bf16* base; bf16* out; const float* bias; const float* rowscale;
    __device__ __forceinline__ void side(const pg8::Unit& u, LAS unsigned char* area, int wid, int lane) const {
        if (wid < 4) side_dma(bias + u.pn * 256 + wid * 64 + lane, area + wid * 256);
        else side_dma(rowscale + u.pm * 256 + (wid - 4) * 64 + lane, area + 1024 + (wid - 4) * 256); }
    __device__ __forceinline__ void operator()(const f32x4 (&acc)[2][2][4][2], const pg8::Unit& u, int wr, int wc, int fr, int fq, const LAS unsigned char* area) const {
        const int col0 = u.pn * 256 + wc * 32 + 8 * fq;
        f32x4 bv[2][2];
#pragma unroll
        for (int bj = 0; bj < 2; ++bj)
#pragma unroll
            for (int n = 0; n < 2; ++n) bv[bj][n] = *(const LAS f32x4*)(area + 4 * (wc * 32 + 8 * fq + bj * 128 + 4 * n));
#pragma unroll
        for (int ai = 0; ai < 2; ++ai) {
            v4u xr[4][2];
#pragma unroll
            for (int m = 0; m < 4; ++m) { const size_t off = (size_t)(u.pm * 256 + ai * 128 + wr * 64 + m * 16 + fr) * D + col0;
#pragma unroll
                for (int bj = 0; bj < 2; ++bj) xr[m][bj] = *(const v4u*)(base + off + bj * 128); }
            __builtin_amdgcn_sched_barrier(0);
#pragma unroll
            for (int m = 0; m < 4; ++m) { const size_t off = (size_t)(u.pm * 256 + ai * 128 + wr * 64 + m * 16 + fr) * D + col0;
#pragma unroll
                for (int bj = 0; bj < 2; ++bj) { const v4u xw = xr[m][bj];
                    const f32x4 v0 = (f32x4){bf_lo(xw.x), bf_hi(xw.x), bf_lo(xw.y), bf_hi(xw.y)} + acc[ai][bj][m][0] + bv[bj][0], v1 = (f32x4){bf_lo(xw.z), bf_hi(xw.z), bf_lo(xw.w), bf_hi(xw.w)} + acc[ai][bj][m][1] + bv[bj][1];
                    v4u w; w.x = pk2(v0[0], v0[1]); w.y = pk2(v0[2], v0[3]); w.z = pk2(v1[0], v1[1]); w.w = pk2(v1[2], v1[3]);
                    *(v4u*)(out + off + bj * 128) = w; } }
        }
    }
};
struct EpiSwiglu {
    static constexpr bool PERM = true, MIDSCALE = false;
    unsigned char* O; const float* b1p;
    __device__ __forceinline__ void side(const pg8::Unit& u, LAS unsigned char* area, int wid, int lane) const { if (wid < 4) side_dma(b1p + (size_t)u.e * 2048 + u.pn * 256 + wid * 64 + lane, area + wid * 256); }
    __device__ __forceinline__ void operator()(const f32x4 (&acc)[2][2][4][2], const pg8::Unit& u, int wr, int wc, int fr, int fq, const LAS unsigned char* area) const {
        const int row0 = u.pm * 256 + wr * 64 + fr, ocol0 = u.pn * 128 + wc * 32 + 8 * fq;
        f32x4 bg[2], bl[2];
#pragma unroll
        for (int n = 0; n < 2; ++n) { bg[n] = *(const LAS f32x4*)(area + 4 * (wc * 32 + 8 * fq + 4 * n)); bl[n] = *(const LAS f32x4*)(area + 4 * (128 + wc * 32 + 8 * fq + 4 * n)); }
        constexpr float SI = 1.0f / (H_SCALE * W_SCALE);
#pragma unroll
        for (int ai = 0; ai < 2; ++ai)
#pragma unroll
            for (int m = 0; m < 4; ++m) { unsigned char* rowp = O + (size_t)(row0 + ai * 128 + m * 16) * 1024 + ocol0;
                f32x2 a[4];
#pragma unroll
                for (int n = 0; n < 2; ++n)
#pragma unroll
                    for (int p = 0; p < 2; ++p) {
                        const f32x2 gv = (f32x2){acc[ai][0][m][n][2 * p], acc[ai][0][m][n][2 * p + 1]} * SI + (f32x2){bg[n][2 * p], bg[n][2 * p + 1]};
                        const f32x2 lv = (f32x2){acc[ai][1][m][n][2 * p], acc[ai][1][m][n][2 * p + 1]} * SI + (f32x2){bl[n][2 * p], bl[n][2 * p + 1]};
                        const f32x2 gg = (f32x2){fminf(gv.x, 7.0f), fminf(gv.y, 7.0f)};
                        const f32x2 ll = (f32x2){__builtin_amdgcn_fmed3f(lv.x, -7.0f, 7.0f), __builtin_amdgcn_fmed3f(lv.y, -7.0f, 7.0f)};
                        const f32x2 z = gg * (-1.702f * LOG2E);
                        const f32x2 d = (f32x2){__builtin_amdgcn_exp2f(z.x), __builtin_amdgcn_exp2f(z.y)} + 1.0f;
                        const f32x2 r = (f32x2){__builtin_amdgcn_rcpf(d.x), __builtin_amdgcn_rcpf(d.y)};
                        a[2 * n + p] = (gg * r) * (ll * ACT_SCALE + ACT_SCALE); }
                v2u w; w.x = pk4_fp8(a[0].x, a[0].y, a[1].x, a[1].y); w.y = pk4_fp8(a[2].x, a[2].y, a[3].x, a[3].y);
                *(v2u*)rowp = w; }
    }
};
struct EpiMoeOut {
    static constexpr bool PERM = true, MIDSCALE = false;
    unsigned char* Y; const float* b2; const int* ltok; const float* lgate;
    __device__ __forceinline__ void side(const pg8::Unit& u, LAS unsigned char* area, int wid, int lane) const {
        if (wid < 4) { side_dma(b2 + (size_t)u.e * 1024 + u.pn * 256 + wid * 64 + lane, area + wid * 256); side_dma(ltok + (size_t)u.e * LIST_CAP + u.rb * 256 + wid * 64 + lane, area + 1024 + wid * 256); }
        else side_dma(lgate + (size_t)u.e * LIST_CAP + u.rb * 256 + (wid - 4) * 64 + lane, area + 2048 + (wid - 4) * 256); }
    __device__ __forceinline__ void operator()(const f32x4 (&acc)[2][2][4][2], const pg8::Unit& u, int wr, int wc, int fr, int fq, const LAS unsigned char* area) const {
        const int col0 = u.pn * 256 + wc * 32 + 8 * fq;
        f32x4 bv[2][2];
#pragma unroll
        for (int bj = 0; bj < 2; ++bj)
#pragma unroll
            for (int n = 0; n < 2; ++n) bv[bj][n] = *(const LAS f32x4*)(area + 4 * (wc * 32 + 8 * fq + bj * 128 + 4 * n));
#pragma unroll
        for (int ai = 0; ai < 2; ++ai)
#pragma unroll
            for (int m = 0; m < 4; ++m) { const int r = ai * 128 + wr * 64 + m * 16 + fr, pos = u.rb * 256 + r;
                const int t4 = *(const LAS int*)(area + 1024 + 4 * r); const float gt = *(const LAS float*)(area + 2048 + 4 * r) * Y_SCALE;
                if (pos < u.cnt) {
                    unsigned char* rowp = Y + (size_t)t4 * 1024 + col0;
#pragma unroll
                    for (int bj = 0; bj < 2; ++bj) { const f32x4 v0 = (acc[ai][bj][m][0] * (1.0f / (ACT_SCALE * W_SCALE)) + bv[bj][0]) * gt, v1 = (acc[ai][bj][m][1] * (1.0f / (ACT_SCALE * W_SCALE)) + bv[bj][1]) * gt;
                        v2u w; w.x = pk4_fp8(v0[0], v0[1], v0[2], v0[3]); w.y = pk4_fp8(v1[0], v1[1], v1[2], v1[3]);
                        *(v2u*)(rowp + bj * 128) = w; } } }
    }
};

template <int ESZ, int MODE  >
__device__ __forceinline__ void p0_item(const float* W, int N, unsigned char* WT, size_t rowpitch, LAS unsigned* scr, int kb, int nb, int lane, float scale, const float* kscale = nullptr, const float* kscale_hi = nullptr) {
    constexpr int KT = (ESZ == 2) ? 64 : 128, NT = (ESZ == 2) ? 64 : 32, LPR = NT / 4;
    const int k0 = KT * kb, n0 = NT * nb, lg = lane / LPR, nc = lane % LPR;
    const float* src = W + (size_t)(k0 + 16 * lg) * N + n0 + 4 * nc;
    f32x4 v[16];
#pragma unroll
    for (int i = 0; i < 16; ++i) v[i] = *(const f32x4*)(src + (size_t)i * N);
    if (kscale) {
#pragma unroll
        for (int i = 0; i < 16; ++i) { const int k = k0 + 16 * lg + i; v[i] = v[i] * ((kscale_hi && k >= 512) ? kscale_hi[k - 512] : kscale[k]); } }
#pragma unroll
    for (int e = 0; e < 4; ++e) {
        LAS unsigned* row = scr + (4 * nc + e) * 36;
        if (ESZ == 2) {
            v4u a, b;
            a.x = pk2(v[0][e] * scale, v[1][e] * scale); a.y = pk2(v[2][e] * scale, v[3][e] * scale); a.z = pk2(v[4][e] * scale, v[5][e] * scale); a.w = pk2(v[6][e] * scale, v[7][e] * scale);
            b.x = pk2(v[8][e] * scale, v[9][e] * scale); b.y = pk2(v[10][e] * scale, v[11][e] * scale); b.z = pk2(v[12][e] * scale, v[13][e] * scale); b.w = pk2(v[14][e] * scale, v[15][e] * scale);
            *(LAS v4u*)(row + 8 * lg) = a; *(LAS v4u*)(row + 8 * lg + 4) = b;
        } else {
            v4u a;
            a.x = pk4_fp8(v[0][e] * scale, v[1][e] * scale, v[2][e] * scale, v[3][e] * scale); a.y = pk4_fp8(v[4][e] * scale, v[5][e] * scale, v[6][e] * scale, v[7][e] * scale);
            a.z = pk4_fp8(v[8][e] * scale, v[9][e] * scale, v[10][e] * scale, v[11][e] * scale); a.w = pk4_fp8(v[12][e] * scale, v[13][e] * scale, v[14][e] * scale, v[15][e] * scale);
            *(LAS v4u*)(row + 4 * lg) = a;
        }
    }
    LDS_WAIT(); asm volatile("" ::: "memory");
    const int c = lane & 7;
#pragma unroll
    for (int j = 0; j < NT / 8; ++j) { const int n = (lane >> 3) + 8 * j; const v4u o = *(const LAS v4u*)(scr + n * 36 + 4 * c);
        const int col = n0 + n; const int row = (MODE == 1) ? ((col & ~255) + 128 * (col & 1) + ((col >> 1) & 127)) : col;
        *(GAS v4u*)(WT + (size_t)row * rowpitch + (size_t)k0 * ESZ + 16 * c) = o; }
    LDS_WAIT(); asm volatile("" ::: "memory");
}

struct W8Item { const float* src; unsigned char* dst; int N, k0, n0, mode; };
__device__ __forceinline__ W8Item w8_item(int r, const float* w1, const float* w2, unsigned char* W1_t, unsigned char* W2_t) {
    W8Item it;
    if (r < 32 * 8 * 64) { const int e = r >> 9, q = r & 511; it.src = w1 + (size_t)e * 1024 * 2048; it.dst = W1_t + (size_t)e * 2048 * 1024; it.N = 2048; it.k0 = 128 * (q >> 6); it.n0 = 32 * (q & 63); it.mode = 1; }
    else { r -= 32 * 8 * 64; const int e = r >> 8, q = r & 255; it.src = w2 + (size_t)e * 1024 * 1024; it.dst = W2_t + (size_t)e * 1024 * 1024; it.N = 1024; it.k0 = 128 * (q >> 5); it.n0 = 32 * (q & 31); it.mode = 0; }
    return it;
}
__device__ __forceinline__ void w8_load(const W8Item& it, f32x4 (&v)[16], int lane) {
    const float* src = it.src + (size_t)(it.k0 + 16 * (lane >> 3)) * it.N + it.n0 + 4 * (lane & 7);
#pragma unroll
    for (int i = 0; i < 16; ++i) v[i] = __builtin_nontemporal_load((const f32x4*)(src + (size_t)i * it.N));
}
__device__ __forceinline__ void w8_store(const W8Item& it, const f32x4 (&v)[16], LAS unsigned* scr, int lane) {
    const int lg = lane >> 3, nc = lane & 7;
#pragma unroll
    for (int e = 0; e < 4; ++e) { v4u a;
        a.x = pk4_fp8(v[0][e] * W_SCALE, v[1][e] * W_SCALE, v[2][e] * W_SCALE, v[3][e] * W_SCALE); a.y = pk4_fp8(v[4][e] * W_SCALE, v[5][e] * W_SCALE, v[6][e] * W_SCALE, v[7][e] * W_SCALE);
        a.z = pk4_fp8(v[8][e] * W_SCALE, v[9][e] * W_SCALE, v[10][e] * W_SCALE, v[11][e] * W_SCALE); a.w = pk4_fp8(v[12][e] * W_SCALE, v[13][e] * W_SCALE, v[14][e] * W_SCALE, v[15][e] * W_SCALE);
        *(LAS v4u*)(scr + (4 * nc + e) * 36 + 4 * lg) = a; }
    LDS_WAIT(); asm volatile("" ::: "memory");
    const int c = lane & 7;
#pragma unroll
    for (int j = 0; j < 4; ++j) { const int n = (lane >> 3) + 8 * j; const v4u o = *(const LAS v4u*)(scr + n * 36 + 4 * c);
        const int col = it.n0 + n; const int row = it.mode ? ((col & ~255) + 128 * (col & 1) + ((col >> 1) & 127)) : col;
        *(GAS v4u*)(it.dst + (size_t)row * 1024 + it.k0 + 16 * c) = o; }
    LDS_WAIT(); asm volatile("" ::: "memory");
}

struct Args { const float* in[21]; float* out; unsigned char* ws; };

__global__ void __launch_bounds__(NWAVES * 64, 2) hymba_fwd(Args args) {
    extern __shared__ __attribute__((aligned(16))) unsigned char lds_raw[];
    LAS unsigned char* lds = (LAS unsigned char*)lds_raw;
    volatile LAS unsigned* MISC = (volatile LAS unsigned*)(lds + MISC_OFF);
    LAS int* TAB = (LAS int*)(lds + TAB_OFF);
    LAS int* t_rbs = TAB; LAS int* t_cnt = TAB + 40; LAS int* t_lcnt = TAB + 72; LAS int* t_gbase = TAB + 104;
#define PHASE_IDS() int tid = threadIdx.x; asm volatile("" : "+v"(tid)); const int lane = tid & 63, wave = __builtin_amdgcn_readfirstlane(tid >> 6); (void)lane; (void)wave
    const int G = gridDim.x;
    const int vcu = (G % 8 == 0) ? ((int)blockIdx.x % 8) * (G / 8) + (int)blockIdx.x / 8 : (int)blockIdx.x;

    const float* x = args.in[0]; const float* g_mix = args.in[1]; const float* w_in = args.in[2]; const float* b_in = args.in[3];
    const float* sinks = args.in[4]; const float* w_dw = args.in[5]; const float* b_dw = args.in[6]; const float* ln_g = args.in[7]; const float* ln_b = args.in[8];
    const float* g_attn = args.in[9]; const float* g_conv = args.in[10]; const float* w_out = args.in[11]; const float* b_out = args.in[12];
    const float* g_ffn = args.in[13]; const float* w_router = args.in[14]; const float* b_router = args.in[15];
    const float* w1 = args.in[16]; const float* b1 = args.in[17]; const float* w2 = args.in[18]; const float* b2 = args.in[19]; const float* g_final = args.in[20];
    float* out = args.out; unsigned char* ws = args.ws;
    unsigned* ctl = (unsigned*)(ws + WS_CTL);
    bf16* Win_t = (bf16*)(ws + WS_WIN); bf16* Wout_t = (bf16*)(ws + WS_WOUT); unsigned char* W1_t = ws + WS_W1; unsigned char* W2_t = ws + WS_W2; unsigned char* XN8 = ws + WS_XN8; bf16* X1B = (bf16*)(ws + WS_XN);
    bf16* XN = (bf16*)(ws + WS_XN); int* ltok = (int*)(ws + WS_LTOK); float* lgate = (float*)(ws + WS_LGATE); float* b1p = (float*)(ws + WS_B1P);
    float* RA = (float*)(ws + WS_RA); float* RS = RA + T; bf16* WrHi = (bf16*)(ws + WS_WR); bf16* WrLo = WrHi + 32 * 1024;
    unsigned char* ACT = ws + WS_ACT; bf16* PROJ = (bf16*)(ws + WS_PROJ); bf16* MIX = (bf16*)(ws + WS_MIX); unsigned char* YB = ws + WS_Y;
    unsigned* gcnt = ctl + CW_GCNT;

    for (int u = threadIdx.x; u < (LDS_BYTES - MISC_OFF) / 4; u += NWAVES * 64) ((LAS unsigned*)(lds + MISC_OFF))[u] = 0u;
    __syncthreads();
    XcdBarrier bar = xcd_barrier_post(ctl + CW_BAR, MISC + 8);

    {
        PHASE_IDS();
        LAS unsigned* scr = (LAS unsigned*)(lds + wave * 16384);
        const int gw = vcu * NWAVES + wave, NGW = G * NWAVES;
        constexpr int I_IN = 16 * 28, I_OUT = 16 * 16;
        for (int it = gw; it < I_IN + I_OUT; it += NGW) {
            int r = it;
            if (r < I_IN) { p0_item<2, 0>(w_in, INW, (unsigned char*)Win_t, 2048, scr, r / 28, r % 28, lane, 1.0f, g_mix); continue; } r -= I_IN;
            p0_item<2, 0>(w_out, 1024, (unsigned char*)Wout_t, 2048, scr, r >> 4, r & 15, lane, 1.0f, g_attn, g_conv);
        }
        for (int m = 2 * gw; m < T; m += 2 * NGW) {
            const GAS f32x4* xr = (const GAS f32x4*)(x + (size_t)m * D) + lane;
            f32x4 v[2][4]; float s[2] = {0.f, 0.f};
#pragma unroll
            for (int q = 0; q < 2; ++q)
#pragma unroll
                for (int j = 0; j < 4; ++j) v[q][j] = __builtin_nontemporal_load(xr + q * 256 + 64 * j);
#pragma unroll
            for (int q = 0; q < 2; ++q)
#pragma unroll
                for (int j = 0; j < 4; ++j) s[q] += (v[q][j].x * v[q][j].x + v[q][j].y * v[q][j].y) + (v[q][j].z * v[q][j].z + v[q][j].w * v[q][j].w);
#pragma unroll
            for (int q = 0; q < 2; ++q) {
                const float rstd = 1.0f / sqrtf(wave_sum(s[q]) * (1.0f / D) + RMS_EPS);
                if (lane == 0) RS[m + q] = rstd;
                GAS v2u* o8 = (GAS v2u*)(XN + (size_t)(m + q) * D) + lane;
#pragma unroll
                for (int j = 0; j < 4; ++j) { v2u o; o.x = pk2(v[q][j].x, v[q][j].y); o.y = pk2(v[q][j].z, v[q][j].w); o8[64 * j] = o; }
            }
        }
        const int gt = vcu * (NWAVES * 64) + tid, NGT = G * NWAVES * 64;
        for (int i = gt; i < 32 * 2048; i += NGT) { const int e = i >> 11, col = i & 2047; const int row = (col & ~255) + 128 * (col & 1) + ((col >> 1) & 127); b1p[e * 2048 + row] = b1[i]; }
        for (int i = gt; i < 32 * 1024; i += NGT) { const int e = i >> 10, k = i & 1023; const float v = w_router[k * 32 + e];
            const unsigned h = pk2(v, 0.f) & 0xffffu; const float lo = v - __uint_as_float(h << 16);
            const int fi = ((((e >> 4) * 32 + (k >> 5)) * 64 + 16 * ((k >> 3) & 3) + (e & 15)) * 8) + (k & 7);
            WrHi[fi] = (bf16)h; WrLo[fi] = (bf16)(pk2(lo, 0.f) & 0xffffu); }
    }
    xcd_barrier(bar);

    {
        const int grp = ((int)blockIdx.x >> 3) & 3;
        EpiProj E{PROJ, b_in, RS};
        {
            DenseSched S{(const char*)Win_t, T / 256, INW / 256, G, (int)blockIdx.x, 2048, 0, grp};
            pg8::gemm_phase<EpiProj, DenseSched, false>(lds, lds + EPI_OFF, (const char*)XN, 2048, S, E);
        }
        {
            PHASE_IDS();
            __syncthreads();
            LAS unsigned* scr = (LAS unsigned*)(lds + wave * 16384);
            const int gw = vcu * NWAVES + wave, NGW = G * NWAVES;
            constexpr int NIT_ALL = 32 * 8 * 64;
            int it = gw, NIT = NIT_ALL, NGW_ = NGW;
            if (G == 256) { const int c = (int)blockIdx.x; NGW_ = 1024;
                if (c >= 128) { it = (c - 128) * NWAVES + wave; NIT = 10240; } else { it = 10240 + c * NWAVES + wave; NIT = NIT_ALL; } }
            f32x4 va[16], vb[16];
            W8Item ia = w8_item(it < NIT ? it : 0, w1, w2, W1_t, W2_t), ib = ia;
            if (it < NIT) w8_load(ia, va, lane);
            while (it < NIT) {
                const int itb = it + NGW_;
                if (itb < NIT) { ib = w8_item(itb, w1, w2, W1_t, W2_t); w8_load(ib, vb, lane); }
                w8_store(ia, va, scr, lane);
                if (itb >= NIT) break;
                const int ita = itb + NGW_;
                if (ita < NIT) { ia = w8_item(ita, w1, w2, W1_t, W2_t); w8_load(ia, va, lane); }
                w8_store(ib, vb, scr, lane);
                it = ita;
            }
            __syncthreads();
        }
        {
            DenseSched S{(const char*)Win_t, T / 256, INW / 256, G, (int)blockIdx.x, 2048, grp, 1 << 30};
            pg8::gemm_phase<EpiProj, DenseSched, false>(lds, lds + EPI_OFF, (const char*)XN, 2048, S, E);
        }
    }
    xcd_barrier(bar);

    for (int unit = blockIdx.x; unit < T / 128; unit += G) {
        const int b = unit >> 4, n = unit & 15, t0 = b * SEQ + n * 128;
        {
            PHASE_IDS();
            constexpr int KOFF = 0, VOFF = 36864;
            const int i16 = lane & 15, g = lane >> 4;
            const int vq = i16 >> 2, vp = i16 & 3;
            float ssq = 0.f;
            const bf16* qrow = PROJ + (size_t)(t0 + 16 * wave + i16) * INW + 8 * g;
            bf16* orow = MIX + (size_t)(t0 + 16 * wave + i16) * D + 4 * g;
            bf16x8 q0n = *(const bf16x8*)qrow, q1n = *(const bf16x8*)(qrow + 32);
            v4u kpre[4], vpre[4];
#define KV_LOAD(kvh) do { _Pragma("unroll") for (int c4 = 0; c4 < 4; ++c4) { const int c = tid + 512 * c4, row = c >> 3, ch = c & 7; kpre[c4] = (v4u){0u, 0u, 0u, 0u}; vpre[c4] = kpre[c4]; \
                if (n > 0 || row >= 128) { const bf16* p = PROJ + (size_t)(t0 - 128 + row) * INW + (kvh) * 64 + ch * 8; kpre[c4] = *(const v4u*)(p + COL_K); vpre[c4] = *(const v4u*)(p + COL_V); } } } while (0)
#define KV_WRITE() do { _Pragma("unroll") for (int c4 = 0; c4 < 4; ++c4) { const int c = tid + 512 * c4, row = c >> 3, ch = c & 7; \
                *(LAS v4u*)(lds + KOFF + row * 144 + ch * 16) = kpre[c4]; *(LAS v4u*)(lds + VOFF + row * 144 + ch * 16) = vpre[c4]; } } while (0)
            KV_LOAD(0);
            __syncthreads();
            KV_WRITE();
            KV_LOAD(1);
            __syncthreads();
            for (int h = 0; h < 8; ++h) {
                if (h == 4) { __syncthreads(); KV_WRITE(); __syncthreads(); }
                const bf16x8 q0 = q0n, q1 = q1n;
                if (h < 7) { q0n = *(const bf16x8*)(qrow + (h + 1) * 64); q1n = *(const bf16x8*)(qrow + (h + 1) * 64 + 32); }
                f32x4 st[9];
#pragma unroll
                for (int j = 0; j < 9; ++j) { const LAS unsigned char* kp = lds + KOFF + (16 * (wave + j) + i16) * 144 + 16 * g;
                    const bf16x8 k0 = *(const LAS bf16x8*)kp, k1 = *(const LAS bf16x8*)(kp + 64);
                    st[j] = __builtin_amdgcn_mfma_f32_16x16x32_bf16(k0, q0, (f32x4){0.f, 0.f, 0.f, 0.f}, 0, 0, 0);
                    st[j] = __builtin_amdgcn_mfma_f32_16x16x32_bf16(k1, q1, st[j], 0, 0, 0); }
                const float NEG = -INFINITY;
#pragma unroll
                for (int j = 0; j < 9; ++j) { const bool dead = (n == 0) && (wave + j < 8);
#pragma unroll
                    for (int r = 0; r < 4; ++r) { const int kr = 4 * g + r; bool ok = !dead; if (j == 0) ok = ok && (kr > i16); if (j == 8) ok = ok && (kr <= i16); if (!ok) st[j][r] = NEG; } }
                const float sink2 = sinks[h] * LOG2E;
                float mx = sink2;
#pragma unroll
                for (int j = 0; j < 9; ++j) mx = fmaxf(fmaxf(mx, fmaxf(st[j][0], st[j][1])), fmaxf(st[j][2], st[j][3]));
                mx = fmaxf(mx, __shfl_xor(mx, 16)); mx = fmaxf(mx, __shfl_xor(mx, 32));
                float ls = 0.f;
#pragma unroll
                for (int j = 0; j < 9; ++j)
#pragma unroll
                    for (int r = 0; r < 4; ++r) { st[j][r] = __builtin_amdgcn_exp2f(st[j][r] - mx); ls += st[j][r]; }
                ls += __shfl_xor(ls, 16); ls += __shfl_xor(ls, 32);
                ls += __builtin_amdgcn_exp2f(sink2 - mx);
                const float inv = 1.0f / ls;
                bf16x8 pf[5];
#pragma unroll
                for (int kk = 0; kk < 5; ++kk) { v4u w; w.x = pk2(st[2 * kk][0], st[2 * kk][1]); w.y = pk2(st[2 * kk][2], st[2 * kk][3]);
                    if (kk < 4) { w.z = pk2(st[2 * kk + 1][0], st[2 * kk + 1][1]); w.w = pk2(st[2 * kk + 1][2], st[2 * kk + 1][3]); } else { w.z = 0u; w.w = 0u; }
                    pf[kk] = __builtin_bit_cast(bf16x8, w); }
#pragma unroll
                for (int dt = 0; dt < 4; ++dt) { f32x4 o = (f32x4){0.f, 0.f, 0.f, 0.f};
#pragma unroll
                    for (int kk = 0; kk < 5; ++kk) { const int kta = wave + 2 * kk, ktb = (kk < 4) ? wave + 2 * kk + 1 : wave + 8;
                        const LAS unsigned char* pa = lds + VOFF + (16 * kta + 4 * g + vq) * 144 + (16 * dt + 4 * vp) * 2;
                        const LAS unsigned char* pb = lds + VOFF + (16 * ktb + 4 * g + vq) * 144 + (16 * dt + 4 * vp) * 2;
                        const v4i16_t va = __builtin_amdgcn_ds_read_tr16_b64_v4i16((LAS v4i16_t*)pa), vb = __builtin_amdgcn_ds_read_tr16_b64_v4i16((LAS v4i16_t*)pb);
                        const bf16x8 vf = (bf16x8){va[0], va[1], va[2], va[3], vb[0], vb[1], vb[2], vb[3]};
                        o = __builtin_amdgcn_mfma_f32_16x16x32_bf16(vf, pf[kk], o, 0, 0, 0); }
                    o = o * inv; ssq += (o[0] * o[0] + o[1] * o[1]) + (o[2] * o[2] + o[3] * o[3]);
                    v2u w; w.x = pk2(o[0], o[1]); w.y = pk2(o[2], o[3]);
                    *(v2u*)(orow + h * 64 + 16 * dt) = w; }
            }
#undef KV_LOAD
#undef KV_WRITE
            ssq += __shfl_xor(ssq, 16); ssq += __shfl_xor(ssq, 32);
            if (g == 0) RA[t0 + 16 * wave + i16] = 1.0f / sqrtf(ssq * (1.0f / 512.0f) + RMS_EPS);
        }
        __syncthreads();
        {
            PHASE_IDS();
            const int cp = tid & 255, th = tid >> 8, c0 = 2 * cp;
            LAS float* tile = (LAS float*)lds;
            f32x2 wk[31];
#pragma unroll
            for (int j = 0; j < 31; ++j) wk[j] = *(const f32x2*)(w_dw + j * 512 + c0);
            const f32x2 bdw = *(const f32x2*)(b_dw + c0);
            const int s0 = n * 128 + 64 * th;
            const bf16* pbase = PROJ + (size_t)(b * SEQ) * INW + c0;
            f32x2 uu[38];
            unsigned ra_[8], rg_[8];
#define GLU_CVT(aw, gw_, dst) do { const float g0 = bf_lo(gw_), g1 = bf_hi(gw_); \
                dst.x = bf_lo(aw) * __builtin_amdgcn_rcpf(1.0f + __builtin_amdgcn_exp2f(-g0 * LOG2E)); dst.y = bf_hi(aw) * __builtin_amdgcn_rcpf(1.0f + __builtin_amdgcn_exp2f(-g1 * LOG2E)); } while (0)
#pragma unroll
            for (int i = 0; i < 30; ++i) { const int pos = s0 - 30 + i; unsigned aw = 0u, gw_ = 0u;
                if (pos >= 0) { aw = *(const unsigned*)(pbase + (size_t)pos * INW + COL_A); gw_ = *(const unsigned*)(pbase + (size_t)pos * INW + COL_G); }
                GLU_CVT(aw, gw_, uu[i]); }
#pragma unroll
            for (int tt = 0; tt < 8; ++tt) { const int pos = s0 + tt; ra_[tt] = *(const unsigned*)(pbase + (size_t)pos * INW + COL_A); rg_[tt] = *(const unsigned*)(pbase + (size_t)pos * INW + COL_G); }
            LAS float* prm = tile + 16 * 512;
            prm[tid] = ln_g[tid]; prm[512 + tid] = ln_b[tid];
            for (int chunk = 0; chunk < 8; ++chunk) {
#pragma unroll
                for (int tt = 0; tt < 8; ++tt) GLU_CVT(ra_[tt], rg_[tt], uu[30 + tt]);
                if (chunk < 7) {
#pragma unroll
                    for (int tt = 0; tt < 8; ++tt) { const int pos = s0 + 8 * (chunk + 1) + tt; ra_[tt] = *(const unsigned*)(pbase + (size_t)pos * INW + COL_A); rg_[tt] = *(const unsigned*)(pbase + (size_t)pos * INW + COL_G); }
                }
#pragma unroll
                for (int tt = 0; tt < 8; ++tt) { f32x2 a = bdw;
#pragma unroll
                    for (int j = 0; j < 31; ++j) a = a + wk[j] * uu[tt + j];
                    *(LAS f32x2*)(tile + (th * 8 + tt) * 512 + c0) = a; }
#pragma unroll
                for (int i = 0; i < 30; ++i) uu[i] = uu[i + 8];
                LDS_WAIT(); __builtin_amdgcn_s_barrier(); asm volatile("" ::: "memory");
#pragma unroll
                for (int q = 0; q < 2; ++q) { const int row = 2 * wave + q, rth = row >> 3, rtt = row & 7; const int tok = t0 + 64 * rth + 8 * chunk + rtt;
                    const f32x4 a0 = *(const LAS f32x4*)(tile + row * 512 + 8 * lane), a1 = *(const LAS f32x4*)(tile + row * 512 + 8 * lane + 4);
                    float v[8] = {a0[0], a0[1], a0[2], a0[3], a1[0], a1[1], a1[2], a1[3]};
                    float s = 0.f;
#pragma unroll
                    for (int j = 0; j < 8; ++j) s += v[j];
                    const float mean = wave_sum_dpp(s) * (1.0f / 512.0f);
                    float s2 = 0.f;
#pragma unroll
                    for (int j = 0; j < 8; ++j) { v[j] -= mean; s2 += v[j] * v[j]; }
                    const float rstd = 1.0f / sqrtf(wave_sum_dpp(s2) * (1.0f / 512.0f) + LN_EPS);
                    const f32x4 lg0 = *(const LAS f32x4*)(prm + 8 * lane), lg1 = *(const LAS f32x4*)(prm + 8 * lane + 4), lb0 = *(const LAS f32x4*)(prm + 512 + 8 * lane), lb1 = *(const LAS f32x4*)(prm + 512 + 8 * lane + 4);
                    const float lgv[8] = {lg0[0], lg0[1], lg0[2], lg0[3], lg1[0], lg1[1], lg1[2], lg1[3]}, lbv[8] = {lb0[0], lb0[1], lb0[2], lb0[3], lb1[0], lb1[1], lb1[2], lb1[3]};
                    float s3 = 0.f;
#pragma unroll
                    for (int j = 0; j < 8; ++j) { const float y = v[j] * rstd * lgv[j] + lbv[j]; const float z = y * __builtin_amdgcn_rcpf(1.0f + __builtin_amdgcn_exp2f(-y * LOG2E)); v[j] = z; s3 += z * z; }
                    const float rc = 1.0f / sqrtf(wave_sum_dpp(s3) * (1.0f / 512.0f) + RMS_EPS);
                    v4u w; w.x = pk2(v[0] * rc, v[1] * rc); w.y = pk2(v[2] * rc, v[3] * rc); w.z = pk2(v[4] * rc, v[5] * rc); w.w = pk2(v[6] * rc, v[7] * rc);
                    *(v4u*)(MIX + (size_t)tok * D + 512 + 8 * lane) = w; }
                LDS_WAIT(); __builtin_amdgcn_s_barrier(); asm volatile("" ::: "memory");
            }
#undef GLU_CVT
        }
    }
    xcd_barrier(bar);

    {
        const int grp = ((int)blockIdx.x >> 3) % 3;
        EpiRes E{XN, X1B, b_out, RA};
        {
            DenseSched S{(const char*)Wout_t, T / 256, D / 256, G, (int)blockIdx.x, 2048, 0, grp};
            pg8::gemm_phase<EpiRes, DenseSched, false>(lds, lds + EPI_OFF, (const char*)MIX, 2048, S, E);
        }
        {
            PHASE_IDS();
            __syncthreads();
            LAS unsigned* scr = (LAS unsigned*)(lds + wave * 16384);
            const int gw = vcu * NWAVES + wave, NGW = G * NWAVES;
            constexpr int NIT0 = 32 * 8 * 64, NIT = NIT0 + 32 * 8 * 32;
            f32x4 va[16], vb[16];
            int it = NIT0 + gw;
            W8Item ia = w8_item(it < NIT ? it : NIT0, w1, w2, W1_t, W2_t), ib = ia;
            if (it < NIT) w8_load(ia, va, lane);
            while (it < NIT) {
                const int itb = it + NGW;
                if (itb < NIT) { ib = w8_item(itb, w1, w2, W1_t, W2_t); w8_load(ib, vb, lane); }
                w8_store(ia, va, scr, lane);
                if (itb >= NIT) break;
                const int ita = itb + NGW;
                if (ita < NIT) { ia = w8_item(ita, w1, w2, W1_t, W2_t); w8_load(ia, va, lane); }
                w8_store(ib, vb, scr, lane);
                it = ita;
            }
            __syncthreads();
        }
        {
            DenseSched S{(const char*)Wout_t, T / 256, D / 256, G, (int)blockIdx.x, 2048, grp, 1 << 30};
            pg8::gemm_phase<EpiRes, DenseSched, false>(lds, lds + EPI_OFF, (const char*)MIX, 2048, S, E);
        }
    }
    xcd_barrier(bar);

    {
        PHASE_IDS();
        if (wave < 4) __builtin_amdgcn_global_load_lds((const unsigned*)((const char*)g_ffn + wave * 1024 + lane * 16), (LAS unsigned*)(lds + P4_G_OFF + wave * 1024), 16, 0, 0);
#pragma unroll
        for (int i = 0; i < 16; ++i) __builtin_amdgcn_global_load_lds((const unsigned*)((const char*)WrHi + (size_t)(wave * 16 + i) * 1024 + lane * 16), (LAS unsigned*)(lds + (wave * 16 + i) * 1024), 16, 0, 0);
        VM_WAIT(); __syncthreads();
    }
    for (int unit = blockIdx.x; unit < T / 128; unit += G) {
        PHASE_IDS();
        const int i16 = lane & 15, g = lane >> 4;
        if (tid < 32) t_lcnt[tid] = 0;
        __syncthreads();
        const int tok = unit * 128 + wave * 16 + i16;
        const bf16* xr = X1B + (size_t)tok * D + 8 * g;
        float ss = 0.f;
#pragma unroll 8
        for (int s = 0; s < 32; ++s) { const v4u a = *(const v4u*)(xr + 32 * s);
            const float a0 = bf_lo(a.x), a1 = bf_hi(a.x), a2 = bf_lo(a.y), a3 = bf_hi(a.y), a4 = bf_lo(a.z), a5 = bf_hi(a.z), a6 = bf_lo(a.w), a7 = bf_hi(a.w);
            ss += (a0 * a0 + a1 * a1) + (a2 * a2 + a3 * a3) + (a4 * a4 + a5 * a5) + (a6 * a6 + a7 * a7); }
        ss += __shfl_xor(ss, 16); ss += __shfl_xor(ss, 32);
        const float rstd = 1.0f / sqrtf(ss * (1.0f / D) + RMS_EPS);
        f32x4 acc0 = (f32x4){0.f, 0.f, 0.f, 0.f}, acc1 = acc0;
        {
        unsigned char* hrow = XN8 + (size_t)tok * D + 8 * g;
        const bf16* wh0 = WrHi + lane * 8; const bf16* wl0 = WrLo + lane * 8;
        for (int s8 = 0; s8 < 4; ++s8) {
            v4u xc[8];
#pragma unroll
            for (int q = 0; q < 8; ++q) xc[q] = *(const v4u*)(xr + 32 * (8 * s8 + q));
            __builtin_amdgcn_sched_barrier(0);
#pragma unroll
            for (int q = 0; q < 8; ++q) { const int s = 8 * s8 + q; const v4u xa = xc[q];
            const f32x4 a = (f32x4){bf_lo(xa.x), bf_hi(xa.x), bf_lo(xa.y), bf_hi(xa.y)} * rstd * *(const LAS f32x4*)((const LAS float*)(lds + P4_G_OFF) + 8 * g + 32 * s), b = (f32x4){bf_lo(xa.z), bf_hi(xa.z), bf_lo(xa.w), bf_hi(xa.w)} * rstd * *(const LAS f32x4*)((const LAS float*)(lds + P4_G_OFF) + 8 * g + 32 * s + 4);
            v4u hp; hp.x = pk2(a[0], a[1]); hp.y = pk2(a[2], a[3]); hp.z = pk2(b[0], b[1]); hp.w = pk2(b[2], b[3]);
            v4u lp; lp.x = pk2(a[0] - bf_lo(hp.x), a[1] - bf_hi(hp.x)); lp.y = pk2(a[2] - bf_lo(hp.y), a[3] - bf_hi(hp.y)); lp.z = pk2(b[0] - bf_lo(hp.z), b[1] - bf_hi(hp.z)); lp.w = pk2(b[2] - bf_lo(hp.w), b[3] - bf_hi(hp.w));
            const bf16x8 hh = __builtin_bit_cast(bf16x8, hp), hl = __builtin_bit_cast(bf16x8, lp);
            const LAS unsigned char* wf = lds + lane * 16; const bf16x8 whA = *(const LAS bf16x8*)(wf + (0 * 32 + s) * 1024), whB = *(const LAS bf16x8*)(wf + (1 * 32 + s) * 1024), wlA = *(const LAS bf16x8*)(wf + (2 * 32 + s) * 1024), wlB = *(const LAS bf16x8*)(wf + (3 * 32 + s) * 1024);
            acc0 = __builtin_amdgcn_mfma_f32_16x16x32_bf16(whA, hh, acc0, 0, 0, 0); acc0 = __builtin_amdgcn_mfma_f32_16x16x32_bf16(whA, hl, acc0, 0, 0, 0); acc0 = __builtin_amdgcn_mfma_f32_16x16x32_bf16(wlA, hh, acc0, 0, 0, 0);
            acc1 = __builtin_amdgcn_mfma_f32_16x16x32_bf16(whB, hh, acc1, 0, 0, 0); acc1 = __builtin_amdgcn_mfma_f32_16x16x32_bf16(whB, hl, acc1, 0, 0, 0); acc1 = __builtin_amdgcn_mfma_f32_16x16x32_bf16(wlB, hh, acc1, 0, 0, 0); }
        }
        }
        {
            unsigned char* hrow = XN8 + (size_t)tok * D + 8 * g;
            const float rs8 = rstd * H_SCALE;
            for (int s8 = 0; s8 < 4; ++s8) {
                v4u xc[8];
#pragma unroll
                for (int q = 0; q < 8; ++q) xc[q] = *(const v4u*)(xr + 32 * (8 * s8 + q));
                __builtin_amdgcn_sched_barrier(0);
#pragma unroll
                for (int q = 0; q < 8; ++q) { const int s = 8 * s8 + q; const v4u xa = xc[q];
                    const f32x4 a = (f32x4){bf_lo(xa.x), bf_hi(xa.x), bf_lo(xa.y), bf_hi(xa.y)} * rs8 * *(const LAS f32x4*)((const LAS float*)(lds + P4_G_OFF) + 8 * g + 32 * s), b = (f32x4){bf_lo(xa.z), bf_hi(xa.z), bf_lo(xa.w), bf_hi(xa.w)} * rs8 * *(const LAS f32x4*)((const LAS float*)(lds + P4_G_OFF) + 8 * g + 32 * s + 4);
                    v2u h8; h8.x = pk4_fp8(a[0], a[1], a[2], a[3]); h8.y = pk4_fp8(b[0], b[1], b[2], b[3]); *(v2u*)(hrow + 32 * s) = h8; }
            }
        }
        LAS float* sc = (LAS float*)(lds + EPI_OFF + wave * 2112);
#pragma unroll
        for (int r = 0; r < 4; ++r) { sc[i16 * 33 + 4 * g + r] = acc0[r] + b_router[4 * g + r]; sc[i16 * 33 + 16 + 4 * g + r] = acc1[r] + b_router[16 + 4 * g + r]; }
        LDS_WAIT(); asm volatile("" ::: "memory");
        int idx[4], rank[4]; float gate[4];
        if (lane < 16) {
            float v[32];
#pragma unroll
            for (int e = 0; e < 32; ++e) v[e] = sc[lane * 33 + e];
            float val[4];
#pragma unroll
            for (int k = 0; k < 4; ++k) { float best = -INFINITY; int bi = 0;
#pragma unroll
                for (int e = 0; e < 32; ++e) if (v[e] > best) { best = v[e]; bi = e; }
                val[k] = best; idx[k] = bi;
#pragma unroll
                for (int e = 0; e < 32; ++e) v[e] = (e == bi) ? -INFINITY : v[e]; }
            float den = 0.f;
#pragma unroll
            for (int k = 0; k < 4; ++k) { gate[k] = __expf(val[k] - val[0]); den += gate[k]; }
            const float rden = 1.0f / den;
#pragma unroll
            for (int k = 0; k < 4; ++k) { gate[k] *= rden; rank[k] = atomicAdd((int*)(t_lcnt + idx[k]), 1); }
        }
        __syncthreads();
        if (tid < 32) { const int c = t_lcnt[tid]; t_gbase[tid] = c ? (int)__hip_atomic_fetch_add(gcnt + 16 * tid, (unsigned)c, __ATOMIC_RELAXED, __HIP_MEMORY_SCOPE_AGENT) : 0; }
        __syncthreads();
        if (lane < 16) {
            const int tk = unit * 128 + wave * 16 + lane;
#pragma unroll
            for (int k = 0; k < 4; ++k) { const int pos = t_gbase[idx[k]] + rank[k]; ltok[idx[k] * LIST_CAP + pos] = tk * 4 + k; lgate[idx[k] * LIST_CAP + pos] = gate[k]; }
        }
        __syncthreads();
    }
    xcd_barrier(bar);

    if (threadIdx.x < 32) t_cnt[threadIdx.x] = (int)__hip_atomic_load(gcnt + 16 * threadIdx.x, __ATOMIC_RELAXED, __HIP_MEMORY_SCOPE_AGENT);
    __syncthreads();
    if (threadIdx.x == 0) { int s = 0; for (int e = 0; e < 32; ++e) { t_rbs[e] = s; s += (t_cnt[e] + 255) >> 8; } t_rbs[32] = s; }
    __syncthreads();
    const int NB = __builtin_amdgcn_readfirstlane(t_rbs[32]);

    {
        MoeSched<true> S{(const char*)W1_t, (size_t)2048 * 1024, ltok, t_rbs, t_cnt, NB, 8, G, (int)blockIdx.x, 1024};
        EpiSwiglu E{ACT, b1p};
        pg8::gemm_phase<EpiSwiglu, MoeSched<true>, true>(lds, lds + EPI_OFF, (const char*)XN8, 1024, S, E);
    }
    xcd_barrier(bar);

    {
        MoeSched<false> S{(const char*)W2_t, (size_t)1024 * 1024, ltok, t_rbs, t_cnt, NB, 4, G, (int)blockIdx.x, 1024};
        EpiMoeOut E{YB, b2, ltok, lgate};
        pg8::gemm_phase<EpiMoeOut, MoeSched<false>, true, false>(lds, lds + EPI_OFF, (const char*)ACT, 1024, S, E);
    }
    xcd_barrier(bar);

    {
        PHASE_IDS();
        const int gw = vcu * NWAVES + wave, NGW = G * NWAVES;
        f32x4 gfin[4];
#pragma unroll
        for (int j = 0; j < 4; ++j) gfin[j] = *((const f32x4*)g_final + lane + 64 * j);
        for (int m0 = 2 * gw; m0 < T; m0 += 2 * NGW) {
            v2u xw_[2][4]; unsigned yw[2][4][4];
#pragma unroll
            for (int q = 0; q < 2; ++q) { const GAS v2u* xr = (const GAS v2u*)(X1B + (size_t)(m0 + q) * D) + lane;
#pragma unroll
                for (int j = 0; j < 4; ++j) xw_[q][j] = __builtin_nontemporal_load(xr + 64 * j);
#pragma unroll
                for (int k = 0; k < 4; ++k) { const GAS unsigned* yr = (const GAS unsigned*)(YB + ((size_t)(m0 + q) * 4 + k) * D) + lane;
#pragma unroll
                    for (int j = 0; j < 4; ++j) yw[q][k][j] = __builtin_nontemporal_load(yr + 64 * j); } }
#pragma unroll
            for (int q = 0; q < 2; ++q) {
                f32x4 v[4];
#pragma unroll
                for (int j = 0; j < 4; ++j) v[j] = (f32x4){bf_lo(xw_[q][j].x), bf_hi(xw_[q][j].x), bf_lo(xw_[q][j].y), bf_hi(xw_[q][j].y)};
#pragma unroll
                for (int k = 0; k < 4; ++k)
#pragma unroll
                    for (int j = 0; j < 4; ++j) { const f32x2 lo = __builtin_amdgcn_cvt_pk_f32_fp8((int)yw[q][k][j], false), hi = __builtin_amdgcn_cvt_pk_f32_fp8((int)yw[q][k][j], true);
                        v[j].x += lo.x * (1.0f / Y_SCALE); v[j].y += lo.y * (1.0f / Y_SCALE); v[j].z += hi.x * (1.0f / Y_SCALE); v[j].w += hi.y * (1.0f / Y_SCALE); }
                float s = 0.f;
#pragma unroll
                for (int j = 0; j < 4; ++j) s += (v[j].x * v[j].x + v[j].y * v[j].y) + (v[j].z * v[j].z + v[j].w * v[j].w);
                const float rstd = 1.0f / sqrtf(wave_sum_dpp(s) * (1.0f / D) + RMS_EPS);
                GAS f32x4* xw = (GAS f32x4*)(out + (size_t)(m0 + q) * D) + lane;
#pragma unroll
                for (int j = 0; j < 4; ++j) __builtin_nontemporal_store(v[j] * rstd * gfin[j], xw + 64 * j);
            }
        }
    }
}

extern "C" void kernel_launch(void* const* d_in, const int* in_sizes, int n_in, void* d_out, int out_size, void* d_ws, size_t ws_size, hipStream_t stream) {
    static int grid = 0;
    if (grid == 0) {
        if (n_in != 21 || in_sizes[0] != T * D || out_size != T * D || ws_size < WS_END) { fprintf(stderr, "kernel_launch: unexpected shapes (n_in %d, in0 %d, out %d, ws %zu)\n", n_in, n_in > 0 ? in_sizes[0] : -1, out_size, ws_size); grid = -1; return; }
        int dev = 0, cus = 0, per_cu = 0;
        if (hipGetDevice(&dev) != hipSuccess || hipDeviceGetAttribute(&cus, hipDeviceAttributeMultiprocessorCount, dev) != hipSuccess) { grid = -1; return; }
        if (hipFuncSetAttribute((const void*)hymba_fwd, hipFuncAttributeMaxDynamicSharedMemorySize, LDS_BYTES) != hipSuccess) { fprintf(stderr, "kernel_launch: hipFuncSetAttribute failed\n"); grid = -1; return; }
        if (hipOccupancyMaxActiveBlocksPerMultiprocessor(&per_cu, (const void*)hymba_fwd, NWAVES * 64, LDS_BYTES) != hipSuccess || per_cu < 1)
            fprintf(stderr, "kernel_launch: occupancy query reports %d workgroups per CU\n", per_cu);
        (void)hipGetLastError();
        grid = cus;
    }
    if (grid < 0) return;
    if (hipMemsetAsync((char*)d_ws + WS_CTL, 0, CTL_ZERO_BYTES, stream) != hipSuccess) return;
    Args a{};
    for (int i = 0; i < 21; ++i) a.in[i] = (const float*)d_in[i];
    a.out = (float*)d_out; a.ws = (unsigned char*)d_ws;
    hipLaunchKernelGGL(hymba_fwd, dim3(grid), dim3(NWAVES * 64), LDS_BYTES, stream, a);
}
```

```cpp
#include <hip/hip_runtime.h>
#include <cstdio>
#include <cstdint>

namespace pg8 {
#define PG8_LAS __attribute__((address_space(3)))
typedef unsigned short bf16_t;
typedef short bf16x8 __attribute__((ext_vector_type(8)));
typedef float f32x4 __attribute__((ext_vector_type(4)));
typedef unsigned u32x4 __attribute__((ext_vector_type(4)));
constexpr int BM = 256, BK = 64, HALF = 128, HTB = HALF * BK * 2, STAGE_BYTES = 8 * HTB, NXCD = 8, WGM = 8;

__host__ __device__ __forceinline__ int lds_byte(int r, int c) { const int st = (r >> 4) * 2 + (c >> 5), rr = r & 15, cc = c & 31, ob = rr * 64 + cc * 2; return st * 1024 + (ob ^ (((ob >> 9) & 1) << 5)); }
__host__ __device__ __forceinline__ void stage_rc(int b, int& R, int& C) { const int st = b / 1024, sb = b % 1024, swz = sb ^ (((sb >> 9) & 1) << 5); R = (st >> 1) * 16 + swz / 64; C = (st & 1) * 32 + (swz % 64) / 2; }
__host__ __device__ __forceinline__ int perm32(int rho) { const int n = rho >> 4, i = rho & 15; return 8 * (i >> 2) + 4 * n + (i & 3); }

struct Unit { int pm, pn, e, rb, cnt; };

__device__ __forceinline__ bool static_order(int i, int G, int c, int nM, int nN, int& pm, int& pn) {
    const int nwg = nM * nN; const long L = (long)i * G + c; if (L >= nwg) return false;
    int wgid = (int)L; { const int q = nwg / NXCD, r = nwg % NXCD, xcd = wgid % NXCD, off = wgid / NXCD; wgid = (xcd < r ? xcd * (q + 1) : r * (q + 1) + (xcd - r) * q) + off; }
    const int nig = WGM * nN, gid = wgid / nig, fm = gid * WGM, gsz = (nM - fm) < WGM ? (nM - fm) : WGM;
    pm = fm + ((wgid % nig) % gsz); pn = (wgid % nig) / gsz; return true;
}

__device__ __forceinline__ unsigned cvt_pk_bf16(float lo, float hi) { unsigned r; asm volatile("v_cvt_pk_bf16_f32 %0, %1, %2" : "=v"(r) : "v"(lo), "v"(hi)); return r; }

typedef int i32x8 __attribute__((ext_vector_type(8)));
typedef int i32x4v __attribute__((ext_vector_type(4)));
template <class Epi, class Sched, bool FP8, bool ALIGN = true>
__device__ __forceinline__ void gemm_phase(PG8_LAS unsigned char* lds, PG8_LAS unsigned char* epi, const char* Abase, const int rp, const Sched& S, const Epi& E) {
    int tid = threadIdx.x; asm volatile("" : "+v"(tid));
    const int wid = __builtin_amdgcn_readfirstlane(tid >> 6), lane = tid & 63, wr = wid >> 2, wc = wid & 3, fr = lane & 15, fq = lane >> 4;
    const int nt = rp / 128;
    int RA[2]; unsigned CA2[2], voffB[2];
#pragma unroll
    for (int i = 0; i < 2; ++i) { int R, C; stage_rc(tid * 16 + i * 8192, R, C); const int Rb = Epi::PERM ? ((R & ~31) + perm32(R & 31)) : R;
        RA[i] = R; CA2[i] = (unsigned)C * 2u; voffB[i] = (unsigned)(Rb * rp + C * 2); }
    const size_t kstep = (size_t)(BK * 2);
    const size_t hstepB = (size_t)HALF * rp;
    const unsigned ldsw = (unsigned)wid * 1024u;
    const int aoff = lds_byte(wr * 64 + fr, fq * 8), boff = lds_byte(wc * 32 + fr, fq * 8);
#define PG8_SA(b, h) (((b) * 2 + (h)) * HTB)
#define PG8_SB(b, h) ((4 + (b) * 2 + (h)) * HTB)
#define PG8_STAGE(bufoff, gbase, voff) do { _Pragma("unroll") for (int _i = 0; _i < 2; ++_i) { unsigned _vo = (voff)[_i]; asm volatile("" : "+v"(_vo));   \
        __builtin_amdgcn_global_load_lds((const unsigned*)((const char*)(gbase) + _vo), (PG8_LAS unsigned*)(lds + (bufoff) + ldsw + _i * 8192), 16, 0, 0); } } while (0)
#define PG8_LDA(dst, b, h) do { _Pragma("unroll") for (int m = 0; m < 4; ++m) _Pragma("unroll") for (int k = 0; k < 2; ++k) dst[m][k] = *(const PG8_LAS bf16x8*)(lds + PG8_SA(b, h) + aoff + m * 2048 + k * 1024); } while (0)
#define PG8_LDB(dst, b, h) do { _Pragma("unroll") for (int n = 0; n < 2; ++n) _Pragma("unroll") for (int k = 0; k < 2; ++k) dst[n][k] = *(const PG8_LAS bf16x8*)(lds + PG8_SB(b, h) + boff + n * 2048 + k * 1024); } while (0)
#define PG8_CAT8(x) __builtin_shufflevector(__builtin_bit_cast(i32x4v, x[0]), __builtin_bit_cast(i32x4v, x[1]), 0, 1, 2, 3, 4, 5, 6, 7)
#define PG8_MMA_(ai, bj, At, Bt, Z) do { __builtin_amdgcn_s_setprio(1); \
        if constexpr (FP8) { _Pragma("unroll") for (int m = 0; m < 4; ++m) _Pragma("unroll") for (int n = 0; n < 2; ++n) \
            { const i32x8 _b = PG8_CAT8(Bt[n]), _a = PG8_CAT8(At[m]);   \
              if (Z) asm volatile("v_mfma_f32_16x16x128_f8f6f4 %0, %1, %2, 0" : "=&v"(acc[ai][bj][m][n]) : "v"(_b), "v"(_a)); \
              else asm volatile("v_mfma_f32_16x16x128_f8f6f4 %0, %1, %2, %0" : "+v"(acc[ai][bj][m][n]) : "v"(_b), "v"(_a)); } } \
        else { _Pragma("unroll") for (int m = 0; m < 4; ++m) _Pragma("unroll") for (int n = 0; n < 2; ++n) _Pragma("unroll") for (int k = 0; k < 2; ++k) \
            acc[ai][bj][m][n] = __builtin_amdgcn_mfma_f32_16x16x32_bf16(Bt[n][k], At[m][k], acc[ai][bj][m][n], 0, 0, 0); } \
        __builtin_amdgcn_s_setprio(0); } while (0)
#define PG8_MMA(ai, bj, At, Bt) PG8_MMA_(ai, bj, At, Bt, false)
#define PG8_MMA0(ai, bj, At, Bt) do { if (FP8 && first) PG8_MMA_(ai, bj, At, Bt, true); else PG8_MMA_(ai, bj, At, Bt, false); } while (0)
#define PG8_WAIT_V(n) asm volatile("s_waitcnt vmcnt(" #n ")" ::: "memory")
#define PG8_WAIT_L(n) asm volatile("s_waitcnt lgkmcnt(" #n ")" ::: "memory")
#define PG8_BAR __builtin_amdgcn_s_barrier()
#define PG8_SCHED __builtin_amdgcn_sched_barrier(0)
#define PG8_ZERO() do { if constexpr (!FP8) { _Pragma("unroll") for (int a = 0; a < 2; ++a) _Pragma("unroll") for (int b = 0; b < 2; ++b) _Pragma("unroll") for (int m = 0; m < 4; ++m) _Pragma("unroll") for (int n = 0; n < 2; ++n) acc[a][b][m][n] = (f32x4){0.f, 0.f, 0.f, 0.f}; } } while (0)
#define PG8_VA(dst, u) do { _Pragma("unroll") for (int _h = 0; _h < 2; ++_h) _Pragma("unroll") for (int _i = 0; _i < 2; ++_i) dst[_h][_i] = S.a_off(u, _h * HALF + RA[_i]) + CA2[_i]; } while (0)
    Unit cur, nxt; int ui = 0;
    if (!S.next(0, cur)) return;
    f32x4 acc[2][2][4][2];
    PG8_ZERO();
    bf16x8 At[4][2], B0[2][2], B1[2][2];
    unsigned cvA[2][2], nvA[2][2];
    float rs[2][4];
    PG8_VA(cvA, cur);
    const char* cB = S.b_tile(cur);
    const char* cA = Abase + S.a_base(cur);
    E.side(cur, epi, wid, lane);
    PG8_STAGE(PG8_SB(0, 0), cB, voffB); PG8_STAGE(PG8_SB(0, 1), cB + hstepB, voffB); PG8_STAGE(PG8_SA(0, 0), cA, cvA[0]); PG8_STAGE(PG8_SA(0, 1), cA, cvA[1]);
    if (wr == 1) PG8_BAR;
    PG8_WAIT_V(2); PG8_BAR;
    PG8_STAGE(PG8_SB(1, 0), cB + kstep, voffB); PG8_STAGE(PG8_SA(1, 0), cA + kstep, cvA[0]); PG8_STAGE(PG8_SB(1, 1), cB + hstepB + kstep, voffB);
    PG8_WAIT_V(6); PG8_BAR;
    for (;;) {
        const bool has_next = S.next(ui + 1, nxt);
        if constexpr (Sched::GATHER) { if (has_next) S.gather_dma(nxt, epi + ((ui + 1) & 1) * 4096 + 3072, wid, lane); }
        const char* nB = has_next ? S.b_tile(nxt) : cB;
        const char* nA = has_next ? Abase + S.a_base(nxt) : cA;
        PG8_LAS unsigned char* area = epi + (ui & 1) * 4096;
        for (int t = 0; t < nt; t += 2) {
            const bool last = (t == nt - 2), first = (t == 0);
            if constexpr (Epi::MIDSCALE) { if (t == nt / 2) {
#pragma unroll
                for (int a = 0; a < 2; ++a)
#pragma unroll
                    for (int m = 0; m < 4; ++m) rs[a][m] = *(const PG8_LAS float*)(area + 1024 + 4 * (a * 128 + wr * 64 + m * 16 + fr));
#pragma unroll
                for (int a = 0; a < 2; ++a)
#pragma unroll
                    for (int b = 0; b < 2; ++b)
#pragma unroll
                        for (int m = 0; m < 4; ++m)
#pragma unroll
                            for (int n = 0; n < 2; ++n) acc[a][b][m][n] = acc[a][b][m][n] * rs[a][m]; } }
            const char* a1 = cA + (size_t)(t + 1) * kstep;
            const char* a2 = last ? nA : cA + (size_t)(t + 2) * kstep; const char* b2 = last ? nB : cB + (size_t)(t + 2) * kstep;
            const char* a3 = a2 + kstep; const char* b3 = b2 + kstep;
            if constexpr (Sched::GATHER) { if (last) {
#pragma unroll
                for (int h = 0; h < 2; ++h)
#pragma unroll
                    for (int i = 0; i < 2; ++i) nvA[h][i] = has_next ? S.a_fin(nxt, h * HALF + RA[i], *(const PG8_LAS int*)(epi + ((ui + 1) & 1) * 4096 + 3072 + 4 * (h * HALF + RA[i]))) + CA2[i] : cvA[h][i]; } }
            unsigned sA[2][2];
#pragma unroll
            for (int h = 0; h < 2; ++h)
#pragma unroll
                for (int i = 0; i < 2; ++i) sA[h][i] = (Sched::GATHER && last) ? nvA[h][i] : cvA[h][i];
            PG8_LDB(B0, 0, 0); PG8_LDB(B1, 0, 1); PG8_SCHED; PG8_LDA(At, 0, 0); PG8_STAGE(PG8_SA(1, 1), a1, cvA[1]);
            PG8_WAIT_V(8); PG8_WAIT_L(0); PG8_BAR; PG8_MMA0(0, 0, At, B0); PG8_MMA0(0, 1, At, B1); PG8_BAR; PG8_SCHED;
            PG8_LDA(At, 0, 1); PG8_STAGE(PG8_SB(0, 0), b2, voffB); PG8_STAGE(PG8_SB(0, 1), b2 + hstepB, voffB); PG8_STAGE(PG8_SA(0, 0), a2, sA[0]);
            PG8_WAIT_V(8); PG8_WAIT_L(0); PG8_BAR; PG8_MMA0(1, 0, At, B0); PG8_MMA0(1, 1, At, B1); PG8_BAR; PG8_SCHED;
            PG8_LDB(B0, 1, 0); PG8_LDB(B1, 1, 1); PG8_SCHED; PG8_LDA(At, 1, 0); PG8_STAGE(PG8_SA(0, 1), a2, sA[1]);
            PG8_WAIT_V(8); PG8_WAIT_L(0); PG8_BAR; PG8_MMA(0, 0, At, B0); PG8_MMA(0, 1, At, B1); PG8_BAR; PG8_SCHED;
            PG8_LDA(At, 1, 1); PG8_STAGE(PG8_SB(1, 0), b3, voffB); PG8_STAGE(PG8_SB(1, 1), b3 + hstepB, voffB); PG8_STAGE(PG8_SA(1, 0), a3, sA[0]);
            PG8_WAIT_V(8); PG8_WAIT_L(0); PG8_BAR; PG8_MMA(1, 0, At, B0); PG8_MMA(1, 1, At, B1); PG8_BAR; PG8_SCHED;
        }
        if constexpr (ALIGN) { if (wr == 0) PG8_BAR; }
        if constexpr (FP8) asm volatile("s_nop 15\n\ts_nop 15" ::: "memory");
        E(acc, cur, wr, wc, fr, fq, area);
        if (!has_next) break;
        PG8_ZERO();
        cur = nxt; cB = nB; cA = nA; ++ui;
        E.side(cur, epi + (ui & 1) * 4096, wid, lane);
        if constexpr (Sched::GATHER) {
#pragma unroll
            for (int h = 0; h < 2; ++h)
#pragma unroll
                for (int i = 0; i < 2; ++i) cvA[h][i] = nvA[h][i]; }
        if constexpr (ALIGN) { if (wr == 1) PG8_BAR; }
    }
    PG8_WAIT_V(0);
    if constexpr (!ALIGN) { if (wr == 0) PG8_BAR; }
    PG8_BAR;
#undef PG8_SA
#undef PG8_SB
#undef PG8_STAGE
#undef PG8_LDA
#undef PG8_LDB
#undef PG8_MMA
#undef PG8_MMA_
#undef PG8_MMA0
#undef PG8_CAT8
#undef PG8_WAIT_V
#undef PG8_WAIT_L
#undef PG8_BAR
#undef PG8_SCHED
#undef PG8_ZERO
#undef PG8_VA
}
}

constexpr int NWAVES = 8;
constexpr int T = 32768, SEQ = 2048, D = 1024, INW = 1792, NEXP = 32, TOPK = 4;
constexpr int COL_K = 512, COL_V = 640, COL_U = 768;
constexpr int PJW = 1280;
constexpr float RMS_EPS = 1e-5f, LN_EPS = 1e-5f;
constexpr float LOG2E = 1.4426950408889634f;
constexpr float QSCALE = 0.125f * LOG2E;
constexpr int LIST_CAP = 32768;
constexpr int MAX_RB = 544;

constexpr size_t MiB = 1u << 20;
constexpr size_t WS_CTL = 0, CTL_ZERO_BYTES = 16 * 1024;
constexpr size_t WS_WIN = 2 * MiB;
constexpr size_t WS_WOUT = 6 * MiB;
constexpr size_t WS_W1 = 8 * MiB;
constexpr size_t WS_W2 = 136 * MiB;
constexpr size_t WS_XN = 200 * MiB;
constexpr size_t WS_LTOK = 264 * MiB;
constexpr size_t WS_LGATE = 268 * MiB;
constexpr size_t WS_B1P = 272 * MiB;
constexpr size_t WS_RA = 272 * MiB + 512 * 1024;
constexpr size_t WS_WR = 273 * MiB;
constexpr size_t WS_ACT = 274 * MiB;
constexpr size_t WS_PROJ = 546 * MiB;
constexpr size_t WS_MIX = 658 * MiB;
constexpr size_t WS_Y = 546 * MiB;
constexpr size_t WS_XN8 = 674 * MiB;
constexpr size_t WS_END = 802 * MiB;
static_assert(WS_ACT + (size_t)MAX_RB * 256 * 1024 * 2 <= WS_PROJ && WS_MIX + (size_t)T * 1024 * 2 <= WS_END && WS_Y + (size_t)T * 4 * 1024 * 2 <= WS_END, "ws map");
constexpr int CW_BAR = 0;
constexpr int CW_GCNT = 3584;
static_assert((CW_BAR + 3456) * 4 <= (int)CTL_ZERO_BYTES && (CW_GCNT + 32 * 16) * 4 <= (int)CTL_ZERO_BYTES, "control words inside the per-call memset");

constexpr int RING_BYTES = 131072;
constexpr int MISC_OFF = RING_BYTES;
constexpr int TAB_OFF = MISC_OFF + 256;
constexpr int EPI_OFF = RING_BYTES + 2048;
constexpr int P4_G_OFF = EPI_OFF + 8 * 2112;
constexpr int LDS_BYTES = 154624;

#define GAS __attribute__((address_space(1)))
#define LAS __attribute__((address_space(3)))
typedef unsigned short bf16;
typedef unsigned v4u __attribute__((ext_vector_type(4)));
typedef unsigned v2u __attribute__((ext_vector_type(2)));
typedef float f32x4 __attribute__((ext_vector_type(4)));
typedef float f32x2 __attribute__((ext_vector_type(2)));
typedef short bf16x8 __attribute__((ext_vector_type(8)));
typedef short v4i16_t __attribute__((ext_vector_type(4)));
#define LDS_WAIT() asm volatile("s_waitcnt lgkmcnt(0)" ::: "memory")
#define VM_WAIT() asm volatile("s_waitcnt vmcnt(0)" ::: "memory")
__device__ __forceinline__ unsigned pk2(float lo, float hi) { return pg8::cvt_pk_bf16(lo, hi); }
__device__ __forceinline__ unsigned pk4_fp8(float a, float b, float c, float d) { int w = 0; w = __builtin_amdgcn_cvt_pk_fp8_f32(a, b, w, false); w = __builtin_amdgcn_cvt_pk_fp8_f32(c, d, w, true); return (unsigned)w; }
constexpr float W_SCALE = 64.0f, H_SCALE = 8.0f, ACT_SCALE = 4.0f, Y_SCALE = 16.0f;
__device__ __forceinline__ float bf_lo(unsigned w) { return __uint_as_float(w << 16); }
__device__ __forceinline__ float bf_hi(unsigned w) { return __uint_as_float(w & 0xffff0000u); }

#define XB_TMO      128
#define XB_XCNT(j)  (256  + 64 * (j))
#define XB_XSUB(j)  (1280 + 64 * (j))
#define XB_XGEN(j)  (2304 + 64 * (j))
#define XB_TOP      3328
#define XB_TOPGEN   3392
#define XCD_BAR_WORDS 3456
#define XB_SPIN_CAP (1u << 18)

__device__ __forceinline__ unsigned xb_ld(unsigned* p)              { return __hip_atomic_load(p, __ATOMIC_RELAXED, __HIP_MEMORY_SCOPE_AGENT); }
__device__ __forceinline__ unsigned xb_add(unsigned* p, unsigned v) { return __hip_atomic_fetch_add(p, v, __ATOMIC_RELAXED, __HIP_MEMORY_SCOPE_AGENT); }
__device__ __forceinline__ unsigned xb_xcc_id() { return (unsigned)__builtin_amdgcn_s_getreg((3 << 11) | 20) & 0xFu; }
#define XB_SPIN(cond, bar) do { unsigned _sp = 0; while (cond) { __builtin_amdgcn_s_sleep(1); \
    if ((++_sp & 255u) == 0u) { if (xb_ld(&(bar)[XB_TMO])) break; if (_sp > XB_SPIN_CAP) { atomicAdd(&(bar)[XB_TMO], 1u); break; } } } } while (0)

struct XcdBarrier { unsigned* bar; unsigned x; volatile LAS unsigned* st; };

__device__ __forceinline__ XcdBarrier xcd_barrier_post(unsigned* bar, volatile LAS unsigned* st) {
    XcdBarrier b; b.bar = bar; b.x = xb_xcc_id(); b.st = st;
    if (threadIdx.x == 0) (void)xb_add(&bar[XB_XCNT(b.x)], 1u);
    return b;
}
__device__ __forceinline__ void xcd_barrier_complete(unsigned* bar, unsigned x, unsigned& nloc, unsigned& nx) {
    const unsigned G = gridDim.x * gridDim.y * gridDim.z;
    unsigned sum, cnt, mine, sp = 0u;
    for (;;) {
        sum = 0u; cnt = 0u; mine = 0u;
#pragma unroll
        for (unsigned j = 0; j < 16; ++j) { const unsigned c = xb_ld(&bar[XB_XCNT(j)]); sum += c; cnt += (c > 0u) ? 1u : 0u; mine = (j == x) ? c : mine; }
        if (sum == G) break;
        __builtin_amdgcn_s_sleep(1);
        if ((++sp & 255u) == 0u) { if (xb_ld(&bar[XB_TMO])) break; if (sp > XB_SPIN_CAP) { atomicAdd(&bar[XB_TMO], 1u); break; } }
    }
    nloc = mine > 0u ? mine : 1u; nx = cnt > 0u ? cnt : 1u;
}
__device__ __forceinline__ void xcd_barrier(const XcdBarrier& b) {
    asm volatile("s_waitcnt vmcnt(0)" ::: "memory");
    __syncthreads();
    if (threadIdx.x == 0) {
        unsigned* bar = b.bar;
        __builtin_amdgcn_s_waitcnt(0);
        unsigned nloc = b.st[0], nx = b.st[1];
        if (nloc == 0u) { xcd_barrier_complete(bar, b.x, nloc, nx); b.st[0] = nloc; b.st[1] = nx; }
        const unsigned old = xb_add(&bar[XB_XSUB(b.x)], 1u);
        const unsigned gen = old / nloc;
        if (old + 1u == (gen + 1u) * nloc) {
            __builtin_amdgcn_fence(__ATOMIC_RELEASE, "agent");
            asm volatile("s_waitcnt vmcnt(0)" ::: "memory");
            const unsigned og = xb_add(&bar[XB_TOP], 1u);
            const unsigned tg = og / nx;
            if (og + 1u == (tg + 1u) * nx) xb_add(&bar[XB_TOPGEN], 1u);
            else XB_SPIN(xb_ld(&bar[XB_TOPGEN]) == tg, bar);
            __builtin_amdgcn_fence(__ATOMIC_ACQUIRE, "agent");
            xb_add(&bar[XB_XGEN(b.x)], 1u);
            asm volatile("s_waitcnt vmcnt(0)" ::: "memory");
        } else {
            XB_SPIN(xb_ld(&bar[XB_XGEN(b.x)]) == gen, bar);
            __builtin_amdgcn_fence(__ATOMIC_ACQUIRE, "agent");
            asm volatile("s_waitcnt vmcnt(0)" ::: "memory");
        }
    }
    __syncthreads();
}

template <int CTRL, int RMASK> __device__ __forceinline__ float dpp_add(float v) { return v + __builtin_bit_cast(float, __builtin_amdgcn_update_dpp(0, __builtin_bit_cast(int, v), CTRL, RMASK, 0xf, false)); }
__device__ __forceinline__ float wave_sum_dpp(float v) {
    v = dpp_add<0xB1, 0xf>(v); v = dpp_add<0x4E, 0xf>(v); v = dpp_add<0x141, 0xf>(v); v = dpp_add<0x140, 0xf>(v);
    v = dpp_add<0x142, 0xa>(v); v = dpp_add<0x143, 0xc>(v);
    return __builtin_bit_cast(float, __builtin_amdgcn_readlane(__builtin_bit_cast(int, v), 63));
}
__device__ __forceinline__ float wave_sum(float v) {
#pragma unroll
    for (int o = 1; o < 64; o <<= 1) v += __shfl_xor(v, o);
    return v;
}

struct DenseSched {
    static constexpr bool GATHER = false;
    const char* Bt; int nM, nN, G, c, rp, ibeg, iend;
    __device__ __forceinline__ size_t a_base(const pg8::Unit& u) const { return (size_t)u.pm * 256 * (size_t)rp; }
    __device__ __forceinline__ bool next(int i, pg8::Unit& u) const { u.e = 0; u.rb = 0; u.cnt = 0; if (i + ibeg >= iend) return false; return pg8::static_order(i + ibeg, G, c, nM, nN, u.pm, u.pn); }
    __device__ __forceinline__ const char* b_tile(const pg8::Unit& u) const { return Bt + (size_t)u.pn * 256 * rp; }
    __device__ __forceinline__ unsigned a_off(const pg8::Unit&, int r) const { return (unsigned)r * (unsigned)rp; }
    __device__ __forceinline__ int a_raw(const pg8::Unit&, int) const { return 0; }
    __device__ __forceinline__ unsigned a_fin(const pg8::Unit&, int r, int) const { return (unsigned)r * (unsigned)rp; }
};
template <bool GATHER_> struct MoeSched {
    static constexpr bool GATHER = GATHER_;
    const char* Bt; size_t bexp;
    const int* ltok; const LAS int* rbs; const LAS int* cnt; int nM, nN, G, c, rp;
    __device__ __forceinline__ size_t a_base(const pg8::Unit& u) const { return GATHER_ ? (size_t)0 : (size_t)u.pm * 256 * (size_t)rp; }
    __device__ __forceinline__ bool next(int i, pg8::Unit& u) const {
        if (!pg8::static_order(i, G, c, nM, nN, u.pm, u.pn)) return false;
        const int lane = threadIdx.x & 63;
        const int v = (lane < 32) ? rbs[lane + 1] : 0x7fffffff;
        const unsigned long long m = __ballot(v <= u.pm);
        const int e = __builtin_amdgcn_readfirstlane((int)__popcll(m));
        u.e = e; u.rb = u.pm - __builtin_amdgcn_readfirstlane(rbs[e]); u.cnt = __builtin_amdgcn_readfirstlane(cnt[e]);
        return true;
    }
    __device__ __forceinline__ const char* b_tile(const pg8::Unit& u) const { return Bt + (size_t)u.e * bexp + (size_t)u.pn * 256 * rp; }
    __device__ __forceinline__ unsigned a_off(const pg8::Unit& u, int r) const {
        return a_fin(u, r, a_raw(u, r));
    }
    __device__ __forceinline__ int a_raw(const pg8::Unit& u, int r) const { if constexpr (GATHER_) return ltok[u.e * LIST_CAP + u.rb * 256 + r]; else return 0; }
    __device__ __forceinline__ void gather_dma(const pg8::Unit& u, LAS unsigned char* dst, int wid, int lane) const {
        if (wid < 4) __builtin_amdgcn_global_load_lds((const unsigned*)(ltok + (size_t)u.e * LIST_CAP + u.rb * 256 + wid * 64 + lane), (LAS unsigned*)(dst + wid * 256), 4, 0, 0); }
    __device__ __forceinline__ unsigned a_fin(const pg8::Unit& u, int r, int raw) const {
        if constexpr (GATHER_) { const int t4 = (u.rb * 256 + r < u.cnt) ? raw : 0; return (unsigned)(t4 >> 2) * (unsigned)rp; }
        else return (unsigned)r * (unsigned)rp;
    }
};

__device__ __forceinline__ void side_dma(const void* src_lane, LAS unsigned char* dst_wave) { __builtin_amdgcn_global_load_lds((const unsigned*)src_lane, (LAS unsigned*)dst_wave, 4, 0, 0); }

struct EpiProj {
    static constexpr bool PERM = true, MIDSCALE = false;
    bf16* O; const float* bias; const float* rowscale;
    __device__ __forceinline__ void side(const pg8::Unit& u, LAS unsigned char* area, int wid, int lane) const {
        if (wid < 4) side_dma(bias + u.pn * 256 + wid * 64 + lane, area + wid * 256);
        else side_dma(rowscale + u.pm * 256 + (wid - 4) * 64 + lane, area + 1024 + (wid - 4) * 256); }
    __device__ __forceinline__ void operator()(const f32x4 (&acc)[2][2][4][2], const pg8::Unit& u, int wr, int wc, int fr, int fq, const LAS unsigned char* area) const {
        const int row0 = u.pm * 256 + wr * 64 + fr;
        f32x4 bv[2][2];
#pragma unroll
        for (int bj = 0; bj < 2; ++bj)
#pragma unroll
            for (int n = 0; n < 2; ++n) bv[bj][n] = *(const LAS f32x4*)(area + 4 * (wc * 32 + 8 * fq + bj * 128 + 4 * n));
        if (u.pn < 3) {
            const int col0 = u.pn * 256 + wc * 32 + 8 * fq;
            const float sc = (u.pn < 2) ? QSCALE : 1.0f;
#pragma unroll
            for (int ai = 0; ai < 2; ++ai)
#pragma unroll
                for (int m = 0; m < 4; ++m) { bf16* rowp = O + (size_t)(row0 + ai * 128 + m * 16) * PJW + col0;
                    const float rs = *(const LAS float*)(area + 1024 + 4 * (ai * 128 + wr * 64 + m * 16 + fr));
#pragma unroll
                    for (int bj = 0; bj < 2; ++bj) { const f32x4 v0 = (acc[ai][bj][m][0] * rs + bv[bj][0]) * sc, v1 = (acc[ai][bj][m][1] * rs + bv[bj][1]) * sc;
                        v4u w; w.x = pk2(v0[0], v0[1]); w.y = pk2(v0[2], v0[3]); w.z = pk2(v1[0], v1[1]); w.w = pk2(v1[2], v1[3]);
                        *(v4u*)(rowp + bj * 128) = w; } }
        } else {
            const int col0 = COL_U + (u.pn - 3) * 128 + wc * 32 + 8 * fq;
#pragma unroll
            for (int ai = 0; ai < 2; ++ai)
#pragma unroll
                for (int m = 0; m < 4; ++m) { bf16* rowp = O + (size_t)(row0 + ai * 128 + m * 16) * PJW + col0;
                    const float rs = *(const LAS float*)(area + 1024 + 4 * (ai * 128 + wr * 64 + m * 16 + fr));
                    f32x2 uv[4];
#pragma unroll
                    for (int n = 0; n < 2; ++n)
#pragma unroll
                        for (int p = 0; p < 2; ++p) {
                            const f32x2 av = (f32x2){acc[ai][0][m][n][2 * p], acc[ai][0][m][n][2 * p + 1]} * rs + (f32x2){bv[0][n][2 * p], bv[0][n][2 * p + 1]};
                            const f32x2 gv = (f32x2){acc[ai][1][m][n][2 * p], acc[ai][1][m][n][2 * p + 1]} * rs + (f32x2){bv[1][n][2 * p], bv[1][n][2 * p + 1]};
                            const f32x2 z = gv * (-LOG2E);
                            const f32x2 d = (f32x2){__builtin_amdgcn_exp2f(z.x), __builtin_amdgcn_exp2f(z.y)} + 1.0f;
                            uv[2 * n + p] = av * (f32x2){__builtin_amdgcn_rcpf(d.x), __builtin_amdgcn_rcpf(d.y)}; }
                    v4u w; w.x = pk2(uv[0].x, uv[0].y); w.y = pk2(uv[1].x, uv[1].y); w.z = pk2(uv[2].x, uv[2].y); w.w = pk2(uv[3].x, uv[3].y);
                    *(v4u*)rowp = w; }
        }
    }
};
struct EpiRes {
    static constexpr bool PERM = true, MIDSCALE = true;
    const bf16* base; bf16* out; const float* bias; const float* rowscale;
    __device__ __forceinline__ void side(const pg8::Unit& u, LAS unsigned char* area, int wid, int lane) const {
        if (wid < 4) side_dma(bias + u.pn * 256 + wid * 64 + lane, area + wid * 256);
        else side_dma(rowscale + u.pm * 256 + (wid - 4) * 64 + lane, area + 1024 + (wid - 4) * 256); }
    __device__ __forceinline__ void operator()(const f32x4 (&acc)[2][2][4][2], const pg8::Unit& u, int wr, int wc, int fr, int fq, const LAS unsigned char* area) const {
        const int col0 = u.pn * 256 + wc * 32 + 8 * fq;
        f32x4 bv[2][2];
#pragma unroll
        for (int bj = 0; bj < 2; ++bj)
#pragma unroll
            for (int n = 0; n < 2; ++n) bv[bj][n] = *(const LAS f32x4*)(area + 4 * (wc * 32 + 8 * fq + bj * 128 + 4 * n));
#pragma unroll
        for (int ai = 0; ai < 2; ++ai) {
            v4u xr[4][2];
#pragma unroll
            for (int m = 0; m < 4; ++m) { const size_t off = (size_t)(u.pm * 256 + ai * 128 + wr * 64 + m * 16 + fr) * D + col0;
#pragma unroll
                for (int bj = 0; bj < 2; ++bj) xr[m][bj] = *(const v4u*)(base + off + bj * 128); }
            __builtin_amdgcn_sched_barrier(0);
#pragma unroll
            for (int m = 0; m < 4; ++m) { const size_t off = (size_t)(u.pm * 256 + ai * 128 + wr * 64 + m * 16 + fr) * D + col0;
#pragma unroll
                for (int bj = 0; bj < 2; ++bj) { const v4u xw = xr[m][bj];
                    const f32x4 v0 = (f32x4){bf_lo(xw.x), bf_hi(xw.x), bf_lo(xw.y), bf_hi(xw.y)} + acc[ai][bj][m][0] + bv[bj][0], v1 = (f32x4){bf_lo(xw.z), bf_hi(xw.z), bf_lo(xw.w), bf_hi(xw.w)} + acc[ai][bj][m][1] + bv[bj][1];
                    v4u w; w.x = pk2(v0[0], v0[1]); w.y = pk2(v0[2], v0[3]); w.z = pk2(v1[0], v1[1]); w.w = pk2(v1[2], v1[3]);
                    *(v4u*)(out + off + bj * 128) = w; } }
        }
    }
};
struct EpiSwiglu {
    static constexpr bool PERM = true, MIDSCALE = false;
    unsigned char* O; const float* b1p;
    __device__ __forceinline__ void side(const pg8::Unit& u, LAS unsigned char* area, int wid, int lane) const { if (wid < 4) side_dma(b1p + (size_t)u.e * 2048 + u.pn * 256 + wid * 64 + lane, area + wid * 256); }
    __device__ __forceinline__ void operator()(const f32x4 (&acc)[2][2][4][2], const pg8::Unit& u, int wr, int wc, int fr, int fq, const LAS unsigned char* area) const {
        const int row0 = u.pm * 256 + wr * 64 + fr, ocol0 = u.pn * 128 + wc * 32 + 8 * fq;
        f32x4 bg[2], bl[2];
#pragma unroll
        for (int n = 0; n < 2; ++n) { bg[n] = *(const LAS f32x4*)(area + 4 * (wc * 32 + 8 * fq + 4 * n)); bl[n] = *(const LAS f32x4*)(area + 4 * (128 + wc * 32 + 8 * fq + 4 * n)); }
        constexpr float SI = 1.0f / (H_SCALE * W_SCALE);
#pragma unroll
        for (int ai = 0; ai < 2; ++ai)
#pragma unroll
            for (int m = 0; m < 4; ++m) { unsigned char* rowp = O + (size_t)(row0 + ai * 128 + m * 16) * 1024 + ocol0;
                f32x2 a[4];
#pragma unroll
                for (int n = 0; n < 2; ++n)
#pragma unroll
                    for (int p = 0; p < 2; ++p) {
                        const f32x2 gv = (f32x2){acc[ai][0][m][n][2 * p], acc[ai][0][m][n][2 * p + 1]} * SI + (f32x2){bg[n][2 * p], bg[n][2 * p + 1]};
                        const f32x2 lv = (f32x2){acc[ai][1][m][n][2 * p], acc[ai][1][m][n][2 * p + 1]} * SI + (f32x2){bl[n][2 * p], bl[n][2 * p + 1]};
                        const f32x2 gg = (f32x2){fminf(gv.x, 7.0f), fminf(gv.y, 7.0f)};
                        const f32x2 ll = (f32x2){__builtin_amdgcn_fmed3f(lv.x, -7.0f, 7.0f), __builtin_amdgcn_fmed3f(lv.y, -7.0f, 7.0f)};
                        const f32x2 z = gg * (-1.702f * LOG2E);
                        const f32x2 d = (f32x2){__builtin_amdgcn_exp2f(z.x), __builtin_amdgcn_exp2f(z.y)} + 1.0f;
                        const f32x2 r = (f32x2){__builtin_amdgcn_rcpf(d.x), __builtin_amdgcn_rcpf(d.y)};
                        a[2 * n + p] = (gg * r) * (ll * ACT_SCALE + ACT_SCALE); }
                v2u w; w.x = pk4_fp8(a[0].x, a[0].y, a[1].x, a[1].y); w.y = pk4_fp8(a[2].x, a[2].y, a[3].x, a[3].y);
                *(v2u*)rowp = w; }
    }
};
struct EpiMoeOut {
    static constexpr bool PERM = true, MIDSCALE = false;
    unsigned char* Y; const float* b2; const int* ltok; const float* lgate;
    __device__ __forceinline__ void side(const pg8::Unit& u, LAS unsigned char* area, int wid, int lane) const {
        if (wid < 4) { side_dma(b2 + (size_t)u.e * 1024 + u.pn * 256 + wid * 64 + lane, area + wid * 256); side_dma(ltok + (size_t)u.e * LIST_CAP + u.rb * 256 + wid * 64 + lane, area + 1024 + wid * 256); }
        else side_dma(lgate + (size_t)u.e * LIST_CAP + u.rb * 256 + (wid - 4) * 64 + lane, area + 2048 + (wid - 4) * 256); }
    __device__ __forceinline__ void operator()(const f32x4 (&acc)[2][2][4][2], const pg8::Unit& u, int wr, int wc, int fr, int fq, const LAS unsigned char* area) const {
        const int col0 = u.pn * 256 + wc * 32 + 8 * fq;
        f32x4 bv[2][2];
#pragma unroll
        for (int bj = 0; bj < 2; ++bj)
#pragma unroll
            for (int n = 0; n < 2; ++n) bv[bj][n] = *(const LAS f32x4*)(area + 4 * (wc * 32 + 8 * fq + bj * 128 + 4 * n));
#pragma unroll
        for (int ai = 0; ai < 2; ++ai)
#pragma unroll
            for (int m = 0; m < 4; ++m) { const int r = ai * 128 + wr * 64 + m * 16 + fr, pos = u.rb * 256 + r;
                const int t4 = *(const LAS int*)(area + 1024 + 4 * r); const float gt = *(const LAS float*)(area + 2048 + 4 * r) * Y_SCALE;
                if (pos < u.cnt) {
                    unsigned char* rowp = Y + (size_t)t4 * 1024 + col0;
#pragma unroll
                    for (int bj = 0; bj < 2; ++bj) { const f32x4 v0 = (acc[ai][bj][m][0] * (1.0f / (ACT_SCALE * W_SCALE)) + bv[bj][0]) * gt, v1 = (acc[ai][bj][m][1] * (1.0f / (ACT_SCALE * W_SCALE)) + bv[bj][1]) * gt;
                        v2u w; w.x = pk4_fp8(v0[0], v0[1], v0[2], v0[3]); w.y = pk4_fp8(v1[0], v1[1], v1[2], v1[3]);
                        *(v2u*)(rowp + bj * 128) = w; } } }
    }
};

__host__ __device__ __forceinline__ int win_row(int c) { if (c < 768) return c; const int cc = c - 768, ch = cc & 511; return 768 + (ch >> 7) * 256 + ((cc >> 9) & 1) * 128 + (ch & 127); }
template <int ESZ, int MODE  >
__device__ __forceinline__ void p0_item(const float* W, int N, unsigned char* WT, size_t rowpitch, LAS unsigned* scr, int kb, int nb, int lane, float scale, const float* kscale = nullptr, const float* kscale_hi = nullptr) {
    constexpr int KT = (ESZ == 2) ? 64 : 128, NT = (ESZ == 2) ? 64 : 32, LPR = NT / 4;
    const int k0 = KT * kb, n0 = NT * nb, lg = lane / LPR, nc = lane % LPR;
    const float* src = W + (size_t)(k0 + 16 * lg) * N + n0 + 4 * nc;
    f32x4 v[16];
#pragma unroll
    for (int i = 0; i < 16; ++i) v[i] = *(const f32x4*)(src + (size_t)i * N);
    if (kscale) {
#pragma unroll
        for (int i = 0; i < 16; ++i) { const int k = k0 + 16 * lg + i; v[i] = v[i] * ((kscale_hi && k >= 512) ? kscale_hi[k - 512] : kscale[k]); } }
#pragma unroll
    for (int e = 0; e < 4; ++e) {
        LAS unsigned* row = scr + (4 * nc + e) * 36;
        if (ESZ == 2) {
            v4u a, b;
            a.x = pk2(v[0][e] * scale, v[1][e] * scale); a.y = pk2(v[2][e] * scale, v[3][e] * scale); a.z = pk2(v[4][e] * scale, v[5][e] * scale); a.w = pk2(v[6][e] * scale, v[7][e] * scale);
            b.x = pk2(v[8][e] * scale, v[9][e] * scale); b.y = pk2(v[10][e] * scale, v[11][e] * scale); b.z = pk2(v[12][e] * scale, v[13][e] * scale); b.w = pk2(v[14][e] * scale, v[15][e] * scale);
            *(LAS v4u*)(row + 8 * lg) = a; *(LAS v4u*)(row + 8 * lg + 4) = b;
        } else {
            v4u a;
            a.x = pk4_fp8(v[0][e] * scale, v[1][e] * scale, v[2][e] * scale, v[3][e] * scale); a.y = pk4_fp8(v[4][e] * scale, v[5][e] * scale, v[6][e] * scale, v[7][e] * scale);
            a.z = pk4_fp8(v[8][e] * scale, v[9][e] * scale, v[10][e] * scale, v[11][e] * scale); a.w = pk4_fp8(v[12][e] * scale, v[13][e] * scale, v[14][e] * scale, v[15][e] * scale);
            *(LAS v4u*)(row + 4 * lg) = a;
        }
    }
    LDS_WAIT(); asm volatile("" ::: "memory");
    const int c = lane & 7;
#pragma unroll
    for (int j = 0; j < NT / 8; ++j) { const int n = (lane >> 3) + 8 * j; const v4u o = *(const LAS v4u*)(scr + n * 36 + 4 * c);
        const int col = n0 + n; const int row = (MODE == 1) ? ((col & ~255) + 128 * (col & 1) + ((col >> 1) & 127)) : (MODE == 2) ? win_row(col) : col;
        *(GAS v4u*)(WT + (size_t)row * rowpitch + (size_t)k0 * ESZ + 16 * c) = o; }
    LDS_WAIT(); asm volatile("" ::: "memory");
}

struct W8Item { const float* src; unsigned char* dst; int N, k0, n0, mode; };
__device__ __forceinline__ W8Item w8_item(int r, const float* w1, const float* w2, unsigned char* W1_t, unsigned char* W2_t) {
    W8Item it;
    if (r < 32 * 8 * 64) { const int e = r >> 9, q = r & 511; it.src = w1 + (size_t)e * 1024 * 2048; it.dst = W1_t + (size_t)e * 2048 * 1024; it.N = 2048; it.k0 = 128 * (q >> 6); it.n0 = 32 * (q & 63); it.mode = 1; }
    else { r -= 32 * 8 * 64; const int e = r >> 8, q = r & 255; it.src = w2 + (size_t)e * 1024 * 1024; it.dst = W2_t + (size_t)e * 1024 * 1024; it.N = 1024; it.k0 = 128 * (q >> 5); it.n0 = 32 * (q & 31); it.mode = 0; }
    return it;
}
__device__ __forceinline__ void w8_load(const W8Item& it, f32x4 (&v)[16], int lane) {
    const float* src = it.src + (size_t)(it.k0 + 16 * (lane >> 3)) * it.N + it.n0 + 4 * (lane & 7);
#pragma unroll
    for (int i = 0; i < 16; ++i) v[i] = __builtin_nontemporal_load((const f32x4*)(src + (size_t)i * it.N));
}
__device__ __forceinline__ void w8_store(const W8Item& it, const f32x4 (&v)[16], LAS unsigned* scr, int lane) {
    const int lg = lane >> 3, nc = lane & 7;
#pragma unroll
    for (int e = 0; e < 4; ++e) { v4u a;
        a.x = pk4_fp8(v[0][e] * W_SCALE, v[1][e] * W_SCALE, v[2][e] * W_SCALE, v[3][e] * W_SCALE); a.y = pk4_fp8(v[4][e] * W_SCALE, v[5][e] * W_SCALE, v[6][e] * W_SCALE, v[7][e] * W_SCALE);
        a.z = pk4_fp8(v[8][e] * W_SCALE, v[9][e] * W_SCALE, v[10][e] * W_SCALE, v[11][e] * W_SCALE); a.w = pk4_fp8(v[12][e] * W_SCALE, v[13][e] * W_SCALE, v[14][e] * W_SCALE, v[15][e] * W_SCALE);
        *(LAS v4u*)(scr + (4 * nc + e) * 36 + 4 * lg) = a; }
    LDS_WAIT(); asm volatile("" ::: "memory");
    const int c = lane & 7;
#pragma unroll
    for (int j = 0; j < 4; ++j) { const int n = (lane >> 3) + 8 * j; const v4u o = *(const LAS v4u*)(scr + n * 36 + 4 * c);
        const int col = it.n0 + n; const int row = it.mode ? ((col & ~255) + 128 * (col & 1) + ((col >> 1) & 127)) : col;
        *(GAS v4u*)(it.dst + (size_t)row * 1024 + it.k0 + 16 * c) = o; }
    LDS_WAIT(); asm volatile("" ::: "memory");
}

struct Args { const float* in[21]; float* out; unsigned char* ws; };

__global__ void __launch_bounds__(NWAVES * 64, 2) hymba_fwd(Args args) {
    extern __shared__ __attribute__((aligned(16))) unsigned char lds_raw[];
    LAS unsigned char* lds = (LAS unsigned char*)lds_raw;
    volatile LAS unsigned* MISC = (volatile LAS unsigned*)(lds + MISC_OFF);
    LAS int* TAB = (LAS int*)(lds + TAB_OFF);
    LAS int* t_rbs = TAB; LAS int* t_cnt = TAB + 40; LAS int* t_lcnt = TAB + 72; LAS int* t_gbase = TAB + 104;
#define PHASE_IDS() int tid = threadIdx.x; asm volatile("" : "+v"(tid)); const int lane = tid & 63, wave = __builtin_amdgcn_readfirstlane(tid >> 6); (void)lane; (void)wave
    const int G = gridDim.x;
    const int vcu = (G % 8 == 0) ? ((int)blockIdx.x % 8) * (G / 8) + (int)blockIdx.x / 8 : (int)blockIdx.x;

    const float* x = args.in[0]; const float* g_mix = args.in[1]; const float* w_in = args.in[2]; const float* b_in = args.in[3];
    const float* sinks = args.in[4]; const float* w_dw = args.in[5]; const float* b_dw = args.in[6]; const float* ln_g = args.in[7]; const float* ln_b = args.in[8];
    const float* g_attn = args.in[9]; const float* g_conv = args.in[10]; const float* w_out = args.in[11]; const float* b_out = args.in[12];
    const float* g_ffn = args.in[13]; const float* w_router = args.in[14]; const float* b_router = args.in[15];
    const float* w1 = args.in[16]; const float* b1 = args.in[17]; const float* w2 = args.in[18]; const float* b2 = args.in[19]; const float* g_final = args.in[20];
    float* out = args.out; unsigned char* ws = args.ws;
    unsigned* ctl = (unsigned*)(ws + WS_CTL);
    bf16* Win_t = (bf16*)(ws + WS_WIN); bf16* Wout_t = (bf16*)(ws + WS_WOUT); unsigned char* W1_t = ws + WS_W1; unsigned char* W2_t = ws + WS_W2; unsigned char* XN8 = ws + WS_XN8; bf16* X1B = (bf16*)(ws + WS_XN);
    bf16* XN = (bf16*)(ws + WS_XN); int* ltok = (int*)(ws + WS_LTOK); float* lgate = (float*)(ws + WS_LGATE); float* b1p = (float*)(ws + WS_B1P);
    float* RA = (float*)(ws + WS_RA); float* RS = RA + T; float* BINP = RS + T + 256;   bf16* WrHi = (bf16*)(ws + WS_WR); bf16* WrLo = WrHi + 32 * 1024;
    unsigned char* ACT = ws + WS_ACT; bf16* PROJ = (bf16*)(ws + WS_PROJ); bf16* MIX = (bf16*)(ws + WS_MIX); unsigned char* YB = ws + WS_Y;
    unsigned* gcnt = ctl + CW_GCNT;

    for (int u = threadIdx.x; u < (LDS_BYTES - MISC_OFF) / 4; u += NWAVES * 64) ((LAS unsigned*)(lds + MISC_OFF))[u] = 0u;
    __syncthreads();
    XcdBarrier bar = xcd_barrier_post(ctl + CW_BAR, MISC + 8);

    {
        PHASE_IDS();
        LAS unsigned* scr = (LAS unsigned*)(lds + wave * 16384);
        const int gw = vcu * NWAVES + wave, NGW = G * NWAVES;
        constexpr int I_IN = 16 * 28, I_OUT = 16 * 16;
        for (int it = gw; it < I_IN + I_OUT; it += NGW) {
            int r = it;
            if (r < I_IN) { p0_item<2, 2>(w_in, INW, (unsigned char*)Win_t, 2048, scr, r / 28, r % 28, lane, 1.0f, g_mix); continue; } r -= I_IN;
            p0_item<2, 0>(w_out, 1024, (unsigned char*)Wout_t, 2048, scr, r >> 4, r & 15, lane, 1.0f, g_attn, g_conv);
        }
        for (int m = 2 * gw; m < T; m += 2 * NGW) {
            const GAS f32x4* xr = (const GAS f32x4*)(x + (size_t)m * D) + lane;
            f32x4 v[2][4]; float s[2] = {0.f, 0.f};
#pragma unroll
            for (int q = 0; q < 2; ++q)
#pragma unroll
                for (int j = 0; j < 4; ++j) v[q][j] = __builtin_nontemporal_load(xr + q * 256 + 64 * j);
#pragma unroll
            for (int q = 0; q < 2; ++q)
#pragma unroll
                for (int j = 0; j < 4; ++j) s[q] += (v[q][j].x * v[q][j].x + v[q][j].y * v[q][j].y) + (v[q][j].z * v[q][j].z + v[q][j].w * v[q][j].w);
#pragma unroll
            for (int q = 0; q < 2; ++q) {
                const float rstd = 1.0f / sqrtf(wave_sum(s[q]) * (1.0f / D) + RMS_EPS);
                if (lane == 0) RS[m + q] = rstd;
                GAS v2u* o8 = (GAS v2u*)(XN + (size_t)(m + q) * D) + lane;
#pragma unroll
                for (int j = 0; j < 4; ++j) { v2u o; o.x = pk2(v[q][j].x, v[q][j].y); o.y = pk2(v[q][j].z, v[q][j].w); o8[64 * j] = o; }
            }
        }
        const int gt = vcu * (NWAVES * 64) + tid, NGT = G * NWAVES * 64;
        for (int i = gt; i < INW; i += NGT) BINP[win_row(i)] = b_in[i];
        for (int i = gt; i < 32 * 2048; i += NGT) { const int e = i >> 11, col = i & 2047; const int row = (col & ~255) + 128 * (col & 1) + ((col >> 1) & 127); b1p[e * 2048 + row] = b1[i]; }
        for (int i = gt; i < 32 * 1024; i += NGT) { const int e = i >> 10, k = i & 1023; const float v = w_router[k * 32 + e];
            const unsigned h = pk2(v, 0.f) & 0xffffu; const float lo = v - __uint_as_float(h << 16);
            const int fi = ((((e >> 4) * 32 + (k >> 5)) * 64 + 16 * ((k >> 3) & 3) + (e & 15)) * 8) + (k & 7);
            WrHi[fi] = (bf16)h; WrLo[fi] = (bf16)(pk2(lo, 0.f) & 0xffffu); }
    }
    xcd_barrier(bar);

    {
        const int grp = ((int)blockIdx.x >> 3) & 3;
        EpiProj E{PROJ, BINP, RS};
        {
            DenseSched S{(const char*)Win_t, T / 256, INW / 256, G, (int)blockIdx.x, 2048, 0, grp};
            pg8::gemm_phase<EpiProj, DenseSched, false>(lds, lds + EPI_OFF, (const char*)XN, 2048, S, E);
        }
        {
            PHASE_IDS();
            __syncthreads();
            LAS unsigned* scr = (LAS unsigned*)(lds + wave * 16384);
            const int gw = vcu * NWAVES + wave, NGW = G * NWAVES;
            constexpr int NIT_ALL = 32 * 8 * 64;
            int it = gw, NIT = NIT_ALL, NGW_ = NGW;
            if (G == 256) { const int c = (int)blockIdx.x; NGW_ = 1024;
                if (c >= 128) { it = (c - 128) * NWAVES + wave; NIT = 10240; } else { it = 10240 + c * NWAVES + wave; NIT = NIT_ALL; } }
            f32x4 va[16], vb[16];
            W8Item ia = w8_item(it < NIT ? it : 0, w1, w2, W1_t, W2_t), ib = ia;
            if (it < NIT) w8_load(ia, va, lane);
            while (it < NIT) {
                const int itb = it + NGW_;
                if (itb < NIT) { ib = w8_item(itb, w1, w2, W1_t, W2_t); w8_load(ib, vb, lane); }
                w8_store(ia, va, scr, lane);
                if (itb >= NIT) break;
                const int ita = itb + NGW_;
                if (ita < NIT) { ia = w8_item(ita, w1, w2, W1_t, W2_t); w8_load(ia, va, lane); }
                w8_store(ib, vb, scr, lane);
                it = ita;
            }
            __syncthreads();
        }
        {
            DenseSched S{(const char*)Win_t, T / 256, INW / 256, G, (int)blockIdx.x, 2048, grp, 1 << 30};
            pg8::gemm_phase<EpiProj, DenseSched, false>(lds, lds + EPI_OFF, (const char*)XN, 2048, S, E);
        }
    }
    xcd_barrier(bar);

    for (int unit = blockIdx.x; unit < T / 128; unit += G) {
        const int b = unit >> 4, n = unit & 15, t0 = b * SEQ + n * 128;
        {
            PHASE_IDS();
            constexpr int KOFF = 0, VOFF = 36864;
            const int i16 = lane & 15, g = lane >> 4;
            const int vq = i16 >> 2, vp = i16 & 3;
            float ssq = 0.f;
            const bf16* qrow = PROJ + (size_t)(t0 + 16 * wave + i16) * PJW + 8 * g;
            bf16* orow = MIX + (size_t)(t0 + 16 * wave + i16) * D + 4 * g;
            bf16x8 q0n = *(const bf16x8*)qrow, q1n = *(const bf16x8*)(qrow + 32);
            v4u kpre[4], vpre[4];
#define KV_LOAD(kvh) do { _Pragma("unroll") for (int c4 = 0; c4 < 4; ++c4) { const int c = tid + 512 * c4, row = c >> 3, ch = c & 7; kpre[c4] = (v4u){0u, 0u, 0u, 0u}; vpre[c4] = kpre[c4]; \
                if (n > 0 || row >= 128) { const bf16* p = PROJ + (size_t)(t0 - 128 + row) * PJW + (kvh) * 64 + ch * 8; kpre[c4] = *(const v4u*)(p + COL_K); vpre[c4] = *(const v4u*)(p + COL_V); } } } while (0)
#define KV_WRITE() do { _Pragma("unroll") for (int c4 = 0; c4 < 4; ++c4) { const int c = tid + 512 * c4, row = c >> 3, ch = c & 7; \
                *(LAS v4u*)(lds + KOFF + row * 144 + ch * 16) = kpre[c4]; *(LAS v4u*)(lds + VOFF + row * 144 + ch * 16) = vpre[c4]; } } while (0)
            KV_LOAD(0);
            __syncthreads();
            KV_WRITE();
            KV_LOAD(1);
            __syncthreads();
            for (int h = 0; h < 8; ++h) {
                if (h == 4) { __syncthreads(); KV_WRITE(); __syncthreads(); }
                const bf16x8 q0 = q0n, q1 = q1n;
                if (h < 7) { q0n = *(const bf16x8*)(qrow + (h + 1) * 64); q1n = *(const bf16x8*)(qrow + (h + 1) * 64 + 32); }
                f32x4 st[9];
#pragma unroll
                for (int j = 0; j < 9; ++j) { const LAS unsigned char* kp = lds + KOFF + (16 * (wave + j) + i16) * 144 + 16 * g;
                    const bf16x8 k0 = *(const LAS bf16x8*)kp, k1 = *(const LAS bf16x8*)(kp + 64);
                    st[j] = __builtin_amdgcn_mfma_f32_16x16x32_bf16(k0, q0, (f32x4){0.f, 0.f, 0.f, 0.f}, 0, 0, 0);
                    st[j] = __builtin_amdgcn_mfma_f32_16x16x32_bf16(k1, q1, st[j], 0, 0, 0); }
                const float NEG = -INFINITY;
#pragma unroll
                for (int j = 0; j < 9; ++j) { const bool dead = (n == 0) && (wave + j < 8);
#pragma unroll
                    for (int r = 0; r < 4; ++r) { const int kr = 4 * g + r; bool ok = !dead; if (j == 0) ok = ok && (kr > i16); if (j == 8) ok = ok && (kr <= i16); if (!ok) st[j][r] = NEG; } }
                const float sink2 = sinks[h] * LOG2E;
                float mx = sink2;
#pragma unroll
                for (int j = 0; j < 9; ++j) mx = fmaxf(fmaxf(mx, fmaxf(st[j][0], st[j][1])), fmaxf(st[j][2], st[j][3]));
                mx = fmaxf(mx, __shfl_xor(mx, 16)); mx = fmaxf(mx, __shfl_xor(mx, 32));
                float ls = 0.f;
#pragma unroll
                for (int j = 0; j < 9; ++j)
#pragma unroll
                    for (int r = 0; r < 4; ++r) { st[j][r] = __builtin_amdgcn_exp2f(st[j][r] - mx); ls += st[j][r]; }
                ls += __shfl_xor(ls, 16); ls += __shfl_xor(ls, 32);
                ls += __builtin_amdgcn_exp2f(sink2 - mx);
                const float inv = 1.0f / ls;
                bf16x8 pf[5];
#pragma unroll
                for (int kk = 0; kk < 5; ++kk) { v4u w; w.x = pk2(st[2 * kk][0], st[2 * kk][1]); w.y = pk2(st[2 * kk][2], st[2 * kk][3]);
                    if (kk < 4) { w.z = pk2(st[2 * kk + 1][0], st[2 * kk + 1][1]); w.w = pk2(st[2 * kk + 1][2], st[2 * kk + 1][3]); } else { w.z = 0u; w.w = 0u; }
                    pf[kk] = __builtin_bit_cast(bf16x8, w); }
#pragma unroll
                for (int dt = 0; dt < 4; ++dt) { f32x4 o = (f32x4){0.f, 0.f, 0.f, 0.f};
#pragma unroll
                    for (int kk = 0; kk < 5; ++kk) { const int kta = wave + 2 * kk, ktb = (kk < 4) ? wave + 2 * kk + 1 : wave + 8;
                        const LAS unsigned char* pa = lds + VOFF + (16 * kta + 4 * g + vq) * 144 + (16 * dt + 4 * vp) * 2;
                        const LAS unsigned char* pb = lds + VOFF + (16 * ktb + 4 * g + vq) * 144 + (16 * dt + 4 * vp) * 2;
                        const v4i16_t va = __builtin_amdgcn_ds_read_tr16_b64_v4i16((LAS v4i16_t*)pa), vb = __builtin_amdgcn_ds_read_tr16_b64_v4i16((LAS v4i16_t*)pb);
                        const bf16x8 vf = (bf16x8){va[0], va[1], va[2], va[3], vb[0], vb[1], vb[2], vb[3]};
                        o = __builtin_amdgcn_mfma_f32_16x16x32_bf16(vf, pf[kk], o, 0, 0, 0); }
                    o = o * inv; ssq += (o[0] * o[0] + o[1] * o[1]) + (o[2] * o[2] + o[3] * o[3]);
                    v2u w; w.x = pk2(o[0], o[1]); w.y = pk2(o[2], o[3]);
                    *(v2u*)(orow + h * 64 + 16 * dt) = w; }
            }
#undef KV_LOAD
#undef KV_WRITE
            ssq += __shfl_xor(ssq, 16); ssq += __shfl_xor(ssq, 32);
            if (g == 0) RA[t0 + 16 * wave + i16] = 1.0f / sqrtf(ssq * (1.0f / 512.0f) + RMS_EPS);
        }
        __syncthreads();
        {
            PHASE_IDS();
            const int cp = tid & 255, th = tid >> 8, c0 = 2 * cp;
            LAS float* tile = (LAS float*)lds;
            f32x2 wk[31];
#pragma unroll
            for (int j = 0; j < 31; ++j) wk[j] = *(const f32x2*)(w_dw + j * 512 + c0);
            const f32x2 bdw = *(const f32x2*)(b_dw + c0);
            const int s0 = n * 128 + 64 * th;
            const bf16* pbase = PROJ + (size_t)(b * SEQ) * PJW + COL_U + c0;
            f32x2 uu[38];
            unsigned ra_[8];
#define GLU_CVT(aw, dst) do { dst.x = bf_lo(aw); dst.y = bf_hi(aw); } while (0)
#pragma unroll
            for (int i = 0; i < 30; ++i) { const int pos = s0 - 30 + i; unsigned aw = 0u;
                if (pos >= 0) aw = *(const unsigned*)(pbase + (size_t)pos * PJW);
                GLU_CVT(aw, uu[i]); }
#pragma unroll
            for (int tt = 0; tt < 8; ++tt) { const int pos = s0 + tt; ra_[tt] = *(const unsigned*)(pbase + (size_t)pos * PJW); }
            LAS float* prm = tile + 16 * 512;
            prm[tid] = ln_g[tid]; prm[512 + tid] = ln_b[tid];
            for (int chunk = 0; chunk < 8; ++chunk) {
#pragma unroll
                for (int tt = 0; tt < 8; ++tt) GLU_CVT(ra_[tt], uu[30 + tt]);
                if (chunk < 7) {
#pragma unroll
                    for (int tt = 0; tt < 8; ++tt) { const int pos = s0 + 8 * (chunk + 1) + tt; ra_[tt] = *(const unsigned*)(pbase + (size_t)pos * PJW); }
                }
#pragma unroll
                for (int tt = 0; tt < 8; ++tt) { f32x2 a = bdw;
#pragma unroll
                    for (int j = 0; j < 31; ++j) a = a + wk[j] * uu[tt + j];
                    *(LAS f32x2*)(tile + (th * 8 + tt) * 512 + c0) = a; }
#pragma unroll
                for (int i = 0; i < 30; ++i) uu[i] = uu[i + 8];
                LDS_WAIT(); __builtin_amdgcn_s_barrier(); asm volatile("" ::: "memory");
#pragma unroll
                for (int q = 0; q < 2; ++q) { const int row = 2 * wave + q, rth = row >> 3, rtt = row & 7; const int tok = t0 + 64 * rth + 8 * chunk + rtt;
                    const f32x4 a0 = *(const LAS f32x4*)(tile + row * 512 + 8 * lane), a1 = *(const LAS f32x4*)(tile + row * 512 + 8 * lane + 4);
                    float v[8] = {a0[0], a0[1], a0[2], a0[3], a1[0], a1[1], a1[2], a1[3]};
                    float s = 0.f;
#pragma unroll
                    for (int j = 0; j < 8; ++j) s += v[j];
                    const float mean = wave_sum_dpp(s) * (1.0f / 512.0f);
                    float s2 = 0.f;
#pragma unroll
                    for (int j = 0; j < 8; ++j) { v[j] -= mean; s2 += v[j] * v[j]; }
                    const float rstd = 1.0f / sqrtf(wave_sum_dpp(s2) * (1.0f / 512.0f) + LN_EPS);
                    const f32x4 lg0 = *(const LAS f32x4*)(prm + 8 * lane), lg1 = *(const LAS f32x4*)(prm + 8 * lane + 4), lb0 = *(const LAS f32x4*)(prm + 512 + 8 * lane), lb1 = *(const LAS f32x4*)(prm + 512 + 8 * lane + 4);
                    const float lgv[8] = {lg0[0], lg0[1], lg0[2], lg0[3], lg1[0], lg1[1], lg1[2], lg1[3]}, lbv[8] = {lb0[0], lb0[1], lb0[2], lb0[3], lb1[0], lb1[1], lb1[2], lb1[3]};
                    float s3 = 0.f;
#pragma unroll
                    for (int j = 0; j < 8; ++j) { const float y = v[j] * rstd * lgv[j] + lbv[j]; const float z = y * __builtin_amdgcn_rcpf(1.0f + __builtin_amdgcn_exp2f(-y * LOG2E)); v[j] = z; s3 += z * z; }
                    const float rc = 1.0f / sqrtf(wave_sum_dpp(s3) * (1.0f / 512.0f) + RMS_EPS);
                    v4u w; w.x = pk2(v[0] * rc, v[1] * rc); w.y = pk2(v[2] * rc, v[3] * rc); w.z = pk2(v[4] * rc, v[5] * rc); w.w = pk2(v[6] * rc, v[7] * rc);
                    *(v4u*)(MIX + (size_t)tok * D + 512 + 8 * lane) = w; }
                LDS_WAIT(); __builtin_amdgcn_s_barrier(); asm volatile("" ::: "memory");
            }
#undef GLU_CVT
        }
    }
    xcd_barrier(bar);

    {
        const int grp = ((int)blockIdx.x >> 3) % 3;
        EpiRes E{XN, X1B, b_out, RA};
        {
            DenseSched S{(const char*)Wout_t, T / 256, D / 256, G, (int)blockIdx.x, 2048, 0, grp};
            pg8::gemm_phase<EpiRes, DenseSched, false>(lds, lds + EPI_OFF, (const char*)MIX, 2048, S, E);
        }
        {
            PHASE_IDS();
            __syncthreads();
            LAS unsigned* scr = (LAS unsigned*)(lds + wave * 16384);
            const int gw = vcu * NWAVES + wave, NGW = G * NWAVES;
            constexpr int NIT0 = 32 * 8 * 64, NIT = NIT0 + 32 * 8 * 32;
            f32x4 va[16], vb[16];
            int it = NIT0 + gw;
            W8Item ia = w8_item(it < NIT ? it : NIT0, w1, w2, W1_t, W2_t), ib = ia;
            if (it < NIT) w8_load(ia, va, lane);
            while (it < NIT) {
                const int itb = it + NGW;
                if (itb < NIT) { ib = w8_item(itb, w1, w2, W1_t, W2_t); w8_load(ib, vb, lane); }
                w8_store(ia, va, scr, lane);
                if (itb >= NIT) break;
                const int ita = itb + NGW;
                if (ita < NIT) { ia = w8_item(ita, w1, w2, W1_t, W2_t); w8_load(ia, va, lane); }
                w8_store(ib, vb, scr, lane);
                it = ita;
            }
            __syncthreads();
        }
        {
            DenseSched S{(const char*)Wout_t, T / 256, D / 256, G, (int)blockIdx.x, 2048, grp, 1 << 30};
            pg8::gemm_phase<EpiRes, DenseSched, false>(lds, lds + EPI_OFF, (const char*)MIX, 2048, S, E);
        }
    }
    xcd_barrier(bar);

    {
        PHASE_IDS();
        if (wave < 4) __builtin_amdgcn_global_load_lds((const unsigned*)((const char*)g_ffn + wave * 1024 + lane * 16), (LAS unsigned*)(lds + P4_G_OFF + wave * 1024), 16, 0, 0);
#pragma unroll
        for (int i = 0; i < 16; ++i) __builtin_amdgcn_global_load_lds((const unsigned*)((const char*)WrHi + (size_t)(wave * 16 + i) * 1024 + lane * 16), (LAS unsigned*)(lds + (wave * 16 + i) * 1024), 16, 0, 0);
        VM_WAIT(); __syncthreads();
    }
    for (int unit = blockIdx.x; unit < T / 128; unit += G) {
        PHASE_IDS();
        const int i16 = lane & 15, g = lane >> 4;
        if (tid < 32) t_lcnt[tid] = 0;
        __syncthreads();
        const int tok = unit * 128 + wave * 16 + i16;
        const bf16* xr = X1B + (size_t)tok * D + 8 * g;
        float ss = 0.f;
#pragma unroll 8
        for (int s = 0; s < 32; ++s) { const v4u a = *(const v4u*)(xr + 32 * s);
            const float a0 = bf_lo(a.x), a1 = bf_hi(a.x), a2 = bf_lo(a.y), a3 = bf_hi(a.y), a4 = bf_lo(a.z), a5 = bf_hi(a.z), a6 = bf_lo(a.w), a7 = bf_hi(a.w);
            ss += (a0 * a0 + a1 * a1) + (a2 * a2 + a3 * a3) + (a4 * a4 + a5 * a5) + (a6 * a6 + a7 * a7); }
        ss += __shfl_xor(ss, 16); ss += __shfl_xor(ss, 32);
        const float rstd = 1.0f / sqrtf(ss * (1.0f / D) + RMS_EPS);
        f32x4 acc0 = (f32x4){0.f, 0.f, 0.f, 0.f}, acc1 = acc0;
        {
        unsigned char* hrow = XN8 + (size_t)tok * D + 8 * g;
        const bf16* wh0 = WrHi + lane * 8; const bf16* wl0 = WrLo + lane * 8;
        for (int s8 = 0; s8 < 4; ++s8) {
            v4u xc[8];
#pragma unroll
            for (int q = 0; q < 8; ++q) xc[q] = *(const v4u*)(xr + 32 * (8 * s8 + q));
            __builtin_amdgcn_sched_barrier(0);
#pragma unroll
            for (int q = 0; q < 8; ++q) { const int s = 8 * s8 + q; const v4u xa = xc[q];
            const f32x4 a = (f32x4){bf_lo(xa.x), bf_hi(xa.x), bf_lo(xa.y), bf_hi(xa.y)} * rstd * *(const LAS f32x4*)((const LAS float*)(lds + P4_G_OFF) + 8 * g + 32 * s), b = (f32x4){bf_lo(xa.z), bf_hi(xa.z), bf_lo(xa.w), bf_hi(xa.w)} * rstd * *(const LAS f32x4*)((const LAS float*)(lds + P4_G_OFF) + 8 * g + 32 * s + 4);
            v4u hp; hp.x = pk2(a[0], a[1]); hp.y = pk2(a[2], a[3]); hp.z = pk2(b[0], b[1]); hp.w = pk2(b[2], b[3]);
            v4u lp; lp.x = pk2(a[0] - bf_lo(hp.x), a[1] - bf_hi(hp.x)); lp.y = pk2(a[2] - bf_lo(hp.y), a[3] - bf_hi(hp.y)); lp.z = pk2(b[0] - bf_lo(hp.z), b[1] - bf_hi(hp.z)); lp.w = pk2(b[2] - bf_lo(hp.w), b[3] - bf_hi(hp.w));
            const bf16x8 hh = __builtin_bit_cast(bf16x8, hp), hl = __builtin_bit_cast(bf16x8, lp);
            const LAS unsigned char* wf = lds + lane * 16; const bf16x8 whA = *(const LAS bf16x8*)(wf + (0 * 32 + s) * 1024), whB = *(const LAS bf16x8*)(wf + (1 * 32 + s) * 1024), wlA = *(const LAS bf16x8*)(wf + (2 * 32 + s) * 1024), wlB = *(const LAS bf16x8*)(wf + (3 * 32 + s) * 1024);
            acc0 = __builtin_amdgcn_mfma_f32_16x16x32_bf16(whA, hh, acc0, 0, 0, 0); acc0 = __builtin_amdgcn_mfma_f32_16x16x32_bf16(whA, hl, acc0, 0, 0, 0); acc0 = __builtin_amdgcn_mfma_f32_16x16x32_bf16(wlA, hh, acc0, 0, 0, 0);
            acc1 = __builtin_amdgcn_mfma_f32_16x16x32_bf16(whB, hh, acc1, 0, 0, 0); acc1 = __builtin_amdgcn_mfma_f32_16x16x32_bf16(whB, hl, acc1, 0, 0, 0); acc1 = __builtin_amdgcn_mfma_f32_16x16x32_bf16(wlB, hh, acc1, 0, 0, 0); }
        }
        }
        {
            unsigned char* hrow = XN8 + (size_t)tok * D + 8 * g;
            const float rs8 = rstd * H_SCALE;
            for (int s8 = 0; s8 < 4; ++s8) {
                v4u xc[8];
#pragma unroll
                for (int q = 0; q < 8; ++q) xc[q] = *(const v4u*)(xr + 32 * (8 * s8 + q));
                __builtin_amdgcn_sched_barrier(0);
#pragma unroll
                for (int q = 0; q < 8; ++q) { const int s = 8 * s8 + q; const v4u xa = xc[q];
                    const f32x4 a = (f32x4){bf_lo(xa.x), bf_hi(xa.x), bf_lo(xa.y), bf_hi(xa.y)} * rs8 * *(const LAS f32x4*)((const LAS float*)(lds + P4_G_OFF) + 8 * g + 32 * s), b = (f32x4){bf_lo(xa.z), bf_hi(xa.z), bf_lo(xa.w), bf_hi(xa.w)} * rs8 * *(const LAS f32x4*)((const LAS float*)(lds + P4_G_OFF) + 8 * g + 32 * s + 4);
                    v2u h8; h8.x = pk4_fp8(a[0], a[1], a[2], a[3]); h8.y = pk4_fp8(b[0], b[1], b[2], b[3]); *(v2u*)(hrow + 32 * s) = h8; }
            }
        }
        LAS float* sc = (LAS float*)(lds + EPI_OFF + wave * 2112);
#pragma unroll
        for (int r = 0; r < 4; ++r) { sc[i16 * 33 + 4 * g + r] = acc0[r] + b_router[4 * g + r]; sc[i16 * 33 + 16 + 4 * g + r] = acc1[r] + b_router[16 + 4 * g + r]; }
        LDS_WAIT(); asm volatile("" ::: "memory");
        int idx[4], rank[4]; float gate[4];
        if (lane < 16) {
            float v[32];
#pragma unroll
            for (int e = 0; e < 32; ++e) v[e] = sc[lane * 33 + e];
            float val[4];
#pragma unroll
            for (int k = 0; k < 4; ++k) { float best = -INFINITY; int bi = 0;
#pragma unroll
                for (int e = 0; e < 32; ++e) if (v[e] > best) { best = v[e]; bi = e; }
                val[k] = best; idx[k] = bi;
#pragma unroll
                for (int e = 0; e < 32; ++e) v[e] = (e == bi) ? -INFINITY : v[e]; }
            float den = 0.f;
#pragma unroll
            for (int k = 0; k < 4; ++k) { gate[k] = __expf(val[k] - val[0]); den += gate[k]; }
            const float rden = 1.0f / den;
#pragma unroll
            for (int k = 0; k < 4; ++k) { gate[k] *= rden; rank[k] = atomicAdd((int*)(t_lcnt + idx[k]), 1); }
        }
        __syncthreads();
        if (tid < 32) { const int c = t_lcnt[tid]; t_gbase[tid] = c ? (int)__hip_atomic_fetch_add(gcnt + 16 * tid, (unsigned)c, __ATOMIC_RELAXED, __HIP_MEMORY_SCOPE_AGENT) : 0; }
        __syncthreads();
        if (lane < 16) {
            const int tk = unit * 128 + wave * 16 + lane;
#pragma unroll
            for (int k = 0; k < 4; ++k) { const int pos = t_gbase[idx[k]] + rank[k]; ltok[idx[k] * LIST_CAP + pos] = tk * 4 + k; lgate[idx[k] * LIST_CAP + pos] = gate[k]; }
        }
        __syncthreads();
    }
    xcd_barrier(bar);

    if (threadIdx.x < 32) t_cnt[threadIdx.x] = (int)__hip_atomic_load(gcnt + 16 * threadIdx.x, __ATOMIC_RELAXED, __HIP_MEMORY_SCOPE_AGENT);
    __syncthreads();
    if (threadIdx.x == 0) { int s = 0; for (int e = 0; e < 32; ++e) { t_rbs[e] = s; s += (t_cnt[e] + 255) >> 8; } t_rbs[32] = s; }
    __syncthreads();
    const int NB = __builtin_amdgcn_readfirstlane(t_rbs[32]);

    {
        MoeSched<true> S{(const char*)W1_t, (size_t)2048 * 1024, ltok, t_rbs, t_cnt, NB, 8, G, (int)blockIdx.x, 1024};
        EpiSwiglu E{ACT, b1p};
        pg8::gemm_phase<EpiSwiglu, MoeSched<true>, true>(lds, lds + EPI_OFF, (const char*)XN8, 1024, S, E);
    }
    xcd_barrier(bar);

    {
        MoeSched<false> S{(const char*)W2_t, (size_t)1024 * 1024, ltok, t_rbs, t_cnt, NB, 4, G, (int)blockIdx.x, 1024};
        EpiMoeOut E{YB, b2, ltok, lgate};
        pg8::gemm_phase<EpiMoeOut, MoeSched<false>, true, false>(lds, lds + EPI_OFF, (const char*)ACT, 1024, S, E);
    }
    xcd_barrier(bar);

    {
        PHASE_IDS();
        const int gw = vcu * NWAVES + wave, NGW = G * NWAVES;
        f32x4 gfin[4];
#pragma unroll
        for (int j = 0; j < 4; ++j) gfin[j] = *((const f32x4*)g_final + lane + 64 * j);
        for (int m0 = 2 * gw; m0 < T; m0 += 2 * NGW) {
            v2u xw_[2][4]; unsigned yw[2][4][4];
#pragma unroll
            for (int q = 0; q < 2; ++q) { const GAS v2u* xr = (const GAS v2u*)(X1B + (size_t)(m0 + q) * D) + lane;
#pragma unroll
                for (int j = 0; j < 4; ++j) xw_[q][j] = __builtin_nontemporal_load(xr + 64 * j);
#pragma unroll
                for (int k = 0; k < 4; ++k) { const GAS unsigned* yr = (const GAS unsigned*)(YB + ((size_t)(m0 + q) * 4 + k) * D) + lane;
#pragma unroll
                    for (int j = 0; j < 4; ++j) yw[q][k][j] = __builtin_nontemporal_load(yr + 64 * j); } }
#pragma unroll
            for (int q = 0; q < 2; ++q) {
                f32x4 v[4];
#pragma unroll
                for (int j = 0; j < 4; ++j) v[j] = (f32x4){bf_lo(xw_[q][j].x), bf_hi(xw_[q][j].x), bf_lo(xw_[q][j].y), bf_hi(xw_[q][j].y)};
#pragma unroll
                for (int k = 0; k < 4; ++k)
#pragma unroll
                    for (int j = 0; j < 4; ++j) { const f32x2 lo = __builtin_amdgcn_cvt_pk_f32_fp8((int)yw[q][k][j], false), hi = __builtin_amdgcn_cvt_pk_f32_fp8((int)yw[q][k][j], true);
                        v[j].x += lo.x * (1.0f / Y_SCALE); v[j].y += lo.y * (1.0f / Y_SCALE); v[j].z += hi.x * (1.0f / Y_SCALE); v[j].w += hi.y * (1.0f / Y_SCALE); }
                float s = 0.f;
#pragma unroll
                for (int j = 0; j < 4; ++j) s += (v[j].x * v[j].x + v[j].y * v[j].y) + (v[j].z * v[j].z + v[j].w * v[j].w);
                const float rstd = 1.0f / sqrtf(wave_sum_dpp(s) * (1.0f / D) + RMS_EPS);
                GAS f32x4* xw = (GAS f32x4*)(out + (size_t)(m0 + q) * D) + lane;
#pragma unroll
                for (int j = 0; j < 4; ++j) __builtin_nontemporal_store(v[j] * rstd * gfin[j], xw + 64 * j);
            }
        }
    }
}

extern "C" void kernel_launch(void* const* d_in, const int* in_sizes, int n_in, void* d_out, int out_size, void* d_ws, size_t ws_size, hipStream_t stream) {
    static int grid = 0;
    if (grid == 0) {
        if (n_in != 21 || in_sizes[0] != T * D || out_size != T * D || ws_size < WS_END) { fprintf(stderr, "kernel_launch: unexpected shapes (n_in %d, in0 %d, out %d, ws %zu)\n", n_in, n_in > 0 ? in_sizes[0] : -1, out_size, ws_size); grid = -1; return; }
        int dev = 0, cus = 0, per_cu = 0;
        if (hipGetDevice(&dev) != hipSuccess || hipDeviceGetAttribute(&cus, hipDeviceAttributeMultiprocessorCount, dev) != hipSuccess) { grid = -1; return; }
        if (hipFuncSetAttribute((const void*)hymba_fwd, hipFuncAttributeMaxDynamicSharedMemorySize, LDS_BYTES) != hipSuccess) { fprintf(stderr, "kernel_launch: hipFuncSetAttribute failed\n"); grid = -1; return; }
        if (hipOccupancyMaxActiveBlocksPerMultiprocessor(&per_cu, (const void*)hymba_fwd, NWAVES * 64, LDS_BYTES) != hipSuccess || per_cu < 1)
            fprintf(stderr, "kernel_launch: occupancy query reports %d workgroups per CU\n", per_cu);
        (void)hipGetLastError();
        grid = cus;
    }
    if (grid < 0) return;
    if (hipMemsetAsync((char*)d_ws + WS_CTL, 0, CTL_ZERO_BYTES, stream) != hipSuccess) return;
    Args a{};
    for (int i = 0; i < 21; ++i) a.in[i] = (const float*)d_in[i];
    a.out = (float*)d_out; a.ws = (unsigned char*)d_ws;
    hipLaunchKernelGGL(hymba_fwd, dim3(grid), dim3(NWAVES * 64), LDS_BYTES, stream, a);
}
```

```cpp
#include <hip/hip_runtime.h>
#include <cstdio>
#include <cstdint>

namespace pg8 {
#define PG8_LAS __attribute__((address_space(3)))
typedef unsigned short bf16_t;
typedef short bf16x8 __attribute__((ext_vector_type(8)));
typedef float f32x4 __attribute__((ext_vector_type(4)));
typedef unsigned u32x4 __attribute__((ext_vector_type(4)));
constexpr int BM = 256, BK = 64, HALF = 128, HTB = HALF * BK * 2, STAGE_BYTES = 8 * HTB, NXCD = 8, WGM = 8;

__host__ __device__ __forceinline__ int lds_byte(int r, int c) { const int st = (r >> 4) * 2 + (c >> 5), rr = r & 15, cc = c & 31, ob = rr * 64 + cc * 2; return st * 1024 + (ob ^ (((ob >> 9) & 1) << 5)); }
__host__ __device__ __forceinline__ void stage_rc(int b, int& R, int& C) { const int st = b / 1024, sb = b % 1024, swz = sb ^ (((sb >> 9) & 1) << 5); R = (st >> 1) * 16 + swz / 64; C = (st & 1) * 32 + (swz % 64) / 2; }
__host__ __device__ __forceinline__ int perm32(int rho) { const int n = rho >> 4, i = rho & 15; return 8 * (i >> 2) + 4 * n + (i & 3); }

struct Unit { int pm, pn, e, rb, cnt; };

__device__ __forceinline__ bool static_order(int i, int G, int c, int nM, int nN, int& pm, int& pn) {
    const int nwg = nM * nN; const long L = (long)i * G + c; if (L >= nwg) return false;
    int wgid = (int)L; { const int q = nwg / NXCD, r = nwg % NXCD, xcd = wgid % NXCD, off = wgid / NXCD; wgid = (xcd < r ? xcd * (q + 1) : r * (q + 1) + (xcd - r) * q) + off; }
    const int nig = WGM * nN, gid = wgid / nig, fm = gid * WGM, gsz = (nM - fm) < WGM ? (nM - fm) : WGM;
    pm = fm + ((wgid % nig) % gsz); pn = (wgid % nig) / gsz; return true;
}

__device__ __forceinline__ unsigned cvt_pk_bf16(float lo, float hi) { unsigned r; asm volatile("v_cvt_pk_bf16_f32 %0, %1, %2" : "=v"(r) : "v"(lo), "v"(hi)); return r; }

typedef int i32x8 __attribute__((ext_vector_type(8)));
typedef int i32x4v __attribute__((ext_vector_type(4)));
template <class Epi, class Sched, bool FP8, bool ALIGN = true>
__device__ __forceinline__ void gemm_phase(PG8_LAS unsigned char* lds, PG8_LAS unsigned char* epi, const char* Abase, const int rp, const Sched& S, const Epi& E) {
    int tid = threadIdx.x; asm volatile("" : "+v"(tid));
    const int wid = __builtin_amdgcn_readfirstlane(tid >> 6), lane = tid & 63, wr = wid >> 2, wc = wid & 3, fr = lane & 15, fq = lane >> 4;
    const int nt = rp / 128;
    int RA[2]; unsigned CA2[2], voffB[2];
#pragma unroll
    for (int i = 0; i < 2; ++i) { int R, C; stage_rc(tid * 16 + i * 8192, R, C); const int Rb = Epi::PERM ? ((R & ~31) + perm32(R & 31)) : R;
        RA[i] = R; CA2[i] = (unsigned)C * 2u; voffB[i] = (unsigned)(Rb * rp + C * 2); }
    const size_t kstep = (size_t)(BK * 2);
    const size_t hstepB = (size_t)HALF * rp;
    const unsigned ldsw = (unsigned)wid * 1024u;
    const int aoff = lds_byte(wr * 64 + fr, fq * 8), boff = lds_byte(wc * 32 + fr, fq * 8);
#define PG8_SA(b, h) (((b) * 2 + (h)) * HTB)
#define PG8_SB(b, h) ((4 + (b) * 2 + (h)) * HTB)
#define PG8_STAGE(bufoff, gbase, voff) do { _Pragma("unroll") for (int _i = 0; _i < 2; ++_i) { unsigned _vo = (voff)[_i]; asm volatile("" : "+v"(_vo));   \
        __builtin_amdgcn_global_load_lds((const unsigned*)((const char*)(gbase) + _vo), (PG8_LAS unsigned*)(lds + (bufoff) + ldsw + _i * 8192), 16, 0, 0); } } while (0)
#define PG8_LDA(dst, b, h) do { _Pragma("unroll") for (int m = 0; m < 4; ++m) _Pragma("unroll") for (int k = 0; k < 2; ++k) dst[m][k] = *(const PG8_LAS bf16x8*)(lds + PG8_SA(b, h) + aoff + m * 2048 + k * 1024); } while (0)
#define PG8_LDB(dst, b, h) do { _Pragma("unroll") for (int n = 0; n < 2; ++n) _Pragma("unroll") for (int k = 0; k < 2; ++k) dst[n][k] = *(const PG8_LAS bf16x8*)(lds + PG8_SB(b, h) + boff + n * 2048 + k * 1024); } while (0)
#define PG8_CAT8(x) __builtin_shufflevector(__builtin_bit_cast(i32x4v, x[0]), __builtin_bit_cast(i32x4v, x[1]), 0, 1, 2, 3, 4, 5, 6, 7)
#define PG8_MMA_(ai, bj, At, Bt, Z) do { __builtin_amdgcn_s_setprio(1); \
        if constexpr (FP8) { _Pragma("unroll") for (int m = 0; m < 4; ++m) _Pragma("unroll") for (int n = 0; n < 2; ++n) \
            { const i32x8 _b = PG8_CAT8(Bt[n]), _a = PG8_CAT8(At[m]);   \
              if (Z) asm volatile("v_mfma_f32_16x16x128_f8f6f4 %0, %1, %2, 0" : "=&v"(acc[ai][bj][m][n]) : "v"(_b), "v"(_a)); \
              else asm volatile("v_mfma_f32_16x16x128_f8f6f4 %0, %1, %2, %0" : "+v"(acc[ai][bj][m][n]) : "v"(_b), "v"(_a)); } } \
        else { _Pragma("unroll") for (int m = 0; m < 4; ++m) _Pragma("unroll") for (int n = 0; n < 2; ++n) _Pragma("unroll") for (int k = 0; k < 2; ++k) \
            acc[ai][bj][m][n] = __builtin_amdgcn_mfma_f32_16x16x32_bf16(Bt[n][k], At[m][k], acc[ai][bj][m][n], 0, 0, 0); } \
        __builtin_amdgcn_s_setprio(0); } while (0)
#define PG8_MMA(ai, bj, At, Bt) PG8_MMA_(ai, bj, At, Bt, false)
#define PG8_MMA0(ai, bj, At, Bt) do { if (FP8 && first) PG8_MMA_(ai, bj, At, Bt, true); else PG8_MMA_(ai, bj, At, Bt, false); } while (0)
#define PG8_WAIT_V(n) asm volatile("s_waitcnt vmcnt(" #n ")" ::: "memory")
#define PG8_WAIT_L(n) asm volatile("s_waitcnt lgkmcnt(" #n ")" ::: "memory")
#define PG8_BAR __builtin_amdgcn_s_barrier()
#define PG8_SCHED __builtin_amdgcn_sched_barrier(0)
#define PG8_ZERO() do { if constexpr (!FP8) { _Pragma("unroll") for (int a = 0; a < 2; ++a) _Pragma("unroll") for (int b = 0; b < 2; ++b) _Pragma("unroll") for (int m = 0; m < 4; ++m) _Pragma("unroll") for (int n = 0; n < 2; ++n) acc[a][b][m][n] = (f32x4){0.f, 0.f, 0.f, 0.f}; } } while (0)
#define PG8_VA(dst, u) do { _Pragma("unroll") for (int _h = 0; _h < 2; ++_h) _Pragma("unroll") for (int _i = 0; _i < 2; ++_i) dst[_h][_i] = S.a_off(u, _h * HALF + RA[_i]) + CA2[_i]; } while (0)
    Unit cur, nxt; int ui = 0;
    if (!S.next(0, cur)) return;
    f32x4 acc[2][2][4][2];
    PG8_ZERO();
    bf16x8 At[4][2], B0[2][2], B1[2][2];
    unsigned cvA[2][2], nvA[2][2];
    float rs[2][4];
    PG8_VA(cvA, cur);
    const char* cB = S.b_tile(cur);
    const char* cA = Abase + S.a_base(cur);
    E.side(cur, epi, wid, lane);
    PG8_STAGE(PG8_SB(0, 0), cB, voffB); PG8_STAGE(PG8_SB(0, 1), cB + hstepB, voffB); PG8_STAGE(PG8_SA(0, 0), cA, cvA[0]); PG8_STAGE(PG8_SA(0, 1), cA, cvA[1]);
    if (wr == 1) PG8_BAR;
    PG8_WAIT_V(2); PG8_BAR;
    PG8_STAGE(PG8_SB(1, 0), cB + kstep, voffB); PG8_STAGE(PG8_SA(1, 0), cA + kstep, cvA[0]); PG8_STAGE(PG8_SB(1, 1), cB + hstepB + kstep, voffB);
    PG8_WAIT_V(6); PG8_BAR;
    for (;;) {
        const bool has_next = S.next(ui + 1, nxt);
        if constexpr (Sched::GATHER) { if (has_next) S.gather_dma(nxt, epi + ((ui + 1) & 1) * 4096 + 3072, wid, lane); }
        const char* nB = has_next ? S.b_tile(nxt) : cB;
        const char* nA = has_next ? Abase + S.a_base(nxt) : cA;
        PG8_LAS unsigned char* area = epi + (ui & 1) * 4096;
        for (int t = 0; t < nt; t += 2) {
            const bool last = (t == nt - 2), first = (t == 0);
            if constexpr (Epi::MIDSCALE) { if (t == nt / 2) {
#pragma unroll
                for (int a = 0; a < 2; ++a)
#pragma unroll
                    for (int m = 0; m < 4; ++m) rs[a][m] = *(const PG8_LAS float*)(area + 1024 + 4 * (a * 128 + wr * 64 + m * 16 + fr));
#pragma unroll
                for (int a = 0; a < 2; ++a)
#pragma unroll
                    for (int b = 0; b < 2; ++b)
#pragma unroll
                        for (int m = 0; m < 4; ++m)
#pragma unroll
                            for (int n = 0; n < 2; ++n) acc[a][b][m][n] = acc[a][b][m][n] * rs[a][m]; } }
            const char* a1 = cA + (size_t)(t + 1) * kstep;
            const char* a2 = last ? nA : cA + (size_t)(t + 2) * kstep; const char* b2 = last ? nB : cB + (size_t)(t + 2) * kstep;
            const char* a3 = a2 + kstep; const char* b3 = b2 + kstep;
            if constexpr (Sched::GATHER) { if (last) {
#pragma unroll
                for (int h = 0; h < 2; ++h)
#pragma unroll
                    for (int i = 0; i < 2; ++i) nvA[h][i] = has_next ? S.a_fin(nxt, h * HALF + RA[i], *(const PG8_LAS int*)(epi + ((ui + 1) & 1) * 4096 + 3072 + 4 * (h * HALF + RA[i]))) + CA2[i] : cvA[h][i]; } }
            unsigned sA[2][2];
#pragma unroll
            for (int h = 0; h < 2; ++h)
#pragma unroll
                for (int i = 0; i < 2; ++i) sA[h][i] = (Sched::GATHER && last) ? nvA[h][i] : cvA[h][i];
            PG8_LDB(B0, 0, 0); PG8_LDB(B1, 0, 1); PG8_SCHED; PG8_LDA(At, 0, 0); PG8_STAGE(PG8_SA(1, 1), a1, cvA[1]);
            PG8_WAIT_V(8); PG8_WAIT_L(0); PG8_BAR; PG8_MMA0(0, 0, At, B0); PG8_MMA0(0, 1, At, B1); PG8_BAR; PG8_SCHED;
            PG8_LDA(At, 0, 1); PG8_STAGE(PG8_SB(0, 0), b2, voffB); PG8_STAGE(PG8_SB(0, 1), b2 + hstepB, voffB); PG8_STAGE(PG8_SA(0, 0), a2, sA[0]);
            PG8_WAIT_V(8); PG8_WAIT_L(0); PG8_BAR; PG8_MMA0(1, 0, At, B0); PG8_MMA0(1, 1, At, B1); PG8_BAR; PG8_SCHED;
            PG8_LDB(B0, 1, 0); PG8_LDB(B1, 1, 1); PG8_SCHED; PG8_LDA(At, 1, 0); PG8_STAGE(PG8_SA(0, 1), a2, sA[1]);
            PG8_WAIT_V(8); PG8_WAIT_L(0); PG8_BAR; PG8_MMA(0, 0, At, B0); PG8_MMA(0, 1, At, B1); PG8_BAR; PG8_SCHED;
            PG8_LDA(At, 1, 1); PG8_STAGE(PG8_SB(1, 0), b3, voffB); PG8_STAGE(PG8_SB(1, 1), b3 + hstepB, voffB); PG8_STAGE(PG8_SA(1, 0), a3, sA[0]);
            PG8_WAIT_V(8); PG8_WAIT_L(0); PG8_BAR; PG8_MMA(1, 0, At, B0); PG8_MMA(1, 1, At, B1); PG8_BAR; PG8_SCHED;
        }
        if constexpr (ALIGN) { if (wr == 0) PG8_BAR; }
        if constexpr (FP8) asm volatile("s_nop 15\n\ts_nop 15" ::: "memory");
        E(acc, cur, wr, wc, fr, fq, area);
        if (!has_next) break;
        PG8_ZERO();
        cur = nxt; cB = nB; cA = nA; ++ui;
        E.side(cur, epi + (ui & 1) * 4096, wid, lane);
        if constexpr (Sched::GATHER) {
#pragma unroll
            for (int h = 0; h < 2; ++h)
#pragma unroll
                for (int i = 0; i < 2; ++i) cvA[h][i] = nvA[h][i]; }
        if constexpr (ALIGN) { if (wr == 1) PG8_BAR; }
    }
    PG8_WAIT_V(0);
    if constexpr (!ALIGN) { if (wr == 0) PG8_BAR; }
    PG8_BAR;
#undef PG8_SA
#undef PG8_SB
#undef PG8_STAGE
#undef PG8_LDA
#undef PG8_LDB
#undef PG8_MMA
#undef PG8_MMA_
#undef PG8_MMA0
#undef PG8_CAT8
#undef PG8_WAIT_V
#undef PG8_WAIT_L
#undef PG8_BAR
#undef PG8_SCHED
#undef PG8_ZERO
#undef PG8_VA
}
}

constexpr int NWAVES = 8;
constexpr int T = 32768, SEQ = 2048, D = 1024, INW = 1792, NEXP = 32, TOPK = 4;
constexpr int COL_K = 512, COL_V = 640, COL_U = 768;
constexpr int PJW = 1280;
constexpr float RMS_EPS = 1e-5f, LN_EPS = 1e-5f;
constexpr float LOG2E = 1.4426950408889634f;
constexpr float QSCALE = 0.125f * LOG2E;
constexpr int LIST_CAP = 32768;
constexpr int MAX_RB = 544;

constexpr size_t MiB = 1u << 20;
constexpr size_t WS_CTL = 0, CTL_ZERO_BYTES = 16 * 1024;
constexpr size_t WS_WIN = 2 * MiB;
constexpr size_t WS_WOUT = 6 * MiB;
constexpr size_t WS_W1 = 8 * MiB;
constexpr size_t WS_W2 = 136 * MiB;
constexpr size_t WS_XN = 200 * MiB;
constexpr size_t WS_LTOK = 264 * MiB;
constexpr size_t WS_LGATE = 268 * MiB;
constexpr size_t WS_B1P = 272 * MiB;
constexpr size_t WS_RA = 272 * MiB + 512 * 1024;
constexpr size_t WS_WR = 273 * MiB;
constexpr size_t WS_ACT = 274 * MiB;
constexpr size_t WS_PROJ = 546 * MiB;
constexpr size_t WS_MIX = 658 * MiB;
constexpr size_t WS_Y = 546 * MiB;
constexpr size_t WS_XN8 = 674 * MiB;
constexpr size_t WS_END = 802 * MiB;
static_assert(WS_ACT + (size_t)MAX_RB * 256 * 1024 * 2 <= WS_PROJ && WS_MIX + (size_t)T * 1024 * 2 <= WS_END && WS_Y + (size_t)T * 4 * 1024 * 2 <= WS_END, "ws map");
constexpr int CW_BAR = 0;
constexpr int CW_GCNT = 3584;
static_assert((CW_BAR + 3456) * 4 <= (int)CTL_ZERO_BYTES && (CW_GCNT + 32 * 16) * 4 <= (int)CTL_ZERO_BYTES, "control words inside the per-call memset");

constexpr int RING_BYTES = 131072;
constexpr int MISC_OFF = RING_BYTES;
constexpr int TAB_OFF = MISC_OFF + 256;
constexpr int EPI_OFF = RING_BYTES + 2048;
constexpr int P4_G_OFF = EPI_OFF + 8 * 2112;
constexpr int LDS_BYTES = 154624;

#define GAS __attribute__((address_space(1)))
#define LAS __attribute__((address_space(3)))
typedef unsigned short bf16;
typedef unsigned v4u __attribute__((ext_vector_type(4)));
typedef unsigned v2u __attribute__((ext_vector_type(2)));
typedef float f32x4 __attribute__((ext_vector_type(4)));
typedef float f32x2 __attribute__((ext_vector_type(2)));
typedef short bf16x8 __attribute__((ext_vector_type(8)));
typedef short v4i16_t __attribute__((ext_vector_type(4)));
#define LDS_WAIT() asm volatile("s_waitcnt lgkmcnt(0)" ::: "memory")
#define VM_WAIT() asm volatile("s_waitcnt vmcnt(0)" ::: "memory")
__device__ __forceinline__ unsigned pk2(float lo, float hi) { return pg8::cvt_pk_bf16(lo, hi); }
__device__ __forceinline__ unsigned pk4_fp8(float a, float b, float c, float d) { int w = 0; w = __builtin_amdgcn_cvt_pk_fp8_f32(a, b, w, false); w = __builtin_amdgcn_cvt_pk_fp8_f32(c, d, w, true); return (unsigned)w; }
constexpr float W_SCALE = 64.0f, H_SCALE = 8.0f, ACT_SCALE = 4.0f, Y_SCALE = 16.0f;
__device__ __forceinline__ float bf_lo(unsigned w) { return __uint_as_float(w << 16); }
__device__ __forceinline__ float bf_hi(unsigned w) { return __uint_as_float(w & 0xffff0000u); }

#define XB_TMO      128
#define XB_XCNT(j)  (256  + 64 * (j))
#define XB_XSUB(j)  (1280 + 64 * (j))
#define XB_XGEN(j)  (2304 + 64 * (j))
#define XB_TOP      3328
#define XB_TOPGEN   3392
#define XCD_BAR_WORDS 3456
#define XB_SPIN_CAP (1u << 18)

__device__ __forceinline__ unsigned xb_ld(unsigned* p)              { return __hip_atomic_load(p, __ATOMIC_RELAXED, __HIP_MEMORY_SCOPE_AGENT); }
__device__ __forceinline__ unsigned xb_add(unsigned* p, unsigned v) { return __hip_atomic_fetch_add(p, v, __ATOMIC_RELAXED, __HIP_MEMORY_SCOPE_AGENT); }
__device__ __forceinline__ unsigned xb_xcc_id() { return (unsigned)__builtin_amdgcn_s_getreg((3 << 11) | 20) & 0xFu; }
#define XB_SPIN(cond, bar) do { unsigned _sp = 0; while (cond) { __builtin_amdgcn_s_sleep(1); \
    if ((++_sp & 255u) == 0u) { if (xb_ld(&(bar)[XB_TMO])) break; if (_sp > XB_SPIN_CAP) { atomicAdd(&(bar)[XB_TMO], 1u); break; } } } } while (0)

struct XcdBarrier { unsigned* bar; unsigned x; volatile LAS unsigned* st; };

__device__ __forceinline__ XcdBarrier xcd_barrier_post(unsigned* bar, volatile LAS unsigned* st) {
    XcdBarrier b; b.bar = bar; b.x = xb_xcc_id(); b.st = st;
    if (threadIdx.x == 0) (void)xb_add(&bar[XB_XCNT(b.x)], 1u);
    return b;
}
__device__ __forceinline__ void xcd_barrier_complete(unsigned* bar, unsigned x, unsigned& nloc, unsigned& nx) {
    const unsigned G = gridDim.x * gridDim.y * gridDim.z;
    unsigned sum, cnt, mine, sp = 0u;
    for (;;) {
        sum = 0u; cnt = 0u; mine = 0u;
#pragma unroll
        for (unsigned j = 0; j < 16; ++j) { const unsigned c = xb_ld(&bar[XB_XCNT(j)]); sum += c; cnt += (c > 0u) ? 1u : 0u; mine = (j == x) ? c : mine; }
        if (sum == G) break;
        __builtin_amdgcn_s_sleep(1);
        if ((++sp & 255u) == 0u) { if (xb_ld(&bar[XB_TMO])) break; if (sp > XB_SPIN_CAP) { atomicAdd(&bar[XB_TMO], 1u); break; } }
    }
    nloc = mine > 0u ? mine : 1u; nx = cnt > 0u ? cnt : 1u;
}
__device__ __forceinline__ void xcd_barrier(const XcdBarrier& b) {
    asm volatile("s_waitcnt vmcnt(0)" ::: "memory");
    __syncthreads();
    if (threadIdx.x == 0) {
        unsigned* bar = b.bar;
        __builtin_amdgcn_s_waitcnt(0);
        unsigned nloc = b.st[0], nx = b.st[1];
        if (nloc == 0u) { xcd_barrier_complete(bar, b.x, nloc, nx); b.st[0] = nloc; b.st[1] = nx; }
        const unsigned old = xb_add(&bar[XB_XSUB(b.x)], 1u);
        const unsigned gen = old / nloc;
        if (old + 1u == (gen + 1u) * nloc) {
            __builtin_amdgcn_fence(__ATOMIC_RELEASE, "agent");
            asm volatile("s_waitcnt vmcnt(0)" ::: "memory");
            const unsigned og = xb_add(&bar[XB_TOP], 1u);
            const unsigned tg = og / nx;
            if (og + 1u == (tg + 1u) * nx) xb_add(&bar[XB_TOPGEN], 1u);
            else XB_SPIN(xb_ld(&bar[XB_TOPGEN]) == tg, bar);
            __builtin_amdgcn_fence(__ATOMIC_ACQUIRE, "agent");
            xb_add(&bar[XB_XGEN(b.x)], 1u);
            asm volatile("s_waitcnt vmcnt(0)" ::: "memory");
        } else {
            XB_SPIN(xb_ld(&bar[XB_XGEN(b.x)]) == gen, bar);
            __builtin_amdgcn_fence(__ATOMIC_ACQUIRE, "agent");
            asm volatile("s_waitcnt vmcnt(0)" ::: "memory");
        }
    }
    __syncthreads();
}

template <int CTRL, int RMASK> __device__ __forceinline__ float dpp_add(float v) { return v + __builtin_bit_cast(float, __builtin_amdgcn_update_dpp(0, __builtin_bit_cast(int, v), CTRL, RMASK, 0xf, false)); }
__device__ __forceinline__ float wave_sum_dpp(float v) {
    v = dpp_add<0xB1, 0xf>(v); v = dpp_add<0x4E, 0xf>(v); v = dpp_add<0x141, 0xf>(v); v = dpp_add<0x140, 0xf>(v);
    v = dpp_add<0x142, 0xa>(v); v = dpp_add<0x143, 0xc>(v);
    return __builtin_bit_cast(float, __builtin_amdgcn_readlane(__builtin_bit_cast(int, v), 63));
}
__device__ __forceinline__ float wave_sum(float v) {
#pragma unroll
    for (int o = 1; o < 64; o <<= 1) v += __shfl_xor(v, o);
    return v;
}

struct DenseSched {
    static constexpr bool GATHER = false;
    const char* Bt; int nM, nN, G, c, rp, ibeg, iend;
    __device__ __forceinline__ size_t a_base(const pg8::Unit& u) const { return (size_t)u.pm * 256 * (size_t)rp; }
    __device__ __forceinline__ bool next(int i, pg8::Unit& u) const { u.e = 0; u.rb = 0; u.cnt = 0; if (i + ibeg >= iend) return false; return pg8::static_order(i + ibeg, G, c, nM, nN, u.pm, u.pn); }
    __device__ __forceinline__ const char* b_tile(const pg8::Unit& u) const { return Bt + (size_t)u.pn * 256 * rp; }
    __device__ __forceinline__ unsigned a_off(const pg8::Unit&, int r) const { return (unsigned)r * (unsigned)rp; }
    __device__ __forceinline__ int a_raw(const pg8::Unit&, int) const { return 0; }
    __device__ __forceinline__ unsigned a_fin(const pg8::Unit&, int r, int) const { return (unsigned)r * (unsigned)rp; }
};
template <bool GATHER_> struct MoeSched {
    static constexpr bool GATHER = GATHER_;
    const char* Bt; size_t bexp;
    const int* ltok; const LAS int* rbs; const LAS int* cnt; int nM, nN, G, c, rp;
    __device__ __forceinline__ size_t a_base(const pg8::Unit& u) const { return GATHER_ ? (size_t)0 : (size_t)u.pm * 256 * (size_t)rp; }
    __device__ __forceinline__ bool next(int i, pg8::Unit& u) const {
        if (!pg8::static_order(i, G, c, nM, nN, u.pm, u.pn)) return false;
        const int lane = threadIdx.x & 63;
        const int v = (lane < 32) ? rbs[lane + 1] : 0x7fffffff;
        const unsigned long long m = __ballot(v <= u.pm);
        const int e = __builtin_amdgcn_readfirstlane((int)__popcll(m));
        u.e = e; u.rb = u.pm - __builtin_amdgcn_readfirstlane(rbs[e]); u.cnt = __builtin_amdgcn_readfirstlane(cnt[e]);
        return true;
    }
    __device__ __forceinline__ const char* b_tile(const pg8::Unit& u) const { return Bt + (size_t)u.e * bexp + (size_t)u.pn * 256 * rp; }
    __device__ __forceinline__ unsigned a_off(const pg8::Unit& u, int r) const {
        return a_fin(u, r, a_raw(u, r));
    }
    __device__ __forceinline__ int a_raw(const pg8::Unit& u, int r) const { if constexpr (GATHER_) return ltok[u.e * LIST_CAP + u.rb * 256 + r]; else return 0; }
    __device__ __forceinline__ void gather_dma(const pg8::Unit& u, LAS unsigned char* dst, int wid, int lane) const {
        if (wid < 4) __builtin_amdgcn_global_load_lds((const unsigned*)(ltok + (size_t)u.e * LIST_CAP + u.rb * 256 + wid * 64 + lane), (LAS unsigned*)(dst + wid * 256), 4, 0, 0); }
    __device__ __forceinline__ unsigned a_fin(const pg8::Unit& u, int r, int raw) const {
        if constexpr (GATHER_) { const int t4 = (u.rb * 256 + r < u.cnt) ? raw : 0; return (unsigned)(t4 >> 2) * (unsigned)rp; }
        else return (unsigned)r * (unsigned)rp;
    }
};

__device__ __forceinline__ void side_dma(const void* src_lane, LAS unsigned char* dst_wave) { __builtin_amdgcn_global_load_lds((const unsigned*)src_lane, (LAS unsigned*)dst_wave, 4, 0, 0); }

struct EpiProj {
    static constexpr bool PERM = true, MIDSCALE = false;
    bf16* O; const float* bias; const float* rowscale;
    __device__ __forceinline__ void side(const pg8::Unit& u, LAS unsigned char* area, int wid, int lane) const {
        if (wid < 4) side_dma(bias + u.pn * 256 + wid * 64 + lane, area + wid * 256);
        else side_dma(rowscale + u.pm * 256 + (wid - 4) * 64 + lane, area + 1024 + (wid - 4) * 256); }
    __device__ __forceinline__ void operator()(const f32x4 (&acc)[2][2][4][2], const pg8::Unit& u, int wr, int wc, int fr, int fq, const LAS unsigned char* area) const {
        const int row0 = u.pm * 256 + wr * 64 + fr;
        f32x4 bv[2][2];
#pragma unroll
        for (int bj = 0; bj < 2; ++bj)
#pragma unroll
            for (int n = 0; n < 2; ++n) bv[bj][n] = *(const LAS f32x4*)(area + 4 * (wc * 32 + 8 * fq + bj * 128 + 4 * n));
        if (u.pn < 3) {
            const int col0 = u.pn * 256 + wc * 32 + 8 * fq;
            const float sc = (u.pn < 2) ? QSCALE : 1.0f;
#pragma unroll
            for (int ai = 0; ai < 2; ++ai)
#pragma unroll
                for (int m = 0; m < 4; ++m) { bf16* rowp = O + (size_t)(row0 + ai * 128 + m * 16) * PJW + col0;
                    const float rs = *(const LAS float*)(area + 1024 + 4 * (ai * 128 + wr * 64 + m * 16 + fr));
#pragma unroll
                    for (int bj = 0; bj < 2; ++bj) { const f32x4 v0 = (acc[ai][bj][m][0] * rs + bv[bj][0]) * sc, v1 = (acc[ai][bj][m][1] * rs + bv[bj][1]) * sc;
                        v4u w; w.x = pk2(v0[0], v0[1]); w.y = pk2(v0[2], v0[3]); w.z = pk2(v1[0], v1[1]); w.w = pk2(v1[2], v1[3]);
                        *(v4u*)(rowp + bj * 128) = w; } }
        } else {
            const int col0 = COL_U + (u.pn - 3) * 128 + wc * 32 + 8 * fq;
#pragma unroll
            for (int ai = 0; ai < 2; ++ai)
#pragma unroll
                for (int m = 0; m < 4; ++m) { bf16* rowp = O + (size_t)(row0 + ai * 128 + m * 16) * PJW + col0;
                    const float rs = *(const LAS float*)(area + 1024 + 4 * (ai * 128 + wr * 64 + m * 16 + fr));
                    f32x2 uv[4];
#pragma unroll
                    for (int n = 0; n < 2; ++n)
#pragma unroll
                        for (int p = 0; p < 2; ++p) {
                            const f32x2 av = (f32x2){acc[ai][0][m][n][2 * p], acc[ai][0][m][n][2 * p + 1]} * rs + (f32x2){bv[0][n][2 * p], bv[0][n][2 * p + 1]};
                            const f32x2 gv = (f32x2){acc[ai][1][m][n][2 * p], acc[ai][1][m][n][2 * p + 1]} * rs + (f32x2){bv[1][n][2 * p], bv[1][n][2 * p + 1]};
                            const f32x2 z = gv * (-LOG2E);
                            const f32x2 d = (f32x2){__builtin_amdgcn_exp2f(z.x), __builtin_amdgcn_exp2f(z.y)} + 1.0f;
                            uv[2 * n + p] = av * (f32x2){__builtin_amdgcn_rcpf(d.x), __builtin_amdgcn_rcpf(d.y)}; }
                    v4u w; w.x = pk2(uv[0].x, uv[0].y); w.y = pk2(uv[1].x, uv[1].y); w.z = pk2(uv[2].x, uv[2].y); w.w = pk2(uv[3].x, uv[3].y);
                    *(v4u*)rowp = w; }
        }
    }
};
struct EpiRes {
    static constexpr bool PERM = true, MIDSCALE = true;
    const bf16* base; bf16* out; const float* bias; const float* rowscale;
    __device__ __forceinline__ void side(const pg8::Unit& u, LAS unsigned char* area, int wid, int lane) const {
        if (wid < 4) side_dma(bias + u.pn * 256 + wid * 64 + lane, area + wid * 256);
        else side_dma(rowscale + u.pm * 256 + (wid - 4) * 64 + lane, area + 1024 + (wid - 4) * 256); }
    __device__ __forceinline__ void operator()(const f32x4 (&acc)[2][2][4][2], const pg8::Unit& u, int wr, int wc, int fr, int fq, const LAS unsigned char* area) const {
        const int col0 = u.pn * 256 + wc * 32 + 8 * fq;
        f32x4 bv[2][2];
#pragma unroll
        for (int bj = 0; bj < 2; ++bj)
#pragma unroll
            for (int n = 0; n < 2; ++n) bv[bj][n] = *(const LAS f32x4*)(area + 4 * (wc * 32 + 8 * fq + bj * 128 + 4 * n));
#pragma unroll
        for (int ai = 0; ai < 2; ++ai) {
            v4u xr[4][2];
#pragma unroll
            for (int m = 0; m < 4; ++m) { const size_t off = (size_t)(u.pm * 256 + ai * 128 + wr * 64 + m * 16 + fr) * D + col0;
#pragma unroll
                for (int bj = 0; bj < 2; ++bj) xr[m][bj] = *(const v4u*)(base + off + bj * 128); }
            __builtin_amdgcn_sched_barrier(0);
#pragma unroll
            for (int m = 0; m < 4; ++m) { const size_t off = (size_t)(u.pm * 256 + ai * 128 + wr * 64 + m * 16 + fr) * D + col0;
#pragma unroll
                for (int bj = 0; bj < 2; ++bj) { const v4u xw = xr[m][bj];
                    const f32x4 v0 = (f32x4){bf_lo(xw.x), bf_hi(xw.x), bf_lo(xw.y), bf_hi(xw.y)} + acc[ai][bj][m][0] + bv[bj][0], v1 = (f32x4){bf_lo(xw.z), bf_hi(xw.z), bf_lo(xw.w), bf_hi(xw.w)} + acc[ai][bj][m][1] + bv[bj][1];
                    v4u w; w.x = pk2(v0[0], v0[1]); w.y = pk2(v0[2], v0[3]); w.z = pk2(v1[0], v1[1]); w.w = pk2(v1[2], v1[3]);
                    *(v4u*)(out + off + bj * 128) = w; } }
        }
    }
};
struct EpiSwiglu {
    static constexpr bool PERM = true, MIDSCALE = false;
    unsigned char* O; const float* b1p;
    __device__ __forceinline__ void side(const pg8::Unit& u, LAS unsigned char* area, int wid, int lane) const { if (wid < 4) side_dma(b1p + (size_t)u.e * 2048 + u.pn * 256 + wid * 64 + lane, area + wid * 256); }
    __device__ __forceinline__ void operator()(const f32x4 (&acc)[2][2][4][2], const pg8::Unit& u, int wr, int wc, int fr, int fq, const LAS unsigned char* area) const {
        const int row0 = u.pm * 256 + wr * 64 + fr, ocol0 = u.pn * 128 + wc * 32 + 8 * fq;
        f32x4 bg[2], bl[2];
#pragma unroll
        for (int n = 0; n < 2; ++n) { bg[n] = *(const LAS f32x4*)(area + 4 * (wc * 32 + 8 * fq + 4 * n)); bl[n] = *(const LAS f32x4*)(area + 4 * (128 + wc * 32 + 8 * fq + 4 * n)); }
        constexpr float SI = 1.0f / (H_SCALE * W_SCALE);
#pragma unroll
        for (int ai = 0; ai < 2; ++ai)
#pragma unroll
            for (int m = 0; m < 4; ++m) { unsigned char* rowp = O + (size_t)(row0 + ai * 128 + m * 16) * 1024 + ocol0;
                f32x2 a[4];
#pragma unroll
                for (int n = 0; n < 2; ++n)
#pragma unroll
                    for (int p = 0; p < 2; ++p) {
                        const f32x2 gv = (f32x2){acc[ai][0][m][n][2 * p], acc[ai][0][m][n][2 * p + 1]} * SI + (f32x2){bg[n][2 * p], bg[n][2 * p + 1]};
                        const f32x2 lv = (f32x2){acc[ai][1][m][n][2 * p], acc[ai][1][m][n][2 * p + 1]} * SI + (f32x2){bl[n][2 * p], bl[n][2 * p + 1]};
                        const f32x2 gg = (f32x2){fminf(gv.x, 7.0f), fminf(gv.y, 7.0f)};
                        const f32x2 ll = (f32x2){__builtin_amdgcn_fmed3f(lv.x, -7.0f, 7.0f), __builtin_amdgcn_fmed3f(lv.y, -7.0f, 7.0f)};
                        const f32x2 z = gg * (-1.702f * LOG2E);
                        const f32x2 d = (f32x2){__builtin_amdgcn_exp2f(z.x), __builtin_amdgcn_exp2f(z.y)} + 1.0f;
                        const f32x2 r = (f32x2){__builtin_amdgcn_rcpf(d.x), __builtin_amdgcn_rcpf(d.y)};
                        a[2 * n + p] = (gg * r) * (ll * ACT_SCALE + ACT_SCALE); }
                v2u w; w.x = pk4_fp8(a[0].x, a[0].y, a[1].x, a[1].y); w.y = pk4_fp8(a[2].x, a[2].y, a[3].x, a[3].y);
                *(v2u*)rowp = w; }
    }
};
struct EpiMoeOut {
    static constexpr bool PERM = true, MIDSCALE = false;
    unsigned char* Y; const float* b2; const int* ltok; const float* lgate;
    __device__ __forceinline__ void side(const pg8::Unit& u, LAS unsigned char* area, int wid, int lane) const {
        if (wid < 4) { side_dma(b2 + (size_t)u.e * 1024 + u.pn * 256 + wid * 64 + lane, area + wid * 256); side_dma(ltok + (size_t)u.e * LIST_CAP + u.rb * 256 + wid * 64 + lane, area + 1024 + wid * 256); }
        else side_dma(lgate + (size_t)u.e * LIST_CAP + u.rb * 256 + (wid - 4) * 64 + lane, area + 2048 + (wid - 4) * 256); }
    __device__ __forceinline__ void operator()(const f32x4 (&acc)[2][2][4][2], const pg8::Unit& u, int wr, int wc, int fr, int fq, const LAS unsigned char* area) const {
        const int col0 = u.pn * 256 + wc * 32 + 8 * fq;
        f32x4 bv[2][2];
#pragma unroll
        for (int bj = 0; bj < 2; ++bj)
#pragma unroll
            for (int n = 0; n < 2; ++n) bv[bj][n] = *(const LAS f32x4*)(area + 4 * (wc * 32 + 8 * fq + bj * 128 + 4 * n));
#pragma unroll
        for (int ai = 0; ai < 2; ++ai)
#pragma unroll
            for (int m = 0; m < 4; ++m) { const int r = ai * 128 + wr * 64 + m * 16 + fr, pos = u.rb * 256 + r;
                const int t4 = *(const LAS int*)(area + 1024 + 4 * r); const float gt = *(const LAS float*)(area + 2048 + 4 * r) * Y_SCALE;
                if (pos < u.cnt) {
                    unsigned char* rowp = Y + (size_t)t4 * 1024 + col0;
#pragma unroll
                    for (int bj = 0; bj < 2; ++bj) { const f32x4 v0 = (acc[ai][bj][m][0] * (1.0f / (ACT_SCALE * W_SCALE)) + bv[bj][0]) * gt, v1 = (acc[ai][bj][m][1] * (1.0f / (ACT_SCALE * W_SCALE)) + bv[bj][1]) * gt;
                        v2u w; w.x = pk4_fp8(v0[0], v0[1], v0[2], v0[3]); w.y = pk4_fp8(v1[0], v1[1], v1[2], v1[3]);
                        *(v2u*)(rowp + bj * 128) = w; } } }
    }
};

__host__ __device__ __forceinline__ int win_row(int c) { if (c < 768) return c; const int cc = c - 768, ch = cc & 511; return 768 + (ch >> 7) * 256 + ((cc >> 9) & 1) * 128 + (ch & 127); }
template <int ESZ, int MODE  >
__device__ __forceinline__ void p0_item(const float* W, int N, unsigned char* WT, size_t rowpitch, LAS unsigned* scr, int kb, int nb, int lane, float scale, const float* kscale = nullptr, const float* kscale_hi = nullptr) {
    constexpr int KT = (ESZ == 2) ? 64 : 128, NT = (ESZ == 2) ? 64 : 32, LPR = NT / 4;
    const int k0 = KT * kb, n0 = NT * nb, lg = lane / LPR, nc = lane % LPR;
    const float* src = W + (size_t)(k0 + 16 * lg) * N + n0 + 4 * nc;
    f32x4 v[16];
#pragma unroll
    for (int i = 0; i < 16; ++i) v[i] = *(const f32x4*)(src + (size_t)i * N);
    if (kscale) {
#pragma unroll
        for (int i = 0; i < 16; ++i) { const int k = k0 + 16 * lg + i; v[i] = v[i] * ((kscale_hi && k >= 512) ? kscale_hi[k - 512] : kscale[k]); } }
#pragma unroll
    for (int e = 0; e < 4; ++e) {
        LAS unsigned* row = scr + (4 * nc + e) * 36;
        if (ESZ == 2) {
            v4u a, b;
            a.x = pk2(v[0][e] * scale, v[1][e] * scale); a.y = pk2(v[2][e] * scale, v[3][e] * scale); a.z = pk2(v[4][e] * scale, v[5][e] * scale); a.w = pk2(v[6][e] * scale, v[7][e] * scale);
            b.x = pk2(v[8][e] * scale, v[9][e] * scale); b.y = pk2(v[10][e] * scale, v[11][e] * scale); b.z = pk2(v[12][e] * scale, v[13][e] * scale); b.w = pk2(v[14][e] * scale, v[15][e] * scale);
            *(LAS v4u*)(row + 8 * lg) = a; *(LAS v4u*)(row + 8 * lg + 4) = b;
        } else {
            v4u a;
            a.x = pk4_fp8(v[0][e] * scale, v[1][e] * scale, v[2][e] * scale, v[3][e] * scale); a.y = pk4_fp8(v[4][e] * scale, v[5][e] * scale, v[6][e] * scale, v[7][e] * scale);
            a.z = pk4_fp8(v[8][e] * scale, v[9][e] * scale, v[10][e] * scale, v[11][e] * scale); a.w = pk4_fp8(v[12][e] * scale, v[13][e] * scale, v[14][e] * scale, v[15][e] * scale);
            *(LAS v4u*)(row + 4 * lg) = a;
        }
    }
    LDS_WAIT(); asm volatile("" ::: "memory");
    const int c = lane & 7;
#pragma unroll
    for (int j = 0; j < NT / 8; ++j) { const int n = (lane >> 3) + 8 * j; const v4u o = *(const LAS v4u*)(scr + n * 36 + 4 * c);
        const int col = n0 + n; const int row = (MODE == 1) ? ((col & ~255) + 128 * (col & 1) + ((col >> 1) & 127)) : (MODE == 2) ? win_row(col) : col;
        *(GAS v4u*)(WT + (size_t)row * rowpitch + (size_t)k0 * ESZ + 16 * c) = o; }
    LDS_WAIT(); asm volatile("" ::: "memory");
}

struct W8Item { const float* src; unsigned char* dst; int N, k0, n0, mode; };
__device__ __forceinline__ W8Item w8_item(int r, const float* w1, const float* w2, unsigned char* W1_t, unsigned char* W2_t) {
    W8Item it;
    if (r < 32 * 8 * 64) { const int e = r >> 9, q = r & 511; it.src = w1 + (size_t)e * 1024 * 2048; it.dst = W1_t + (size_t)e * 2048 * 1024; it.N = 2048; it.k0 = 128 * (q >> 6); it.n0 = 32 * (q & 63); it.mode = 1; }
    else { r -= 32 * 8 * 64; const int e = r >> 8, q = r & 255; it.src = w2 + (size_t)e * 1024 * 1024; it.dst = W2_t + (size_t)e * 1024 * 1024; it.N = 1024; it.k0 = 128 * (q >> 5); it.n0 = 32 * (q & 31); it.mode = 0; }
    return it;
}
__device__ __forceinline__ void w8_load(const W8Item& it, f32x4 (&v)[16], int lane) {
    const float* src = it.src + (size_t)(it.k0 + 16 * (lane >> 3)) * it.N + it.n0 + 4 * (lane & 7);
#pragma unroll
    for (int i = 0; i < 16; ++i) v[i] = __builtin_nontemporal_load((const f32x4*)(src + (size_t)i * it.N));
}
__device__ __forceinline__ void w8_store(const W8Item& it, const f32x4 (&v)[16], LAS unsigned* scr, int lane) {
    const int lg = lane >> 3, nc = lane & 7;
#pragma unroll
    for (int e = 0; e < 4; ++e) { v4u a;
        a.x = pk4_fp8(v[0][e] * W_SCALE, v[1][e] * W_SCALE, v[2][e] * W_SCALE, v[3][e] * W_SCALE); a.y = pk4_fp8(v[4][e] * W_SCALE, v[5][e] * W_SCALE, v[6][e] * W_SCALE, v[7][e] * W_SCALE);
        a.z = pk4_fp8(v[8][e] * W_SCALE, v[9][e] * W_SCALE, v[10][e] * W_SCALE, v[11][e] * W_SCALE); a.w = pk4_fp8(v[12][e] * W_SCALE, v[13][e] * W_SCALE, v[14][e] * W_SCALE, v[15][e] * W_SCALE);
        *(LAS v4u*)(scr + (4 * nc + e) * 36 + 4 * lg) = a; }
    LDS_WAIT(); asm volatile("" ::: "memory");
    const int c = lane & 7;
#pragma unroll
    for (int j = 0; j < 4; ++j) { const int n = (lane >> 3) + 8 * j; const v4u o = *(const LAS v4u*)(scr + n * 36 + 4 * c);
        const int col = it.n0 + n; const int row = it.mode ? ((col & ~255) + 128 * (col & 1) + ((col >> 1) & 127)) : col;
        *(GAS v4u*)(it.dst + (size_t)row * 1024 + it.k0 + 16 * c) = o; }
    LDS_WAIT(); asm volatile("" ::: "memory");
}

struct Args { const float* in[21]; float* out; unsigned char* ws; };

__global__ void __launch_bounds__(NWAVES * 64, 2) hymba_fwd(Args args) {
    extern __shared__ __attribute__((aligned(16))) unsigned char lds_raw[];
    LAS unsigned char* lds = (LAS unsigned char*)lds_raw;
    volatile LAS unsigned* MISC = (volatile LAS unsigned*)(lds + MISC_OFF);
    LAS int* TAB = (LAS int*)(lds + TAB_OFF);
    LAS int* t_rbs = TAB; LAS int* t_cnt = TAB + 40; LAS int* t_lcnt = TAB + 72; LAS int* t_gbase = TAB + 104;
#define PHASE_IDS() int tid = threadIdx.x; asm volatile("" : "+v"(tid)); const int lane = tid & 63, wave = __builtin_amdgcn_readfirstlane(tid >> 6); (void)lane; (void)wave
    const int G = gridDim.x;
    const int vcu = (G % 8 == 0) ? ((int)blockIdx.x % 8) * (G / 8) + (int)blockIdx.x / 8 : (int)blockIdx.x;

    const float* x = args.in[0]; const float* g_mix = args.in[1]; const float* w_in = args.in[2]; const float* b_in = args.in[3];
    const float* sinks = args.in[4]; const float* w_dw = args.in[5]; const float* b_dw = args.in[6]; const float* ln_g = args.in[7]; const float* ln_b = args.in[8];
    const float* g_attn = args.in[9]; const float* g_conv = args.in[10]; const float* w_out = args.in[11]; const float* b_out = args.in[12];
    const float* g_ffn = args.in[13]; const float* w_router = args.in[14]; const float* b_router = args.in[15];
    const float* w1 = args.in[16]; const float* b1 = args.in[17]; const float* w2 = args.in[18]; const float* b2 = args.in[19]; const float* g_final = args.in[20];
    float* out = args.out; unsigned char* ws = args.ws;
    unsigned* ctl = (unsigned*)(ws + WS_CTL);
    bf16* Win_t = (bf16*)(ws + WS_WIN); bf16* Wout_t = (bf16*)(ws + WS_WOUT); unsigned char* W1_t = ws + WS_W1; unsigned char* W2_t = ws + WS_W2; unsigned char* XN8 = ws + WS_XN8; bf16* X1B = (bf16*)(ws + WS_XN);
    bf16* XN = (bf16*)(ws + WS_XN); int* ltok = (int*)(ws + WS_LTOK); float* lgate = (float*)(ws + WS_LGATE); float* b1p = (float*)(ws + WS_B1P);
    float* RA = (float*)(ws + WS_RA); float* RS = RA + T; float* BINP = RS + T + 256;   bf16* WrHi = (bf16*)(ws + WS_WR); bf16* WrLo = WrHi + 32 * 1024;
    unsigned char* ACT = ws + WS_ACT; bf16* PROJ = (bf16*)(ws + WS_PROJ); bf16* MIX = (bf16*)(ws + WS_MIX); unsigned char* YB = ws + WS_Y;
    unsigned* gcnt = ctl + CW_GCNT;

    for (int u = threadIdx.x; u < (LDS_BYTES - MISC_OFF) / 4; u += NWAVES * 64) ((LAS unsigned*)(lds + MISC_OFF))[u] = 0u;
    __syncthreads();
    XcdBarrier bar = xcd_barrier_post(ctl + CW_BAR, MISC + 8);

    {
        PHASE_IDS();
        LAS unsigned* scr = (LAS unsigned*)(lds + wave * 16384);
        const int gw = vcu * NWAVES + wave, NGW = G * NWAVES;
        constexpr int I_IN = 16 * 28, I_OUT = 16 * 16;
        for (int it = gw; it < I_IN + I_OUT; it += NGW) {
            int r = it;
            if (r < I_IN) { p0_item<2, 2>(w_in, INW, (unsigned char*)Win_t, 2048, scr, r / 28, r % 28, lane, 1.0f, g_mix); continue; } r -= I_IN;
            p0_item<2, 0>(w_out, 1024, (unsigned char*)Wout_t, 2048, scr, r >> 4, r & 15, lane, 1.0f, g_attn, g_conv);
        }
        for (int m = 2 * gw; m < T; m += 2 * NGW) {
            const GAS f32x4* xr = (const GAS f32x4*)(x + (size_t)m * D) + lane;
            f32x4 v[2][4]; float s[2] = {0.f, 0.f};
#pragma unroll
            for (int q = 0; q < 2; ++q)
#pragma unroll
                for (int j = 0; j < 4; ++j) v[q][j] = __builtin_nontemporal_load(xr + q * 256 + 64 * j);
#pragma unroll
            for (int q = 0; q < 2; ++q)
#pragma unroll
                for (int j = 0; j < 4; ++j) s[q] += (v[q][j].x * v[q][j].x + v[q][j].y * v[q][j].y) + (v[q][j].z * v[q][j].z + v[q][j].w * v[q][j].w);
#pragma unroll
            for (int q = 0; q < 2; ++q) {
                const float rstd = 1.0f / sqrtf(wave_sum(s[q]) * (1.0f / D) + RMS_EPS);
                if (lane == 0) RS[m + q] = rstd;
                GAS v2u* o8 = (GAS v2u*)(XN + (size_t)(m + q) * D) + lane;
#pragma unroll
                for (int j = 0; j < 4; ++j) { v2u o; o.x = pk2(v[q][j].x, v[q][j].y); o.y = pk2(v[q][j].z, v[q][j].w); o8[64 * j] = o; }
            }
        }
        const int gt = vcu * (NWAVES * 64) + tid, NGT = G * NWAVES * 64;
        for (int i = gt; i < INW; i += NGT) BINP[win_row(i)] = b_in[i];
        for (int i = gt; i < 32 * 2048; i += NGT) { const int e = i >> 11, col = i & 2047; const int row = (col & ~255) + 128 * (col & 1) + ((col >> 1) & 127); b1p[e * 2048 + row] = b1[i]; }
        for (int i = gt; i < 32 * 1024; i += NGT) { const int e = i >> 10, k = i & 1023; const float v = w_router[k * 32 + e];
            const unsigned h = pk2(v, 0.f) & 0xffffu; const float lo = v - __uint_as_float(h << 16);
            const int fi = ((((e >> 4) * 32 + (k >> 5)) * 64 + 16 * ((k >> 3) & 3) + (e & 15)) * 8) + (k & 7);
            WrHi[fi] = (bf16)h; WrLo[fi] = (bf16)(pk2(lo, 0.f) & 0xffffu); }
    }
    xcd_barrier(bar);

    {
        const int grp = ((int)blockIdx.x >> 3) & 3;
        EpiProj E{PROJ, BINP, RS};
        {
            DenseSched S{(const char*)Win_t, T / 256, INW / 256, G, (int)blockIdx.x, 2048, 0, grp};
            pg8::gemm_phase<EpiProj, DenseSched, false>(lds, lds + EPI_OFF, (const char*)XN, 2048, S, E);
        }
        {
            PHASE_IDS();
            __syncthreads();
            LAS unsigned* scr = (LAS unsigned*)(lds + wave * 16384);
            const int gw = vcu * NWAVES + wave, NGW = G * NWAVES;
            constexpr int NIT_ALL = 16384;
            int it = gw, NIT = NIT_ALL, NGW_ = NGW;
            if (G == 256) { const int c = (int)blockIdx.x; NGW_ = 1024;
                if (c >= 128) { it = (c - 128) * NWAVES + wave; NIT = 10240; } else { it = 10240 + c * NWAVES + wave; NIT = NIT_ALL; } }
            f32x4 va[16], vb[16];
            W8Item ia = w8_item(24575 - (it < NIT ? it : 0), w1, w2, W1_t, W2_t), ib = ia;
            if (it < NIT) w8_load(ia, va, lane);
            while (it < NIT) {
                const int itb = it + NGW_;
                if (itb < NIT) { ib = w8_item(24575 - itb, w1, w2, W1_t, W2_t); w8_load(ib, vb, lane); }
                w8_store(ia, va, scr, lane);
                if (itb >= NIT) break;
                const int ita = itb + NGW_;
                if (ita < NIT) { ia = w8_item(24575 - ita, w1, w2, W1_t, W2_t); w8_load(ia, va, lane); }
                w8_store(ib, vb, scr, lane);
                it = ita;
            }
            __syncthreads();
        }
        {
            DenseSched S{(const char*)Win_t, T / 256, INW / 256, G, (int)blockIdx.x, 2048, grp, 1 << 30};
            pg8::gemm_phase<EpiProj, DenseSched, false>(lds, lds + EPI_OFF, (const char*)XN, 2048, S, E);
        }
    }
    xcd_barrier(bar);

    for (int unit = blockIdx.x; unit < T / 128; unit += G) {
        const int b = unit >> 4, n = unit & 15, t0 = b * SEQ + n * 128;
        {
            PHASE_IDS();
            constexpr int KOFF = 0, VOFF = 36864;
            const int i16 = lane & 15, g = lane >> 4;
            const int vq = i16 >> 2, vp = i16 & 3;
            float ssq = 0.f;
            const bf16* qrow = PROJ + (size_t)(t0 + 16 * wave + i16) * PJW + 8 * g;
            bf16* orow = MIX + (size_t)(t0 + 16 * wave + i16) * D + 4 * g;
            bf16x8 q0n = *(const bf16x8*)qrow, q1n = *(const bf16x8*)(qrow + 32);
            v4u kpre[4], vpre[4];
#define KV_LOAD(kvh) do { _Pragma("unroll") for (int c4 = 0; c4 < 4; ++c4) { const int c = tid + 512 * c4, row = c >> 3, ch = c & 7; kpre[c4] = (v4u){0u, 0u, 0u, 0u}; vpre[c4] = kpre[c4]; \
                if (n > 0 || row >= 128) { const bf16* p = PROJ + (size_t)(t0 - 128 + row) * PJW + (kvh) * 64 + ch * 8; kpre[c4] = *(const v4u*)(p + COL_K); vpre[c4] = *(const v4u*)(p + COL_V); } } } while (0)
#define KV_WRITE() do { _Pragma("unroll") for (int c4 = 0; c4 < 4; ++c4) { const int c = tid + 512 * c4, row = c >> 3, ch = c & 7; \
                *(LAS v4u*)(lds + KOFF + row * 144 + ch * 16) = kpre[c4]; *(LAS v4u*)(lds + VOFF + row * 144 + ch * 16) = vpre[c4]; } } while (0)
            KV_LOAD(0);
            __syncthreads();
            KV_WRITE();
            KV_LOAD(1);
            __syncthreads();
            for (int h = 0; h < 8; ++h) {
                if (h == 4) { __syncthreads(); KV_WRITE(); __syncthreads(); }
                const bf16x8 q0 = q0n, q1 = q1n;
                if (h < 7) { q0n = *(const bf16x8*)(qrow + (h + 1) * 64); q1n = *(const bf16x8*)(qrow + (h + 1) * 64 + 32); }
                f32x4 st[9];
#pragma unroll
                for (int j = 0; j < 9; ++j) { const LAS unsigned char* kp = lds + KOFF + (16 * (wave + j) + i16) * 144 + 16 * g;
                    const bf16x8 k0 = *(const LAS bf16x8*)kp, k1 = *(const LAS bf16x8*)(kp + 64);
                    st[j] = __builtin_amdgcn_mfma_f32_16x16x32_bf16(k0, q0, (f32x4){0.f, 0.f, 0.f, 0.f}, 0, 0, 0);
                    st[j] = __builtin_amdgcn_mfma_f32_16x16x32_bf16(k1, q1, st[j], 0, 0, 0); }
                const float NEG = -INFINITY;
#pragma unroll
                for (int j = 0; j < 9; ++j) { const bool dead = (n == 0) && (wave + j < 8);
#pragma unroll
                    for (int r = 0; r < 4; ++r) { const int kr = 4 * g + r; bool ok = !dead; if (j == 0) ok = ok && (kr > i16); if (j == 8) ok = ok && (kr <= i16); if (!ok) st[j][r] = NEG; } }
                const float sink2 = sinks[h] * LOG2E;
                float mx = sink2;
#pragma unroll
                for (int j = 0; j < 9; ++j) mx = fmaxf(fmaxf(mx, fmaxf(st[j][0], st[j][1])), fmaxf(st[j][2], st[j][3]));
                mx = fmaxf(mx, __shfl_xor(mx, 16)); mx = fmaxf(mx, __shfl_xor(mx, 32));
                float ls = 0.f;
#pragma unroll
                for (int j = 0; j < 9; ++j)
#pragma unroll
                    for (int r = 0; r < 4; ++r) { st[j][r] = __builtin_amdgcn_exp2f(st[j][r] - mx); ls += st[j][r]; }
                ls += __shfl_xor(ls, 16); ls += __shfl_xor(ls, 32);
                ls += __builtin_amdgcn_exp2f(sink2 - mx);
                const float inv = 1.0f / ls;
                bf16x8 pf[5];
#pragma unroll
                for (int kk = 0; kk < 5; ++kk) { v4u w; w.x = pk2(st[2 * kk][0], st[2 * kk][1]); w.y = pk2(st[2 * kk][2], st[2 * kk][3]);
                    if (kk < 4) { w.z = pk2(st[2 * kk + 1][0], st[2 * kk + 1][1]); w.w = pk2(st[2 * kk + 1][2], st[2 * kk + 1][3]); } else { w.z = 0u; w.w = 0u; }
                    pf[kk] = __builtin_bit_cast(bf16x8, w); }
#pragma unroll
                for (int dt = 0; dt < 4; ++dt) { f32x4 o = (f32x4){0.f, 0.f, 0.f, 0.f};
#pragma unroll
                    for (int kk = 0; kk < 5; ++kk) { const int kta = wave + 2 * kk, ktb = (kk < 4) ? wave + 2 * kk + 1 : wave + 8;
                        const LAS unsigned char* pa = lds + VOFF + (16 * kta + 4 * g + vq) * 144 + (16 * dt + 4 * vp) * 2;
                        const LAS unsigned char* pb = lds + VOFF + (16 * ktb + 4 * g + vq) * 144 + (16 * dt + 4 * vp) * 2;
                        const v4i16_t va = __builtin_amdgcn_ds_read_tr16_b64_v4i16((LAS v4i16_t*)pa), vb = __builtin_amdgcn_ds_read_tr16_b64_v4i16((LAS v4i16_t*)pb);
                        const bf16x8 vf = (bf16x8){va[0], va[1], va[2], va[3], vb[0], vb[1], vb[2], vb[3]};
                        o = __builtin_amdgcn_mfma_f32_16x16x32_bf16(vf, pf[kk], o, 0, 0, 0); }
                    o = o * inv; ssq += (o[0] * o[0] + o[1] * o[1]) + (o[2] * o[2] + o[3] * o[3]);
                    v2u w; w.x = pk2(o[0], o[1]); w.y = pk2(o[2], o[3]);
                    *(v2u*)(orow + h * 64 + 16 * dt) = w; }
            }
#undef KV_LOAD
#undef KV_WRITE
            ssq += __shfl_xor(ssq, 16); ssq += __shfl_xor(ssq, 32);
            if (g == 0) RA[t0 + 16 * wave + i16] = 1.0f / sqrtf(ssq * (1.0f / 512.0f) + RMS_EPS);
        }
        __syncthreads();
        {
            PHASE_IDS();
            const int cp = tid & 255, th = tid >> 8, c0 = 2 * cp;
            LAS float* tile = (LAS float*)lds;
            f32x2 wk[31];
#pragma unroll
            for (int j = 0; j < 31; ++j) wk[j] = *(const f32x2*)(w_dw + j * 512 + c0);
            const f32x2 bdw = *(const f32x2*)(b_dw + c0);
            const int s0 = n * 128 + 64 * th;
            const bf16* pbase = PROJ + (size_t)(b * SEQ) * PJW + COL_U + c0;
            f32x2 uu[38];
            unsigned ra_[8];
#define GLU_CVT(aw, dst) do { dst.x = bf_lo(aw); dst.y = bf_hi(aw); } while (0)
#pragma unroll
            for (int i = 0; i < 30; ++i) { const int pos = s0 - 30 + i; unsigned aw = 0u;
                if (pos >= 0) aw = *(const unsigned*)(pbase + (size_t)pos * PJW);
                GLU_CVT(aw, uu[i]); }
#pragma unroll
            for (int tt = 0; tt < 8; ++tt) { const int pos = s0 + tt; ra_[tt] = *(const unsigned*)(pbase + (size_t)pos * PJW); }
            LAS float* prm = tile + 16 * 512;
            prm[tid] = ln_g[tid]; prm[512 + tid] = ln_b[tid];
            for (int chunk = 0; chunk < 8; ++chunk) {
#pragma unroll
                for (int tt = 0; tt < 8; ++tt) GLU_CVT(ra_[tt], uu[30 + tt]);
                if (chunk < 7) {
#pragma unroll
                    for (int tt = 0; tt < 8; ++tt) { const int pos = s0 + 8 * (chunk + 1) + tt; ra_[tt] = *(const unsigned*)(pbase + (size_t)pos * PJW); }
                }
#pragma unroll
                for (int tt = 0; tt < 8; ++tt) { f32x2 a = bdw;
#pragma unroll
                    for (int j = 0; j < 31; ++j) a = a + wk[j] * uu[tt + j];
                    *(LAS f32x2*)(tile + (th * 8 + tt) * 512 + c0) = a; }
#pragma unroll
                for (int i = 0; i < 30; ++i) uu[i] = uu[i + 8];
                LDS_WAIT(); __builtin_amdgcn_s_barrier(); asm volatile("" ::: "memory");
#pragma unroll
                for (int q = 0; q < 2; ++q) { const int row = 2 * wave + q, rth = row >> 3, rtt = row & 7; const int tok = t0 + 64 * rth + 8 * chunk + rtt;
                    const f32x4 a0 = *(const LAS f32x4*)(tile + row * 512 + 8 * lane), a1 = *(const LAS f32x4*)(tile + row * 512 + 8 * lane + 4);
                    float v[8] = {a0[0], a0[1], a0[2], a0[3], a1[0], a1[1], a1[2], a1[3]};
                    float s = 0.f;
#pragma unroll
                    for (int j = 0; j < 8; ++j) s += v[j];
                    const float mean = wave_sum_dpp(s) * (1.0f / 512.0f);
                    float s2 = 0.f;
#pragma unroll
                    for (int j = 0; j < 8; ++j) { v[j] -= mean; s2 += v[j] * v[j]; }
                    const float rstd = 1.0f / sqrtf(wave_sum_dpp(s2) * (1.0f / 512.0f) + LN_EPS);
                    const f32x4 lg0 = *(const LAS f32x4*)(prm + 8 * lane), lg1 = *(const LAS f32x4*)(prm + 8 * lane + 4), lb0 = *(const LAS f32x4*)(prm + 512 + 8 * lane), lb1 = *(const LAS f32x4*)(prm + 512 + 8 * lane + 4);
                    const float lgv[8] = {lg0[0], lg0[1], lg0[2], lg0[3], lg1[0], lg1[1], lg1[2], lg1[3]}, lbv[8] = {lb0[0], lb0[1], lb0[2], lb0[3], lb1[0], lb1[1], lb1[2], lb1[3]};
                    float s3 = 0.f;
#pragma unroll
                    for (int j = 0; j < 8; ++j) { const float y = v[j] * rstd * lgv[j] + lbv[j]; const float z = y * __builtin_amdgcn_rcpf(1.0f + __builtin_amdgcn_exp2f(-y * LOG2E)); v[j] = z; s3 += z * z; }
                    const float rc = 1.0f / sqrtf(wave_sum_dpp(s3) * (1.0f / 512.0f) + RMS_EPS);
                    v4u w; w.x = pk2(v[0] * rc, v[1] * rc); w.y = pk2(v[2] * rc, v[3] * rc); w.z = pk2(v[4] * rc, v[5] * rc); w.w = pk2(v[6] * rc, v[7] * rc);
                    *(v4u*)(MIX + (size_t)tok * D + 512 + 8 * lane) = w; }
                LDS_WAIT(); __builtin_amdgcn_s_barrier(); asm volatile("" ::: "memory");
            }
#undef GLU_CVT
        }
    }
    xcd_barrier(bar);

    {
        const int grp = ((int)blockIdx.x >> 3) % 3;
        EpiRes E{XN, X1B, b_out, RA};
        {
            DenseSched S{(const char*)Wout_t, T / 256, D / 256, G, (int)blockIdx.x, 2048, 0, grp};
            pg8::gemm_phase<EpiRes, DenseSched, false>(lds, lds + EPI_OFF, (const char*)MIX, 2048, S, E);
        }
        {
            PHASE_IDS();
            __syncthreads();
            LAS unsigned* scr = (LAS unsigned*)(lds + wave * 16384);
            const int gw = vcu * NWAVES + wave, NGW = G * NWAVES;
            constexpr int NIT = 8192;
            f32x4 va[16], vb[16];
            int it = gw;
            W8Item ia = w8_item(8191 - (it < NIT ? it : 0), w1, w2, W1_t, W2_t), ib = ia;
            if (it < NIT) w8_load(ia, va, lane);
            while (it < NIT) {
                const int itb = it + NGW;
                if (itb < NIT) { ib = w8_item(8191 - itb, w1, w2, W1_t, W2_t); w8_load(ib, vb, lane); }
                w8_store(ia, va, scr, lane);
                if (itb >= NIT) break;
                const int ita = itb + NGW;
                if (ita < NIT) { ia = w8_item(8191 - ita, w1, w2, W1_t, W2_t); w8_load(ia, va, lane); }
                w8_store(ib, vb, scr, lane);
                it = ita;
            }
            __syncthreads();
        }
        {
            DenseSched S{(const char*)Wout_t, T / 256, D / 256, G, (int)blockIdx.x, 2048, grp, 1 << 30};
            pg8::gemm_phase<EpiRes, DenseSched, false>(lds, lds + EPI_OFF, (const char*)MIX, 2048, S, E);
        }
    }
    xcd_barrier(bar);

    {
        PHASE_IDS();
        if (wave < 4) __builtin_amdgcn_global_load_lds((const unsigned*)((const char*)g_ffn + wave * 1024 + lane * 16), (LAS unsigned*)(lds + P4_G_OFF + wave * 1024), 16, 0, 0);
#pragma unroll
        for (int i = 0; i < 16; ++i) __builtin_amdgcn_global_load_lds((const unsigned*)((const char*)WrHi + (size_t)(wave * 16 + i) * 1024 + lane * 16), (LAS unsigned*)(lds + (wave * 16 + i) * 1024), 16, 0, 0);
        VM_WAIT(); __syncthreads();
    }
    for (int unit = blockIdx.x; unit < T / 128; unit += G) {
        PHASE_IDS();
        const int i16 = lane & 15, g = lane >> 4;
        if (tid < 32) t_lcnt[tid] = 0;
        __syncthreads();
        const int tok = unit * 128 + wave * 16 + i16;
        const bf16* xr = X1B + (size_t)tok * D + 8 * g;
        float ss = 0.f;
#pragma unroll 8
        for (int s = 0; s < 32; ++s) { const v4u a = *(const v4u*)(xr + 32 * s);
            const float a0 = bf_lo(a.x), a1 = bf_hi(a.x), a2 = bf_lo(a.y), a3 = bf_hi(a.y), a4 = bf_lo(a.z), a5 = bf_hi(a.z), a6 = bf_lo(a.w), a7 = bf_hi(a.w);
            ss += (a0 * a0 + a1 * a1) + (a2 * a2 + a3 * a3) + (a4 * a4 + a5 * a5) + (a6 * a6 + a7 * a7); }
        ss += __shfl_xor(ss, 16); ss += __shfl_xor(ss, 32);
        const float rstd = 1.0f / sqrtf(ss * (1.0f / D) + RMS_EPS);
        f32x4 acc0 = (f32x4){0.f, 0.f, 0.f, 0.f}, acc1 = acc0;
        {
        unsigned char* hrow = XN8 + (size_t)tok * D + 8 * g;
        const bf16* wh0 = WrHi + lane * 8; const bf16* wl0 = WrLo + lane * 8;
        for (int s8 = 0; s8 < 4; ++s8) {
            v4u xc[8];
#pragma unroll
            for (int q = 0; q < 8; ++q) xc[q] = *(const v4u*)(xr + 32 * (8 * s8 + q));
            __builtin_amdgcn_sched_barrier(0);
#pragma unroll
            for (int q = 0; q < 8; ++q) { const int s = 8 * s8 + q; const v4u xa = xc[q];
            const f32x4 a = (f32x4){bf_lo(xa.x), bf_hi(xa.x), bf_lo(xa.y), bf_hi(xa.y)} * rstd * *(const LAS f32x4*)((const LAS float*)(lds + P4_G_OFF) + 8 * g + 32 * s), b = (f32x4){bf_lo(xa.z), bf_hi(xa.z), bf_lo(xa.w), bf_hi(xa.w)} * rstd * *(const LAS f32x4*)((const LAS float*)(lds + P4_G_OFF) + 8 * g + 32 * s + 4);
            v4u hp; hp.x = pk2(a[0], a[1]); hp.y = pk2(a[2], a[3]); hp.z = pk2(b[0], b[1]); hp.w = pk2(b[2], b[3]);
            v4u lp; lp.x = pk2(a[0] - bf_lo(hp.x), a[1] - bf_hi(hp.x)); lp.y = pk2(a[2] - bf_lo(hp.y), a[3] - bf_hi(hp.y)); lp.z = pk2(b[0] - bf_lo(hp.z), b[1] - bf_hi(hp.z)); lp.w = pk2(b[2] - bf_lo(hp.w), b[3] - bf_hi(hp.w));
            const bf16x8 hh = __builtin_bit_cast(bf16x8, hp), hl = __builtin_bit_cast(bf16x8, lp);
            const LAS unsigned char* wf = lds + lane * 16; const bf16x8 whA = *(const LAS bf16x8*)(wf + (0 * 32 + s) * 1024), whB = *(const LAS bf16x8*)(wf + (1 * 32 + s) * 1024), wlA = *(const LAS bf16x8*)(wf + (2 * 32 + s) * 1024), wlB = *(const LAS bf16x8*)(wf + (3 * 32 + s) * 1024);
            acc0 = __builtin_amdgcn_mfma_f32_16x16x32_bf16(whA, hh, acc0, 0, 0, 0); acc0 = __builtin_amdgcn_mfma_f32_16x16x32_bf16(whA, hl, acc0, 0, 0, 0); acc0 = __builtin_amdgcn_mfma_f32_16x16x32_bf16(wlA, hh, acc0, 0, 0, 0);
            acc1 = __builtin_amdgcn_mfma_f32_16x16x32_bf16(whB, hh, acc1, 0, 0, 0); acc1 = __builtin_amdgcn_mfma_f32_16x16x32_bf16(whB, hl, acc1, 0, 0, 0); acc1 = __builtin_amdgcn_mfma_f32_16x16x32_bf16(wlB, hh, acc1, 0, 0, 0); }
        }
        }
        {
            unsigned char* hrow = XN8 + (size_t)tok * D + 8 * g;
            const float rs8 = rstd * H_SCALE;
            for (int s8 = 0; s8 < 4; ++s8) {
                v4u xc[8];
#pragma unroll
                for (int q = 0; q < 8; ++q) xc[q] = *(const v4u*)(xr + 32 * (8 * s8 + q));
                __builtin_amdgcn_sched_barrier(0);
#pragma unroll
                for (int q = 0; q < 8; ++q) { const int s = 8 * s8 + q; const v4u xa = xc[q];
                    const f32x4 a = (f32x4){bf_lo(xa.x), bf_hi(xa.x), bf_lo(xa.y), bf_hi(xa.y)} * rs8 * *(const LAS f32x4*)((const LAS float*)(lds + P4_G_OFF) + 8 * g + 32 * s), b = (f32x4){bf_lo(xa.z), bf_hi(xa.z), bf_lo(xa.w), bf_hi(xa.w)} * rs8 * *(const LAS f32x4*)((const LAS float*)(lds + P4_G_OFF) + 8 * g + 32 * s + 4);
                    v2u h8; h8.x = pk4_fp8(a[0], a[1], a[2], a[3]); h8.y = pk4_fp8(b[0], b[1], b[2], b[3]); *(v2u*)(hrow + 32 * s) = h8; }
            }
        }
        LAS float* sc = (LAS float*)(lds + EPI_OFF + wave * 2112);
#pragma unroll
        for (int r = 0; r < 4; ++r) { sc[i16 * 33 + 4 * g + r] = acc0[r] + b_router[4 * g + r]; sc[i16 * 33 + 16 + 4 * g + r] = acc1[r] + b_router[16 + 4 * g + r]; }
        LDS_WAIT(); asm volatile("" ::: "memory");
        int idx[4], rank[4]; float gate[4];
        if (lane < 16) {
            float v[32];
#pragma unroll
            for (int e = 0; e < 32; ++e) v[e] = sc[lane * 33 + e];
            float val[4];
#pragma unroll
            for (int k = 0; k < 4; ++k) { float best = -INFINITY; int bi = 0;
#pragma unroll
                for (int e = 0; e < 32; ++e) if (v[e] > best) { best = v[e]; bi = e; }
                val[k] = best; idx[k] = bi;
#pragma unroll
                for (int e = 0; e < 32; ++e) v[e] = (e == bi) ? -INFINITY : v[e]; }
            float den = 0.f;
#pragma unroll
            for (int k = 0; k < 4; ++k) { gate[k] = __expf(val[k] - val[0]); den += gate[k]; }
            const float rden = 1.0f / den;
#pragma unroll
            for (int k = 0; k < 4; ++k) { gate[k] *= rden; rank[k] = atomicAdd((int*)(t_lcnt + idx[k]), 1); }
        }
        __syncthreads();
        if (tid < 32) { const int c = t_lcnt[tid]; t_gbase[tid] = c ? (int)__hip_atomic_fetch_add(gcnt + 16 * tid, (unsigned)c, __ATOMIC_RELAXED, __HIP_MEMORY_SCOPE_AGENT) : 0; }
        __syncthreads();
        if (lane < 16) {
            const int tk = unit * 128 + wave * 16 + lane;
#pragma unroll
            for (int k = 0; k < 4; ++k) { const int pos = t_gbase[idx[k]] + rank[k]; ltok[idx[k] * LIST_CAP + pos] = tk * 4 + k; lgate[idx[k] * LIST_CAP + pos] = gate[k]; }
        }
        __syncthreads();
    }
    xcd_barrier(bar);

    if (threadIdx.x < 32) t_cnt[threadIdx.x] = (int)__hip_atomic_load(gcnt + 16 * threadIdx.x, __ATOMIC_RELAXED, __HIP_MEMORY_SCOPE_AGENT);
    __syncthreads();
    if (threadIdx.x == 0) { int s = 0; for (int e = 0; e < 32; ++e) { t_rbs[e] = s; s += (t_cnt[e] + 255) >> 8; } t_rbs[32] = s; }
    __syncthreads();
    const int NB = __builtin_amdgcn_readfirstlane(t_rbs[32]);

    {
        MoeSched<true> S{(const char*)W1_t, (size_t)2048 * 1024, ltok, t_rbs, t_cnt, NB, 8, G, (int)blockIdx.x, 1024};
        EpiSwiglu E{ACT, b1p};
        pg8::gemm_phase<EpiSwiglu, MoeSched<true>, true>(lds, lds + EPI_OFF, (const char*)XN8, 1024, S, E);
    }
    xcd_barrier(bar);

    {
        MoeSched<false> S{(const char*)W2_t, (size_t)1024 * 1024, ltok, t_rbs, t_cnt, NB, 4, G, (int)blockIdx.x, 1024};
        EpiMoeOut E{YB, b2, ltok, lgate};
        pg8::gemm_phase<EpiMoeOut, MoeSched<false>, true, false>(lds, lds + EPI_OFF, (const char*)ACT, 1024, S, E);
    }
    xcd_barrier(bar);

    {
        PHASE_IDS();
        const int gw = vcu * NWAVES + wave, NGW = G * NWAVES;
        f32x4 gfin[4];
#pragma unroll
        for (int j = 0; j < 4; ++j) gfin[j] = *((const f32x4*)g_final + lane + 64 * j);
        for (int m0 = 2 * gw; m0 < T; m0 += 2 * NGW) {
            v2u xw_[2][4]; unsigned yw[2][4][4];
#pragma unroll
            for (int q = 0; q < 2; ++q) { const GAS v2u* xr = (const GAS v2u*)(X1B + (size_t)(m0 + q) * D) + lane;
#pragma unroll
                for (int j = 0; j < 4; ++j) xw_[q][j] = __builtin_nontemporal_load(xr + 64 * j);
#pragma unroll
                for (int k = 0; k < 4; ++k) { const GAS unsigned* yr = (const GAS unsigned*)(YB + ((size_t)(m0 + q) * 4 + k) * D) + lane;
#pragma unroll
                    for (int j = 0; j < 4; ++j) yw[q][k][j] = __builtin_nontemporal_load(yr + 64 * j); } }
#pragma unroll
            for (int q = 0; q < 2; ++q) {
                f32x4 v[4];
#pragma unroll
                for (int j = 0; j < 4; ++j) v[j] = (f32x4){bf_lo(xw_[q][j].x), bf_hi(xw_[q][j].x), bf_lo(xw_[q][j].y), bf_hi(xw_[q][j].y)};
#pragma unroll
                for (int k = 0; k < 4; ++k)
#pragma unroll
                    for (int j = 0; j < 4; ++j) { const f32x2 lo = __builtin_amdgcn_cvt_pk_f32_fp8((int)yw[q][k][j], false), hi = __builtin_amdgcn_cvt_pk_f32_fp8((int)yw[q][k][j], true);
                        v[j].x += lo.x * (1.0f / Y_SCALE); v[j].y += lo.y * (1.0f / Y_SCALE); v[j].z += hi.x * (1.0f / Y_SCALE); v[j].w += hi.y * (1.0f / Y_SCALE); }
                float s = 0.f;
#pragma unroll
                for (int j = 0; j < 4; ++j) s += (v[j].x * v[j].x + v[j].y * v[j].y) + (v[j].z * v[j].z + v[j].w * v[j].w);
                const float rstd = 1.0f / sqrtf(wave_sum_dpp(s) * (1.0f / D) + RMS_EPS);
                GAS f32x4* xw = (GAS f32x4*)(out + (size_t)(m0 + q) * D) + lane;
#pragma unroll
                for (int j = 0; j < 4; ++j) __builtin_nontemporal_store(v[j] * rstd * gfin[j], xw + 64 * j);
            }
        }
    }
}

extern "C" void kernel_launch(void* const* d_in, const int* in_sizes, int n_in, void* d_out, int out_size, void* d_ws, size_t ws_size, hipStream_t stream) {
    static int grid = 0;
    if (grid == 0) {
        if (n_in != 21 || in_sizes[0] != T * D || out_size != T * D || ws_size < WS_END) { fprintf(stderr, "kernel_launch: unexpected shapes (n_in %d, in0 %d, out %d, ws %zu)\n", n_in, n_in > 0 ? in_sizes[0] : -1, out_size, ws_size); grid = -1; return; }
        int dev = 0, cus = 0, per_cu = 0;
        if (hipGetDevice(&dev) != hipSuccess || hipDeviceGetAttribute(&cus, hipDeviceAttributeMultiprocessorCount, dev) != hipSuccess) { grid = -1; return; }
        if (hipFuncSetAttribute((const void*)hymba_fwd, hipFuncAttributeMaxDynamicSharedMemorySize, LDS_BYTES) != hipSuccess) { fprintf(stderr, "kernel_launch: hipFuncSetAttribute failed\n"); grid = -1; return; }
        if (hipOccupancyMaxActiveBlocksPerMultiprocessor(&per_cu, (const void*)hymba_fwd, NWAVES * 64, LDS_BYTES) != hipSuccess || per_cu < 1)
            fprintf(stderr, "kernel_launch: occupancy query reports %d workgroups per CU\n", per_cu);
        (void)hipGetLastError();
        grid = cus;
    }
    if (grid < 0) return;
    if (hipMemsetAsync((char*)d_ws + WS_CTL, 0, CTL_ZERO_BYTES, stream) != hipSuccess) return;
    Args a{};
    for (int i = 0; i < 21; ++i) a.in[i] = (const float*)d_in[i];
    a.out = (float*)d_out; a.ws = (unsigned char*)d_ws;
    hipLaunchKernelGGL(hymba_fwd, dim3(grid), dim3(NWAVES * 64), LDS_BYTES, stream, a);
}
```

```cpp
#include <hip/hip_runtime.h>
#include <cstdio>
#include <cstdint>

namespace pg8 {
#define PG8_LAS __attribute__((address_space(3)))
typedef unsigned short bf16_t;
typedef short bf16x8 __attribute__((ext_vector_type(8)));
typedef float f32x4 __attribute__((ext_vector_type(4)));
typedef unsigned u32x4 __attribute__((ext_vector_type(4)));
constexpr int BM = 256, BK = 64, HALF = 128, HTB = HALF * BK * 2, STAGE_BYTES = 8 * HTB, NXCD = 8, WGM = 8;

__host__ __device__ __forceinline__ int lds_byte(int r, int c) { const int st = (r >> 4) * 2 + (c >> 5), rr = r & 15, cc = c & 31, ob = rr * 64 + cc * 2; return st * 1024 + (ob ^ (((ob >> 9) & 1) << 5)); }
__host__ __device__ __forceinline__ void stage_rc(int b, int& R, int& C) { const int st = b / 1024, sb = b % 1024, swz = sb ^ (((sb >> 9) & 1) << 5); R = (st >> 1) * 16 + swz / 64; C = (st & 1) * 32 + (swz % 64) / 2; }
__host__ __device__ __forceinline__ int perm32(int rho) { const int n = rho >> 4, i = rho & 15; return 8 * (i >> 2) + 4 * n + (i & 3); }

struct Unit { int pm, pn, e, rb, cnt; };

__device__ __forceinline__ bool static_order(int i, int G, int c, int nM, int nN, int& pm, int& pn) {
    const int nwg = nM * nN; const long L = (long)i * G + c; if (L >= nwg) return false;
    int wgid = (int)L; { const int q = nwg / NXCD, r = nwg % NXCD, xcd = wgid % NXCD, off = wgid / NXCD; wgid = (xcd < r ? xcd * (q + 1) : r * (q + 1) + (xcd - r) * q) + off; }
    const int nig = WGM * nN, gid = wgid / nig, fm = gid * WGM, gsz = (nM - fm) < WGM ? (nM - fm) : WGM;
    pm = fm + ((wgid % nig) % gsz); pn = (wgid % nig) / gsz; return true;
}

__device__ __forceinline__ unsigned cvt_pk_bf16(float lo, float hi) { unsigned r; asm volatile("v_cvt_pk_bf16_f32 %0, %1, %2" : "=v"(r) : "v"(lo), "v"(hi)); return r; }

typedef int i32x8 __attribute__((ext_vector_type(8)));
typedef int i32x4v __attribute__((ext_vector_type(4)));
template <class Epi, class Sched, bool FP8, bool ALIGN = true>
__device__ __forceinline__ void gemm_phase(PG8_LAS unsigned char* lds, PG8_LAS unsigned char* epi, const char* Abase, const int rp, const Sched& S, const Epi& E) {
    int tid = threadIdx.x; asm volatile("" : "+v"(tid));
    const int wid = __builtin_amdgcn_readfirstlane(tid >> 6), lane = tid & 63, wr = wid >> 2, wc = wid & 3, fr = lane & 15, fq = lane >> 4;
    const int nt = rp / 128;
    int RA[2]; unsigned CA2[2], voffB[2];
#pragma unroll
    for (int i = 0; i < 2; ++i) { int R, C; stage_rc(tid * 16 + i * 8192, R, C); const int Rb = Epi::PERM ? ((R & ~31) + perm32(R & 31)) : R;
        RA[i] = R; CA2[i] = (unsigned)C * 2u; voffB[i] = (unsigned)(Rb * rp + C * 2); }
    const size_t kstep = (size_t)(BK * 2);
    const size_t hstepB = (size_t)HALF * rp;
    const unsigned ldsw = (unsigned)wid * 1024u;
    const int aoff = lds_byte(wr * 64 + fr, fq * 8), boff = lds_byte(wc * 32 + fr, fq * 8);
#define PG8_SA(b, h) (((b) * 2 + (h)) * HTB)
#define PG8_SB(b, h) ((4 + (b) * 2 + (h)) * HTB)
#define PG8_STAGE(bufoff, gbase, voff) do { _Pragma("unroll") for (int _i = 0; _i < 2; ++_i) { unsigned _vo = (voff)[_i]; asm volatile("" : "+v"(_vo));   \
        __builtin_amdgcn_global_load_lds((const unsigned*)((const char*)(gbase) + _vo), (PG8_LAS unsigned*)(lds + (bufoff) + ldsw + _i * 8192), 16, 0, 0); } } while (0)
#define PG8_LDA(dst, b, h) do { _Pragma("unroll") for (int m = 0; m < 4; ++m) _Pragma("unroll") for (int k = 0; k < 2; ++k) dst[m][k] = *(const PG8_LAS bf16x8*)(lds + PG8_SA(b, h) + aoff + m * 2048 + k * 1024); } while (0)
#define PG8_LDB(dst, b, h) do { _Pragma("unroll") for (int n = 0; n < 2; ++n) _Pragma("unroll") for (int k = 0; k < 2; ++k) dst[n][k] = *(const PG8_LAS bf16x8*)(lds + PG8_SB(b, h) + boff + n * 2048 + k * 1024); } while (0)
#define PG8_CAT8(x) __builtin_shufflevector(__builtin_bit_cast(i32x4v, x[0]), __builtin_bit_cast(i32x4v, x[1]), 0, 1, 2, 3, 4, 5, 6, 7)
#define PG8_MMA_(ai, bj, At, Bt, Z) do { __builtin_amdgcn_s_setprio(1); \
        if constexpr (FP8) { _Pragma("unroll") for (int m = 0; m < 4; ++m) _Pragma("unroll") for (int n = 0; n < 2; ++n) \
            { const i32x8 _b = PG8_CAT8(Bt[n]), _a = PG8_CAT8(At[m]);   \
              if (Z) asm volatile("v_mfma_f32_16x16x128_f8f6f4 %0, %1, %2, 0" : "=&v"(acc[ai][bj][m][n]) : "v"(_b), "v"(_a)); \
              else asm volatile("v_mfma_f32_16x16x128_f8f6f4 %0, %1, %2, %0" : "+v"(acc[ai][bj][m][n]) : "v"(_b), "v"(_a)); } } \
        else { _Pragma("unroll") for (int m = 0; m < 4; ++m) _Pragma("unroll") for (int n = 0; n < 2; ++n) _Pragma("unroll") for (int k = 0; k < 2; ++k) \
            acc[ai][bj][m][n] = __builtin_amdgcn_mfma_f32_16x16x32_bf16(Bt[n][k], At[m][k], acc[ai][bj][m][n], 0, 0, 0); } \
        __builtin_amdgcn_s_setprio(0); } while (0)
#define PG8_MMA(ai, bj, At, Bt) PG8_MMA_(ai, bj, At, Bt, false)
#define PG8_MMA0(ai, bj, At, Bt) do { if (FP8 && first) PG8_MMA_(ai, bj, At, Bt, true); else PG8_MMA_(ai, bj, At, Bt, false); } while (0)
#define PG8_WAIT_V(n) asm volatile("s_waitcnt vmcnt(" #n ")" ::: "memory")
#define PG8_WAIT_L(n) asm volatile("s_waitcnt lgkmcnt(" #n ")" ::: "memory")
#define PG8_BAR __builtin_amdgcn_s_barrier()
#define PG8_SCHED __builtin_amdgcn_sched_barrier(0)
#define PG8_ZERO() do { if constexpr (!FP8) { _Pragma("unroll") for (int a = 0; a < 2; ++a) _Pragma("unroll") for (int b = 0; b < 2; ++b) _Pragma("unroll") for (int m = 0; m < 4; ++m) _Pragma("unroll") for (int n = 0; n < 2; ++n) acc[a][b][m][n] = (f32x4){0.f, 0.f, 0.f, 0.f}; } } while (0)
#define PG8_VA(dst, u) do { _Pragma("unroll") for (int _h = 0; _h < 2; ++_h) _Pragma("unroll") for (int _i = 0; _i < 2; ++_i) dst[_h][_i] = S.a_off(u, _h * HALF + RA[_i]) + CA2[_i]; } while (0)
    Unit cur, nxt; int ui = 0;
    if (!S.next(0, cur)) return;
    f32x4 acc[2][2][4][2];
    PG8_ZERO();
    bf16x8 At[4][2], B0[2][2], B1[2][2];
    unsigned cvA[2][2], nvA[2][2];
    float rs[2][4];
    PG8_VA(cvA, cur);
    const char* cB = S.b_tile(cur);
    const char* cA = Abase + S.a_base(cur);
    E.side(cur, epi, wid, lane);
    PG8_STAGE(PG8_SB(0, 0), cB, voffB); PG8_STAGE(PG8_SB(0, 1), cB + hstepB, voffB); PG8_STAGE(PG8_SA(0, 0), cA, cvA[0]); PG8_STAGE(PG8_SA(0, 1), cA, cvA[1]);
    if (wr == 1) PG8_BAR;
    PG8_WAIT_V(2); PG8_BAR;
    PG8_STAGE(PG8_SB(1, 0), cB + kstep, voffB); PG8_STAGE(PG8_SA(1, 0), cA + kstep, cvA[0]); PG8_STAGE(PG8_SB(1, 1), cB + hstepB + kstep, voffB);
    PG8_WAIT_V(6); PG8_BAR;
    for (;;) {
        const bool has_next = S.next(ui + 1, nxt);
        if constexpr (Sched::GATHER) { if (has_next) S.gather_dma(nxt, epi + ((ui + 1) & 1) * 4096 + 3072, wid, lane); }
        const char* nB = has_next ? S.b_tile(nxt) : cB;
        const char* nA = has_next ? Abase + S.a_base(nxt) : cA;
        PG8_LAS unsigned char* area = epi + (ui & 1) * 4096;
        for (int t = 0; t < nt; t += 2) {
            const bool last = (t == nt - 2), first = (t == 0);
            if constexpr (Epi::MIDSCALE) { if (t == nt / 2) {
#pragma unroll
                for (int a = 0; a < 2; ++a)
#pragma unroll
                    for (int m = 0; m < 4; ++m) rs[a][m] = *(const PG8_LAS float*)(area + 1024 + 4 * (a * 128 + wr * 64 + m * 16 + fr));
#pragma unroll
                for (int a = 0; a < 2; ++a)
#pragma unroll
                    for (int b = 0; b < 2; ++b)
#pragma unroll
                        for (int m = 0; m < 4; ++m)
#pragma unroll
                            for (int n = 0; n < 2; ++n) acc[a][b][m][n] = acc[a][b][m][n] * rs[a][m]; } }
            const char* a1 = cA + (size_t)(t + 1) * kstep;
            const char* a2 = last ? nA : cA + (size_t)(t + 2) * kstep; const char* b2 = last ? nB : cB + (size_t)(t + 2) * kstep;
            const char* a3 = a2 + kstep; const char* b3 = b2 + kstep;
            if constexpr (Sched::GATHER) { if (last) {
#pragma unroll
                for (int h = 0; h < 2; ++h)
#pragma unroll
                    for (int i = 0; i < 2; ++i) nvA[h][i] = has_next ? S.a_fin(nxt, h * HALF + RA[i], *(const PG8_LAS int*)(epi + ((ui + 1) & 1) * 4096 + 3072 + 4 * (h * HALF + RA[i]))) + CA2[i] : cvA[h][i]; } }
            unsigned sA[2][2];
#pragma unroll
            for (int h = 0; h < 2; ++h)
#pragma unroll
                for (int i = 0; i < 2; ++i) sA[h][i] = (Sched::GATHER && last) ? nvA[h][i] : cvA[h][i];
            PG8_LDB(B0, 0, 0); PG8_LDB(B1, 0, 1); PG8_SCHED; PG8_LDA(At, 0, 0); PG8_STAGE(PG8_SA(1, 1), a1, cvA[1]);
            PG8_WAIT_V(8); PG8_WAIT_L(0); PG8_BAR; PG8_MMA0(0, 0, At, B0); PG8_MMA0(0, 1, At, B1); PG8_BAR; PG8_SCHED;
            PG8_LDA(At, 0, 1); PG8_STAGE(PG8_SB(0, 0), b2, voffB); PG8_STAGE(PG8_SB(0, 1), b2 + hstepB, voffB); PG8_STAGE(PG8_SA(0, 0), a2, sA[0]);
            PG8_WAIT_V(8); PG8_WAIT_L(0); PG8_BAR; PG8_MMA0(1, 0, At, B0); PG8_MMA0(1, 1, At, B1); PG8_BAR; PG8_SCHED;
            PG8_LDB(B0, 1, 0); PG8_LDB(B1, 1, 1); PG8_SCHED; PG8_LDA(At, 1, 0); PG8_STAGE(PG8_SA(0, 1), a2, sA[1]);
            PG8_WAIT_V(8); PG8_WAIT_L(0); PG8_BAR; PG8_MMA(0, 0, At, B0); PG8_MMA(0, 1, At, B1); PG8_BAR; PG8_SCHED;
            PG8_LDA(At, 1, 1); PG8_STAGE(PG8_SB(1, 0), b3, voffB); PG8_STAGE(PG8_SB(1, 1), b3 + hstepB, voffB); PG8_STAGE(PG8_SA(1, 0), a3, sA[0]);
            PG8_WAIT_V(8); PG8_WAIT_L(0); PG8_BAR; PG8_MMA(1, 0, At, B0); PG8_MMA(1, 1, At, B1); PG8_BAR; PG8_SCHED;
        }
        if constexpr (ALIGN) { if (wr == 0) PG8_BAR; }
        if constexpr (FP8) asm volatile("s_nop 15\n\ts_nop 15" ::: "memory");
        E(acc, cur, wr, wc, fr, fq, area);
        if (!has_next) break;
        PG8_ZERO();
        cur = nxt; cB = nB; cA = nA; ++ui;
        E.side(cur, epi + (ui & 1) * 4096, wid, lane);
        if constexpr (Sched::GATHER) {
#pragma unroll
            for (int h = 0; h < 2; ++h)
#pragma unroll
                for (int i = 0; i < 2; ++i) cvA[h][i] = nvA[h][i]; }
        if constexpr (ALIGN) { if (wr == 1) PG8_BAR; }
    }
    PG8_WAIT_V(0);
    if constexpr (!ALIGN) { if (wr == 0) PG8_BAR; }
    PG8_BAR;
#undef PG8_SA
#undef PG8_SB
#undef PG8_STAGE
#undef PG8_LDA
#undef PG8_LDB
#undef PG8_MMA
#undef PG8_MMA_
#undef PG8_MMA0
#undef PG8_CAT8
#undef PG8_WAIT_V
#undef PG8_WAIT_L
#undef PG8_BAR
#undef PG8_SCHED
#undef PG8_ZERO
#undef PG8_VA
}
}

constexpr int NWAVES = 8;
constexpr int T = 32768, SEQ = 2048, D = 1024, INW = 1792, NEXP = 32, TOPK = 4;
constexpr int COL_K = 512, COL_V = 640, COL_U = 768;
constexpr int PJW = 1280;
constexpr float RMS_EPS = 1e-5f, LN_EPS = 1e-5f;
constexpr float LOG2E = 1.4426950408889634f;
constexpr float QSCALE = 0.125f * LOG2E;
constexpr int LIST_CAP = 32768;
constexpr int MAX_RB = 544;

constexpr size_t MiB = 1u << 20;
constexpr size_t WS_CTL = 0, CTL_ZERO_BYTES = 16 * 1024;
constexpr size_t WS_WIN = 2 * MiB;
constexpr size_t WS_WOUT = 6 * MiB;
constexpr size_t WS_W1 = 8 * MiB;
constexpr size_t WS_W2 = 136 * MiB;
constexpr size_t WS_XN = 200 * MiB;
constexpr size_t WS_LTOK = 264 * MiB;
constexpr size_t WS_LGATE = 268 * MiB;
constexpr size_t WS_B1P = 272 * MiB;
constexpr size_t WS_RA = 272 * MiB + 512 * 1024;
constexpr size_t WS_WR = 273 * MiB;
constexpr size_t WS_ACT = 274 * MiB;
constexpr size_t WS_PROJ = 546 * MiB;
constexpr size_t WS_MIX = 658 * MiB;
constexpr size_t WS_Y = 546 * MiB;
constexpr size_t WS_XN8 = 674 * MiB;
constexpr size_t WS_END = 802 * MiB;
static_assert(WS_ACT + (size_t)MAX_RB * 256 * 1024 * 2 <= WS_PROJ && WS_MIX + (size_t)T * 1024 * 2 <= WS_END && WS_Y + (size_t)T * 4 * 1024 * 2 <= WS_END, "ws map");
constexpr int CW_BAR = 0;
constexpr int CW_GCNT = 3584;
static_assert((CW_BAR + 3456) * 4 <= (int)CTL_ZERO_BYTES && (CW_GCNT + 32 * 16) * 4 <= (int)CTL_ZERO_BYTES, "control words inside the per-call memset");

constexpr int RING_BYTES = 131072;
constexpr int MISC_OFF = RING_BYTES;
constexpr int TAB_OFF = MISC_OFF + 256;
constexpr int EPI_OFF = RING_BYTES + 2048;
constexpr int P4_G_OFF = EPI_OFF + 8 * 2112;
constexpr int LDS_BYTES = 154624;

#define GAS __attribute__((address_space(1)))
#define LAS __attribute__((address_space(3)))
typedef unsigned short bf16;
typedef unsigned v4u __attribute__((ext_vector_type(4)));
typedef unsigned v2u __attribute__((ext_vector_type(2)));
typedef float f32x4 __attribute__((ext_vector_type(4)));
typedef float f32x2 __attribute__((ext_vector_type(2)));
typedef short bf16x8 __attribute__((ext_vector_type(8)));
typedef short v4i16_t __attribute__((ext_vector_type(4)));
#define LDS_WAIT() asm volatile("s_waitcnt lgkmcnt(0)" ::: "memory")
#define VM_WAIT() asm volatile("s_waitcnt vmcnt(0)" ::: "memory")
__device__ __forceinline__ unsigned pk2(float lo, float hi) { return pg8::cvt_pk_bf16(lo, hi); }
__device__ __forceinline__ unsigned pk4_fp8(float a, float b, float c, float d) { int w = 0; w = __builtin_amdgcn_cvt_pk_fp8_f32(a, b, w, false); w = __builtin_amdgcn_cvt_pk_fp8_f32(c, d, w, true); return (unsigned)w; }
constexpr float W_SCALE = 64.0f, H_SCALE = 8.0f, ACT_SCALE = 4.0f, Y_SCALE = 16.0f;
__device__ __forceinline__ float bf_lo(unsigned w) { return __uint_as_float(w << 16); }
__device__ __forceinline__ float bf_hi(unsigned w) { return __uint_as_float(w & 0xffff0000u); }

#define XB_TMO      128
#define XB_XCNT(j)  (256  + 64 * (j))
#define XB_XSUB(j)  (1280 + 64 * (j))
#define XB_XGEN(j)  (2304 + 64 * (j))
#define XB_TOP      3328
#define XB_TOPGEN   3392
#define XCD_BAR_WORDS 3456
#define XB_SPIN_CAP (1u << 18)

__device__ __forceinline__ unsigned xb_ld(unsigned* p)              { return __hip_atomic_load(p, __ATOMIC_RELAXED, __HIP_MEMORY_SCOPE_AGENT); }
__device__ __forceinline__ unsigned xb_add(unsigned* p, unsigned v) { return __hip_atomic_fetch_add(p, v, __ATOMIC_RELAXED, __HIP_MEMORY_SCOPE_AGENT); }
__device__ __forceinline__ unsigned xb_xcc_id() { return (unsigned)__builtin_amdgcn_s_getreg((3 << 11) | 20) & 0xFu; }
#define XB_SPIN(cond, bar) do { unsigned _sp = 0; while (cond) { __builtin_amdgcn_s_sleep(1); \
    if ((++_sp & 255u) == 0u) { if (xb_ld(&(bar)[XB_TMO])) break; if (_sp > XB_SPIN_CAP) { atomicAdd(&(bar)[XB_TMO], 1u); break; } } } } while (0)

struct XcdBarrier { unsigned* bar; unsigned x; volatile LAS unsigned* st; };

__device__ __forceinline__ XcdBarrier xcd_barrier_post(unsigned* bar, volatile LAS unsigned* st) {
    XcdBarrier b; b.bar = bar; b.x = xb_xcc_id(); b.st = st;
    if (threadIdx.x == 0) (void)xb_add(&bar[XB_XCNT(b.x)], 1u);
    return b;
}
__device__ __forceinline__ void xcd_barrier_complete(unsigned* bar, unsigned x, unsigned& nloc, unsigned& nx) {
    const unsigned G = gridDim.x * gridDim.y * gridDim.z;
    unsigned sum, cnt, mine, sp = 0u;
    for (;;) {
        sum = 0u; cnt = 0u; mine = 0u;
#pragma unroll
        for (unsigned j = 0; j < 16; ++j) { const unsigned c = xb_ld(&bar[XB_XCNT(j)]); sum += c; cnt += (c > 0u) ? 1u : 0u; mine = (j == x) ? c : mine; }
        if (sum == G) break;
        __builtin_amdgcn_s_sleep(1);
        if ((++sp & 255u) == 0u) { if (xb_ld(&bar[XB_TMO])) break; if (sp > XB_SPIN_CAP) { atomicAdd(&bar[XB_TMO], 1u); break; } }
    }
    nloc = mine > 0u ? mine : 1u; nx = cnt > 0u ? cnt : 1u;
}
__device__ __forceinline__ void xcd_barrier(const XcdBarrier& b) {
    asm volatile("s_waitcnt vmcnt(0)" ::: "memory");
    __syncthreads();
    if (threadIdx.x == 0) {
        unsigned* bar = b.bar;
        __builtin_amdgcn_s_waitcnt(0);
        unsigned nloc = b.st[0], nx = b.st[1];
        if (nloc == 0u) { xcd_barrier_complete(bar, b.x, nloc, nx); b.st[0] = nloc; b.st[1] = nx; }
        const unsigned old = xb_add(&bar[XB_XSUB(b.x)], 1u);
        const unsigned gen = old / nloc;
        if (old + 1u == (gen + 1u) * nloc) {
            __builtin_amdgcn_fence(__ATOMIC_RELEASE, "agent");
            asm volatile("s_waitcnt vmcnt(0)" ::: "memory");
            const unsigned og = xb_add(&bar[XB_TOP], 1u);
            const unsigned tg = og / nx;
            if (og + 1u == (tg + 1u) * nx) xb_add(&bar[XB_TOPGEN], 1u);
            else XB_SPIN(xb_ld(&bar[XB_TOPGEN]) == tg, bar);
            __builtin_amdgcn_fence(__ATOMIC_ACQUIRE, "agent");
            xb_add(&bar[XB_XGEN(b.x)], 1u);
            asm volatile("s_waitcnt vmcnt(0)" ::: "memory");
        } else {
            XB_SPIN(xb_ld(&bar[XB_XGEN(b.x)]) == gen, bar);
            __builtin_amdgcn_fence(__ATOMIC_ACQUIRE, "agent");
            asm volatile("s_waitcnt vmcnt(0)" ::: "memory");
        }
    }
    __syncthreads();
}

template <int CTRL, int RMASK> __device__ __forceinline__ float dpp_add(float v) { return v + __builtin_bit_cast(float, __builtin_amdgcn_update_dpp(0, __builtin_bit_cast(int, v), CTRL, RMASK, 0xf, false)); }
__device__ __forceinline__ float wave_sum_dpp(float v) {
    v = dpp_add<0xB1, 0xf>(v); v = dpp_add<0x4E, 0xf>(v); v = dpp_add<0x141, 0xf>(v); v = dpp_add<0x140, 0xf>(v);
    v = dpp_add<0x142, 0xa>(v); v = dpp_add<0x143, 0xc>(v);
    return __builtin_bit_cast(float, __builtin_amdgcn_readlane(__builtin_bit_cast(int, v), 63));
}
__device__ __forceinline__ float wave_sum(float v) {
#pragma unroll
    for (int o = 1; o < 64; o <<= 1) v += __shfl_xor(v, o);
    return v;
}

struct DenseSched {
    static constexpr bool GATHER = false;
    const char* Bt; int nM, nN, G, c, rp, ibeg, iend;
    __device__ __forceinline__ size_t a_base(const pg8::Unit& u) const { return (size_t)u.pm * 256 * (size_t)rp; }
    __device__ __forceinline__ bool next(int i, pg8::Unit& u) const { u.e = 0; u.rb = 0; u.cnt = 0; if (i + ibeg >= iend) return false; return pg8::static_order(i + ibeg, G, c, nM, nN, u.pm, u.pn); }
    __device__ __forceinline__ const char* b_tile(const pg8::Unit& u) const { return Bt + (size_t)u.pn * 256 * rp; }
    __device__ __forceinline__ unsigned a_off(const pg8::Unit&, int r) const { return (unsigned)r * (unsigned)rp; }
    __device__ __forceinline__ int a_raw(const pg8::Unit&, int) const { return 0; }
    __device__ __forceinline__ unsigned a_fin(const pg8::Unit&, int r, int) const { return (unsigned)r * (unsigned)rp; }
};
template <bool GATHER_> struct MoeSched {
    static constexpr bool GATHER = GATHER_;
    const char* Bt; size_t bexp;
    const int* ltok; const LAS int* rbs; const LAS int* cnt; int nM, nN, G, c, rp;
    __device__ __forceinline__ size_t a_base(const pg8::Unit& u) const { return GATHER_ ? (size_t)0 : (size_t)u.pm * 256 * (size_t)rp; }
    __device__ __forceinline__ bool next(int i, pg8::Unit& u) const {
        if (!pg8::static_order(i, G, c, nM, nN, u.pm, u.pn)) return false;
        const int lane = threadIdx.x & 63;
        const int v = (lane < 32) ? rbs[lane + 1] : 0x7fffffff;
        const unsigned long long m = __ballot(v <= u.pm);
        const int e = __builtin_amdgcn_readfirstlane((int)__popcll(m));
        u.e = e; u.rb = u.pm - __builtin_amdgcn_readfirstlane(rbs[e]); u.cnt = __builtin_amdgcn_readfirstlane(cnt[e]);
        return true;
    }
    __device__ __forceinline__ const char* b_tile(const pg8::Unit& u) const { return Bt + (size_t)u.e * bexp + (size_t)u.pn * 256 * rp; }
    __device__ __forceinline__ unsigned a_off(const pg8::Unit& u, int r) const {
        return a_fin(u, r, a_raw(u, r));
    }
    __device__ __forceinline__ int a_raw(const pg8::Unit& u, int r) const { if constexpr (GATHER_) return ltok[u.e * LIST_CAP + u.rb * 256 + r]; else return 0; }
    __device__ __forceinline__ void gather_dma(const pg8::Unit& u, LAS unsigned char* dst, int wid, int lane) const {
        if (wid < 4) __builtin_amdgcn_global_load_lds((const unsigned*)(ltok + (size_t)u.e * LIST_CAP + u.rb * 256 + wid * 64 + lane), (LAS unsigned*)(dst + wid * 256), 4, 0, 0); }
    __device__ __forceinline__ unsigned a_fin(const pg8::Unit& u, int r, int raw) const {
        if constexpr (GATHER_) { const int t4 = (u.rb * 256 + r < u.cnt) ? raw : 0; return (unsigned)(t4 >> 2) * (unsigned)rp; }
        else return (unsigned)r * (unsigned)rp;
    }
};

__device__ __forceinline__ void side_dma(const void* src_lane, LAS unsigned char* dst_wave) { __builtin_amdgcn_global_load_lds((const unsigned*)src_lane, (LAS unsigned*)dst_wave, 4, 0, 0); }

struct EpiProj {
    static constexpr bool PERM = true, MIDSCALE = false;
    bf16* O; const float* bias; const float* rowscale;
    __device__ __forceinline__ void side(const pg8::Unit& u, LAS unsigned char* area, int wid, int lane) const {
        if (wid < 4) side_dma(bias + u.pn * 256 + wid * 64 + lane, area + wid * 256);
        else side_dma(rowscale + u.pm * 256 + (wid - 4) * 64 + lane, area + 1024 + (wid - 4) * 256); }
    __device__ __forceinline__ void operator()(const f32x4 (&acc)[2][2][4][2], const pg8::Unit& u, int wr, int wc, int fr, int fq, const LAS unsigned char* area) const {
        const int row0 = u.pm * 256 + wr * 64 + fr;
        f32x4 bv[2][2];
#pragma unroll
        for (int bj = 0; bj < 2; ++bj)
#pragma unroll
            for (int n = 0; n < 2; ++n) bv[bj][n] = *(const LAS f32x4*)(area + 4 * (wc * 32 + 8 * fq + bj * 128 + 4 * n));
        if (u.pn < 3) {
            const int col0 = u.pn * 256 + wc * 32 + 8 * fq;
            const float sc = (u.pn < 2) ? QSCALE : 1.0f;
#pragma unroll
            for (int ai = 0; ai < 2; ++ai)
#pragma unroll
                for (int m = 0; m < 4; ++m) { bf16* rowp = O + (size_t)(row0 + ai * 128 + m * 16) * PJW + col0;
                    const float rs = *(const LAS float*)(area + 1024 + 4 * (ai * 128 + wr * 64 + m * 16 + fr));
#pragma unroll
                    for (int bj = 0; bj < 2; ++bj) { const f32x4 v0 = (acc[ai][bj][m][0] * rs + bv[bj][0]) * sc, v1 = (acc[ai][bj][m][1] * rs + bv[bj][1]) * sc;
                        v4u w; w.x = pk2(v0[0], v0[1]); w.y = pk2(v0[2], v0[3]); w.z = pk2(v1[0], v1[1]); w.w = pk2(v1[2], v1[3]);
                        *(v4u*)(rowp + bj * 128) = w; } }
        } else {
            const int col0 = COL_U + (u.pn - 3) * 128 + wc * 32 + 8 * fq;
#pragma unroll
            for (int ai = 0; ai < 2; ++ai)
#pragma unroll
                for (int m = 0; m < 4; ++m) { bf16* rowp = O + (size_t)(row0 + ai * 128 + m * 16) * PJW + col0;
                    const float rs = *(const LAS float*)(area + 1024 + 4 * (ai * 128 + wr * 64 + m * 16 + fr));
                    f32x2 uv[4];
#pragma unroll
                    for (int n = 0; n < 2; ++n)
#pragma unroll
                        for (int p = 0; p < 2; ++p) {
                            const f32x2 av = (f32x2){acc[ai][0][m][n][2 * p], acc[ai][0][m][n][2 * p + 1]} * rs + (f32x2){bv[0][n][2 * p], bv[0][n][2 * p + 1]};
                            const f32x2 gv = (f32x2){acc[ai][1][m][n][2 * p], acc[ai][1][m][n][2 * p + 1]} * rs + (f32x2){bv[1][n][2 * p], bv[1][n][2 * p + 1]};
                            const f32x2 z = gv * (-LOG2E);
                            const f32x2 d = (f32x2){__builtin_amdgcn_exp2f(z.x), __builtin_amdgcn_exp2f(z.y)} + 1.0f;
                            uv[2 * n + p] = av * (f32x2){__builtin_amdgcn_rcpf(d.x), __builtin_amdgcn_rcpf(d.y)}; }
                    v4u w; w.x = pk2(uv[0].x, uv[0].y); w.y = pk2(uv[1].x, uv[1].y); w.z = pk2(uv[2].x, uv[2].y); w.w = pk2(uv[3].x, uv[3].y);
                    *(v4u*)rowp = w; }
        }
    }
};
struct EpiRes {
    static constexpr bool PERM = true, MIDSCALE = true;
    const bf16* base; bf16* out; const float* bias; const float* rowscale;
    __device__ __forceinline__ void side(const pg8::Unit& u, LAS unsigned char* area, int wid, int lane) const {
        if (wid < 4) side_dma(bias + u.pn * 256 + wid * 64 + lane, area + wid * 256);
        else side_dma(rowscale + u.pm * 256 + (wid - 4) * 64 + lane, area + 1024 + (wid - 4) * 256); }
    __device__ __forceinline__ void operator()(const f32x4 (&acc)[2][2][4][2], const pg8::Unit& u, int wr, int wc, int fr, int fq, const LAS unsigned char* area) const {
        const int col0 = u.pn * 256 + wc * 32 + 8 * fq;
        f32x4 bv[2][2];
#pragma unroll
        for (int bj = 0; bj < 2; ++bj)
#pragma unroll
            for (int n = 0; n < 2; ++n) bv[bj][n] = *(const LAS f32x4*)(area + 4 * (wc * 32 + 8 * fq + bj * 128 + 4 * n));
#pragma unroll
        for (int ai = 0; ai < 2; ++ai) {
            v4u xr[4][2];
#pragma unroll
            for (int m = 0; m < 4; ++m) { const size_t off = (size_t)(u.pm * 256 + ai * 128 + wr * 64 + m * 16 + fr) * D + col0;
#pragma unroll
                for (int bj = 0; bj < 2; ++bj) xr[m][bj] = *(const v4u*)(base + off + bj * 128); }
            __builtin_amdgcn_sched_barrier(0);
#pragma unroll
            for (int m = 0; m < 4; ++m) { const size_t off = (size_t)(u.pm * 256 + ai * 128 + wr * 64 + m * 16 + fr) * D + col0;
#pragma unroll
                for (int bj = 0; bj < 2; ++bj) { const v4u xw = xr[m][bj];
                    const f32x4 v0 = (f32x4){bf_lo(xw.x), bf_hi(xw.x), bf_lo(xw.y), bf_hi(xw.y)} + acc[ai][bj][m][0] + bv[bj][0], v1 = (f32x4){bf_lo(xw.z), bf_hi(xw.z), bf_lo(xw.w), bf_hi(xw.w)} + acc[ai][bj][m][1] + bv[bj][1];
                    v4u w; w.x = pk2(v0[0], v0[1]); w.y = pk2(v0[2], v0[3]); w.z = pk2(v1[0], v1[1]); w.w = pk2(v1[2], v1[3]);
                    *(v4u*)(out + off + bj * 128) = w; } }
        }
    }
};
struct EpiSwiglu {
    static constexpr bool PERM = true, MIDSCALE = false;
    unsigned char* O; const float* b1p;
    __device__ __forceinline__ void side(const pg8::Unit& u, LAS unsigned char* area, int wid, int lane) const { if (wid < 4) side_dma(b1p + (size_t)u.e * 2048 + u.pn * 256 + wid * 64 + lane, area + wid * 256); }
    __device__ __forceinline__ void operator()(const f32x4 (&acc)[2][2][4][2], const pg8::Unit& u, int wr, int wc, int fr, int fq, const LAS unsigned char* area) const {
        const int row0 = u.pm * 256 + wr * 64 + fr, ocol0 = u.pn * 128 + wc * 32 + 8 * fq;
        f32x4 bg[2], bl[2];
#pragma unroll
        for (int n = 0; n < 2; ++n) { bg[n] = *(const LAS f32x4*)(area + 4 * (wc * 32 + 8 * fq + 4 * n)); bl[n] = *(const LAS f32x4*)(area + 4 * (128 + wc * 32 + 8 * fq + 4 * n)); }
        constexpr float SI = 1.0f / (H_SCALE * W_SCALE);
        const int odd = fq & 1, ocolw = u.pn * 128 + wc * 32 + 8 * (fq & ~1);
#pragma unroll
        for (int ai = 0; ai < 2; ++ai)
#pragma unroll
            for (int j2 = 0; j2 < 2; ++j2) {
                v2u w[2];
#pragma unroll
                for (int mm = 0; mm < 2; ++mm) { const int m = 2 * j2 + mm;
                f32x2 a[4];
#pragma unroll
                for (int n = 0; n < 2; ++n)
#pragma unroll
                    for (int p = 0; p < 2; ++p) {
                        const f32x2 gv = (f32x2){acc[ai][0][m][n][2 * p], acc[ai][0][m][n][2 * p + 1]} * SI + (f32x2){bg[n][2 * p], bg[n][2 * p + 1]};
                        const f32x2 lv = (f32x2){acc[ai][1][m][n][2 * p], acc[ai][1][m][n][2 * p + 1]} * SI + (f32x2){bl[n][2 * p], bl[n][2 * p + 1]};
                        const f32x2 gg = (f32x2){fminf(gv.x, 7.0f), fminf(gv.y, 7.0f)};
                        const f32x2 ll = (f32x2){__builtin_amdgcn_fmed3f(lv.x, -7.0f, 7.0f), __builtin_amdgcn_fmed3f(lv.y, -7.0f, 7.0f)};
                        const f32x2 z = gg * (-1.702f * LOG2E);
                        const f32x2 d = (f32x2){__builtin_amdgcn_exp2f(z.x), __builtin_amdgcn_exp2f(z.y)} + 1.0f;
                        const f32x2 r = (f32x2){__builtin_amdgcn_rcpf(d.x), __builtin_amdgcn_rcpf(d.y)};
                        a[2 * n + p] = (gg * r) * (ll * ACT_SCALE + ACT_SCALE); }
                w[mm].x = pk4_fp8(a[0].x, a[0].y, a[1].x, a[1].y); w[mm].y = pk4_fp8(a[2].x, a[2].y, a[3].x, a[3].y); }
                const auto rx = __builtin_amdgcn_permlane16_swap(w[0].x, w[1].x, false, false), ry = __builtin_amdgcn_permlane16_swap(w[0].y, w[1].y, false, false);
                v4u o; o.x = rx[0]; o.y = ry[0]; o.z = rx[1]; o.w = ry[1];
                *(v4u*)(O + (size_t)(row0 + ai * 128 + (2 * j2 + odd) * 16) * 1024 + ocolw) = o; }
    }
};
struct EpiMoeOut {
    static constexpr bool PERM = true, MIDSCALE = false;
    unsigned char* Y; const float* b2; const int* ltok; const float* lgate;
    __device__ __forceinline__ void side(const pg8::Unit& u, LAS unsigned char* area, int wid, int lane) const {
        if (wid < 4) { side_dma(b2 + (size_t)u.e * 1024 + u.pn * 256 + wid * 64 + lane, area + wid * 256); side_dma(ltok + (size_t)u.e * LIST_CAP + u.rb * 256 + wid * 64 + lane, area + 1024 + wid * 256); }
        else side_dma(lgate + (size_t)u.e * LIST_CAP + u.rb * 256 + (wid - 4) * 64 + lane, area + 2048 + (wid - 4) * 256); }
    __device__ __forceinline__ void operator()(const f32x4 (&acc)[2][2][4][2], const pg8::Unit& u, int wr, int wc, int fr, int fq, const LAS unsigned char* area) const {
        const int col0 = u.pn * 256 + wc * 32 + 8 * fq;
        f32x4 bv[2][2];
#pragma unroll
        for (int bj = 0; bj < 2; ++bj)
#pragma unroll
            for (int n = 0; n < 2; ++n) bv[bj][n] = *(const LAS f32x4*)(area + 4 * (wc * 32 + 8 * fq + bj * 128 + 4 * n));
        const int odd = fq & 1, colw = u.pn * 256 + wc * 32 + 8 * (fq & ~1);
#pragma unroll
        for (int ai = 0; ai < 2; ++ai)
#pragma unroll
            for (int j2 = 0; j2 < 2; ++j2) {
                int t4[2]; float gt[2]; bool ok[2];
#pragma unroll
                for (int mm = 0; mm < 2; ++mm) { const int r = ai * 128 + wr * 64 + (2 * j2 + mm) * 16 + fr;
                    t4[mm] = *(const LAS int*)(area + 1024 + 4 * r); gt[mm] = *(const LAS float*)(area + 2048 + 4 * r) * Y_SCALE; ok[mm] = (u.rb * 256 + r < u.cnt); }
                const int t4s = odd ? t4[1] : t4[0]; const bool oks = odd ? ok[1] : ok[0];
#pragma unroll
                for (int bj = 0; bj < 2; ++bj) {
                    v2u w[2];
#pragma unroll
                    for (int mm = 0; mm < 2; ++mm) { const int m = 2 * j2 + mm;
                        const f32x4 v0 = (acc[ai][bj][m][0] * (1.0f / (ACT_SCALE * W_SCALE)) + bv[bj][0]) * gt[mm], v1 = (acc[ai][bj][m][1] * (1.0f / (ACT_SCALE * W_SCALE)) + bv[bj][1]) * gt[mm];
                        w[mm].x = pk4_fp8(v0[0], v0[1], v0[2], v0[3]); w[mm].y = pk4_fp8(v1[0], v1[1], v1[2], v1[3]); }
                    const auto rx = __builtin_amdgcn_permlane16_swap(w[0].x, w[1].x, false, false), ry = __builtin_amdgcn_permlane16_swap(w[0].y, w[1].y, false, false);
                    v4u o; o.x = rx[0]; o.y = ry[0]; o.z = rx[1]; o.w = ry[1];
                    if (oks) *(v4u*)(Y + (size_t)t4s * 1024 + colw + bj * 128) = o; } }
    }
};

__host__ __device__ __forceinline__ int win_row(int c) { if (c < 768) return c; const int cc = c - 768, ch = cc & 511; return 768 + (ch >> 7) * 256 + ((cc >> 9) & 1) * 128 + (ch & 127); }
template <int ESZ, int MODE  >
__device__ __forceinline__ void p0_item(const float* W, int N, unsigned char* WT, size_t rowpitch, LAS unsigned* scr, int kb, int nb, int lane, float scale, const float* kscale = nullptr, const float* kscale_hi = nullptr) {
    constexpr int KT = (ESZ == 2) ? 64 : 128, NT = (ESZ == 2) ? 64 : 32, LPR = NT / 4;
    const int k0 = KT * kb, n0 = NT * nb, lg = lane / LPR, nc = lane % LPR;
    const float* src = W + (size_t)(k0 + 16 * lg) * N + n0 + 4 * nc;
    f32x4 v[16];
#pragma unroll
    for (int i = 0; i < 16; ++i) v[i] = *(const f32x4*)(src + (size_t)i * N);
    if (kscale) {
#pragma unroll
        for (int i = 0; i < 16; ++i) { const int k = k0 + 16 * lg + i; v[i] = v[i] * ((kscale_hi && k >= 512) ? kscale_hi[k - 512] : kscale[k]); } }
#pragma unroll
    for (int e = 0; e < 4; ++e) {
        LAS unsigned* row = scr + (4 * nc + e) * 36;
        if (ESZ == 2) {
            v4u a, b;
            a.x = pk2(v[0][e] * scale, v[1][e] * scale); a.y = pk2(v[2][e] * scale, v[3][e] * scale); a.z = pk2(v[4][e] * scale, v[5][e] * scale); a.w = pk2(v[6][e] * scale, v[7][e] * scale);
            b.x = pk2(v[8][e] * scale, v[9][e] * scale); b.y = pk2(v[10][e] * scale, v[11][e] * scale); b.z = pk2(v[12][e] * scale, v[13][e] * scale); b.w = pk2(v[14][e] * scale, v[15][e] * scale);
            *(LAS v4u*)(row + 8 * lg) = a; *(LAS v4u*)(row + 8 * lg + 4) = b;
        } else {
            v4u a;
            a.x = pk4_fp8(v[0][e] * scale, v[1][e] * scale, v[2][e] * scale, v[3][e] * scale); a.y = pk4_fp8(v[4][e] * scale, v[5][e] * scale, v[6][e] * scale, v[7][e] * scale);
            a.z = pk4_fp8(v[8][e] * scale, v[9][e] * scale, v[10][e] * scale, v[11][e] * scale); a.w = pk4_fp8(v[12][e] * scale, v[13][e] * scale, v[14][e] * scale, v[15][e] * scale);
            *(LAS v4u*)(row + 4 * lg) = a;
        }
    }
    LDS_WAIT(); asm volatile("" ::: "memory");
    const int c = lane & 7;
#pragma unroll
    for (int j = 0; j < NT / 8; ++j) { const int n = (lane >> 3) + 8 * j; const v4u o = *(const LAS v4u*)(scr + n * 36 + 4 * c);
        const int col = n0 + n; const int row = (MODE == 1) ? ((col & ~255) + 128 * (col & 1) + ((col >> 1) & 127)) : (MODE == 2) ? win_row(col) : col;
        *(GAS v4u*)(WT + (size_t)row * rowpitch + (size_t)k0 * ESZ + 16 * c) = o; }
    LDS_WAIT(); asm volatile("" ::: "memory");
}

struct W8Item { const float* src; unsigned char* dst; int N, k0, n0, mode; };
__device__ __forceinline__ W8Item w8_item(int r, const float* w1, const float* w2, unsigned char* W1_t, unsigned char* W2_t) {
    W8Item it;
    if (r < 32 * 8 * 64) { const int e = r >> 9, q = r & 511; it.src = w1 + (size_t)e * 1024 * 2048; it.dst = W1_t + (size_t)e * 2048 * 1024; it.N = 2048; it.k0 = 128 * (q >> 6); it.n0 = 32 * (q & 63); it.mode = 1; }
    else { r -= 32 * 8 * 64; const int e = r >> 8, q = r & 255; it.src = w2 + (size_t)e * 1024 * 1024; it.dst = W2_t + (size_t)e * 1024 * 1024; it.N = 1024; it.k0 = 128 * (q >> 5); it.n0 = 32 * (q & 31); it.mode = 0; }
    return it;
}
__device__ __forceinline__ void w8_load(const W8Item& it, f32x4 (&v)[16], int lane) {
    const float* src = it.src + (size_t)(it.k0 + 16 * (lane >> 3)) * it.N + it.n0 + 4 * (lane & 7);
#pragma unroll
    for (int i = 0; i < 16; ++i) v[i] = __builtin_nontemporal_load((const f32x4*)(src + (size_t)i * it.N));
}
__device__ __forceinline__ void w8_store(const W8Item& it, const f32x4 (&v)[16], LAS unsigned* scr, int lane) {
    const int lg = lane >> 3, nc = lane & 7;
#pragma unroll
    for (int e = 0; e < 4; ++e) { v4u a;
        a.x = pk4_fp8(v[0][e] * W_SCALE, v[1][e] * W_SCALE, v[2][e] * W_SCALE, v[3][e] * W_SCALE); a.y = pk4_fp8(v[4][e] * W_SCALE, v[5][e] * W_SCALE, v[6][e] * W_SCALE, v[7][e] * W_SCALE);
        a.z = pk4_fp8(v[8][e] * W_SCALE, v[9][e] * W_SCALE, v[10][e] * W_SCALE, v[11][e] * W_SCALE); a.w = pk4_fp8(v[12][e] * W_SCALE, v[13][e] * W_SCALE, v[14][e] * W_SCALE, v[15][e] * W_SCALE);
        *(LAS v4u*)(scr + (4 * nc + e) * 36 + 4 * lg) = a; }
    LDS_WAIT(); asm volatile("" ::: "memory");
    const int c = lane & 7;
#pragma unroll
    for (int j = 0; j < 4; ++j) { const int n = (lane >> 3) + 8 * j; const v4u o = *(const LAS v4u*)(scr + n * 36 + 4 * c);
        const int col = it.n0 + n; const int row = it.mode ? ((col & ~255) + 128 * (col & 1) + ((col >> 1) & 127)) : col;
        *(GAS v4u*)(it.dst + (size_t)row * 1024 + it.k0 + 16 * c) = o; }
    LDS_WAIT(); asm volatile("" ::: "memory");
}

struct Args { const float* in[21]; float* out; unsigned char* ws; };

__global__ void __launch_bounds__(NWAVES * 64, 2) hymba_fwd(Args args) {
    extern __shared__ __attribute__((aligned(16))) unsigned char lds_raw[];
    LAS unsigned char* lds = (LAS unsigned char*)lds_raw;
    volatile LAS unsigned* MISC = (volatile LAS unsigned*)(lds + MISC_OFF);
    LAS int* TAB = (LAS int*)(lds + TAB_OFF);
    LAS int* t_rbs = TAB; LAS int* t_cnt = TAB + 40; LAS int* t_lcnt = TAB + 72; LAS int* t_gbase = TAB + 104;
#define PHASE_IDS() int tid = threadIdx.x; asm volatile("" : "+v"(tid)); const int lane = tid & 63, wave = __builtin_amdgcn_readfirstlane(tid >> 6); (void)lane; (void)wave
    const int G = gridDim.x;
    const int vcu = (G % 8 == 0) ? ((int)blockIdx.x % 8) * (G / 8) + (int)blockIdx.x / 8 : (int)blockIdx.x;

    const float* x = args.in[0]; const float* g_mix = args.in[1]; const float* w_in = args.in[2]; const float* b_in = args.in[3];
    const float* sinks = args.in[4]; const float* w_dw = args.in[5]; const float* b_dw = args.in[6]; const float* ln_g = args.in[7]; const float* ln_b = args.in[8];
    const float* g_attn = args.in[9]; const float* g_conv = args.in[10]; const float* w_out = args.in[11]; const float* b_out = args.in[12];
    const float* g_ffn = args.in[13]; const float* w_router = args.in[14]; const float* b_router = args.in[15];
    const float* w1 = args.in[16]; const float* b1 = args.in[17]; const float* w2 = args.in[18]; const float* b2 = args.in[19]; const float* g_final = args.in[20];
    float* out = args.out; unsigned char* ws = args.ws;
    unsigned* ctl = (unsigned*)(ws + WS_CTL);
    bf16* Win_t = (bf16*)(ws + WS_WIN); bf16* Wout_t = (bf16*)(ws + WS_WOUT); unsigned char* W1_t = ws + WS_W1; unsigned char* W2_t = ws + WS_W2; unsigned char* XN8 = ws + WS_XN8; bf16* X1B = (bf16*)(ws + WS_XN);
    bf16* XN = (bf16*)(ws + WS_XN); int* ltok = (int*)(ws + WS_LTOK); float* lgate = (float*)(ws + WS_LGATE); float* b1p = (float*)(ws + WS_B1P);
    float* RA = (float*)(ws + WS_RA); float* RS = RA + T; float* BINP = RS + T + 256;   bf16* WrHi = (bf16*)(ws + WS_WR); bf16* WrLo = WrHi + 32 * 1024;
    unsigned char* ACT = ws + WS_ACT; bf16* PROJ = (bf16*)(ws + WS_PROJ); bf16* MIX = (bf16*)(ws + WS_MIX); unsigned char* YB = ws + WS_Y;
    unsigned* gcnt = ctl + CW_GCNT;

    for (int u = threadIdx.x; u < (LDS_BYTES - MISC_OFF) / 4; u += NWAVES * 64) ((LAS unsigned*)(lds + MISC_OFF))[u] = 0u;
    __syncthreads();
    XcdBarrier bar = xcd_barrier_post(ctl + CW_BAR, MISC + 8);

    {
        PHASE_IDS();
        LAS unsigned* scr = (LAS unsigned*)(lds + wave * 16384);
        const int gw = vcu * NWAVES + wave, NGW = G * NWAVES;
        constexpr int I_IN = 16 * 28, I_OUT = 16 * 16;
        for (int it = gw; it < I_IN + I_OUT; it += NGW) {
            int r = it;
            if (r < I_IN) { p0_item<2, 2>(w_in, INW, (unsigned char*)Win_t, 2048, scr, r / 28, r % 28, lane, 1.0f, g_mix); continue; } r -= I_IN;
            p0_item<2, 0>(w_out, 1024, (unsigned char*)Wout_t, 2048, scr, r >> 4, r & 15, lane, 1.0f, g_attn, g_conv);
        }
        for (int m = 2 * gw; m < T; m += 2 * NGW) {
            const GAS f32x4* xr = (const GAS f32x4*)(x + (size_t)m * D) + lane;
            f32x4 v[2][4]; float s[2] = {0.f, 0.f};
#pragma unroll
            for (int q = 0; q < 2; ++q)
#pragma unroll
                for (int j = 0; j < 4; ++j) v[q][j] = __builtin_nontemporal_load(xr + q * 256 + 64 * j);
#pragma unroll
            for (int q = 0; q < 2; ++q)
#pragma unroll
                for (int j = 0; j < 4; ++j) s[q] += (v[q][j].x * v[q][j].x + v[q][j].y * v[q][j].y) + (v[q][j].z * v[q][j].z + v[q][j].w * v[q][j].w);
#pragma unroll
            for (int q = 0; q < 2; ++q) {
                const float rstd = 1.0f / sqrtf(wave_sum(s[q]) * (1.0f / D) + RMS_EPS);
                if (lane == 0) RS[m + q] = rstd;
                GAS v2u* o8 = (GAS v2u*)(XN + (size_t)(m + q) * D) + lane;
#pragma unroll
                for (int j = 0; j < 4; ++j) { v2u o; o.x = pk2(v[q][j].x, v[q][j].y); o.y = pk2(v[q][j].z, v[q][j].w); o8[64 * j] = o; }
            }
        }
        const int gt = vcu * (NWAVES * 64) + tid, NGT = G * NWAVES * 64;
        for (int i = gt; i < INW; i += NGT) BINP[win_row(i)] = b_in[i];
        for (int i = gt; i < 32 * 2048; i += NGT) { const int e = i >> 11, col = i & 2047; const int row = (col & ~255) + 128 * (col & 1) + ((col >> 1) & 127); b1p[e * 2048 + row] = b1[i]; }
        for (int i = gt; i < 32 * 1024; i += NGT) { const int e = i >> 10, k = i & 1023; const float v = w_router[k * 32 + e];
            const unsigned h = pk2(v, 0.f) & 0xffffu; const float lo = v - __uint_as_float(h << 16);
            const int fi = ((((e >> 4) * 32 + (k >> 5)) * 64 + 16 * ((k >> 3) & 3) + (e & 15)) * 8) + (k & 7);
            WrHi[fi] = (bf16)h; WrLo[fi] = (bf16)(pk2(lo, 0.f) & 0xffffu); }
    }
    xcd_barrier(bar);

    {
        const int grp = ((int)blockIdx.x >> 3) & 3;
        EpiProj E{PROJ, BINP, RS};
        {
            DenseSched S{(const char*)Win_t, T / 256, INW / 256, G, (int)blockIdx.x, 2048, 0, grp};
            pg8::gemm_phase<EpiProj, DenseSched, false>(lds, lds + EPI_OFF, (const char*)XN, 2048, S, E);
        }
        {
            PHASE_IDS();
            __syncthreads();
            LAS unsigned* scr = (LAS unsigned*)(lds + wave * 16384);
            const int gw = vcu * NWAVES + wave, NGW = G * NWAVES;
            constexpr int NIT_ALL = 16384;
            int it = gw, NIT = NIT_ALL, NGW_ = NGW;
            if (G == 256) { const int c = (int)blockIdx.x; NGW_ = 1024;
                if (c >= 128) { it = (c - 128) * NWAVES + wave; NIT = 10240; } else { it = 10240 + c * NWAVES + wave; NIT = NIT_ALL; } }
            f32x4 va[16], vb[16];
            W8Item ia = w8_item(24575 - (it < NIT ? it : 0), w1, w2, W1_t, W2_t), ib = ia;
            if (it < NIT) w8_load(ia, va, lane);
            while (it < NIT) {
                const int itb = it + NGW_;
                if (itb < NIT) { ib = w8_item(24575 - itb, w1, w2, W1_t, W2_t); w8_load(ib, vb, lane); }
                w8_store(ia, va, scr, lane);
                if (itb >= NIT) break;
                const int ita = itb + NGW_;
                if (ita < NIT) { ia = w8_item(24575 - ita, w1, w2, W1_t, W2_t); w8_load(ia, va, lane); }
                w8_store(ib, vb, scr, lane);
                it = ita;
            }
            __syncthreads();
        }
        {
            DenseSched S{(const char*)Win_t, T / 256, INW / 256, G, (int)blockIdx.x, 2048, grp, 1 << 30};
            pg8::gemm_phase<EpiProj, DenseSched, false>(lds, lds + EPI_OFF, (const char*)XN, 2048, S, E);
        }
    }
    xcd_barrier(bar);

    for (int unit = blockIdx.x; unit < T / 128; unit += G) {
        const int b = unit >> 4, n = unit & 15, t0 = b * SEQ + n * 128;
        {
            PHASE_IDS();
            constexpr int KOFF = 0, VOFF = 36864;
            const int i16 = lane & 15, g = lane >> 4;
            const int vq = i16 >> 2, vp = i16 & 3;
            float ssq = 0.f;
            const bf16* qrow = PROJ + (size_t)(t0 + 16 * wave + i16) * PJW + 8 * g;
            bf16* orow = MIX + (size_t)(t0 + 16 * wave + i16) * D + 4 * g;
            bf16x8 q0n = *(const bf16x8*)qrow, q1n = *(const bf16x8*)(qrow + 32);
            v4u kpre[4], vpre[4];
#define KV_LOAD(kvh) do { _Pragma("unroll") for (int c4 = 0; c4 < 4; ++c4) { const int c = tid + 512 * c4, row = c >> 3, ch = c & 7; kpre[c4] = (v4u){0u, 0u, 0u, 0u}; vpre[c4] = kpre[c4]; \
                if (n > 0 || row >= 128) { const bf16* p = PROJ + (size_t)(t0 - 128 + row) * PJW + (kvh) * 64 + ch * 8; kpre[c4] = *(const v4u*)(p + COL_K); vpre[c4] = *(const v4u*)(p + COL_V); } } } while (0)
#define KV_WRITE() do { _Pragma("unroll") for (int c4 = 0; c4 < 4; ++c4) { const int c = tid + 512 * c4, row = c >> 3, ch = c & 7; \
                *(LAS v4u*)(lds + KOFF + row * 144 + ch * 16) = kpre[c4]; *(LAS v4u*)(lds + VOFF + row * 144 + ch * 16) = vpre[c4]; } } while (0)
            KV_LOAD(0);
            __syncthreads();
            KV_WRITE();
            KV_LOAD(1);
            __syncthreads();
            for (int h = 0; h < 8; ++h) {
                if (h == 4) { __syncthreads(); KV_WRITE(); __syncthreads(); }
                const bf16x8 q0 = q0n, q1 = q1n;
                if (h < 7) { q0n = *(const bf16x8*)(qrow + (h + 1) * 64); q1n = *(const bf16x8*)(qrow + (h + 1) * 64 + 32); }
                f32x4 st[9];
#pragma unroll
                for (int j = 0; j < 9; ++j) { const LAS unsigned char* kp = lds + KOFF + (16 * (wave + j) + i16) * 144 + 16 * g;
                    const bf16x8 k0 = *(const LAS bf16x8*)kp, k1 = *(const LAS bf16x8*)(kp + 64);
                    st[j] = __builtin_amdgcn_mfma_f32_16x16x32_bf16(k0, q0, (f32x4){0.f, 0.f, 0.f, 0.f}, 0, 0, 0);
                    st[j] = __builtin_amdgcn_mfma_f32_16x16x32_bf16(k1, q1, st[j], 0, 0, 0); }
                const float NEG = -INFINITY;
#pragma unroll
                for (int j = 0; j < 9; ++j) { const bool dead = (n == 0) && (wave + j < 8);
#pragma unroll
                    for (int r = 0; r < 4; ++r) { const int kr = 4 * g + r; bool ok = !dead; if (j == 0) ok = ok && (kr > i16); if (j == 8) ok = ok && (kr <= i16); if (!ok) st[j][r] = NEG; } }
                const float sink2 = sinks[h] * LOG2E;
                float mx = sink2;
#pragma unroll
                for (int j = 0; j < 9; ++j) mx = fmaxf(fmaxf(mx, fmaxf(st[j][0], st[j][1])), fmaxf(st[j][2], st[j][3]));
                mx = fmaxf(mx, __shfl_xor(mx, 16)); mx = fmaxf(mx, __shfl_xor(mx, 32));
                float ls = 0.f;
#pragma unroll
                for (int j = 0; j < 9; ++j)
#pragma unroll
                    for (int r = 0; r < 4; ++r) { st[j][r] = __builtin_amdgcn_exp2f(st[j][r] - mx); ls += st[j][r]; }
                ls += __shfl_xor(ls, 16); ls += __shfl_xor(ls, 32);
                ls += __builtin_amdgcn_exp2f(sink2 - mx);
                const float inv = 1.0f / ls;
                bf16x8 pf[5];
#pragma unroll
                for (int kk = 0; kk < 5; ++kk) { v4u w; w.x = pk2(st[2 * kk][0], st[2 * kk][1]); w.y = pk2(st[2 * kk][2], st[2 * kk][3]);
                    if (kk < 4) { w.z = pk2(st[2 * kk + 1][0], st[2 * kk + 1][1]); w.w = pk2(st[2 * kk + 1][2], st[2 * kk + 1][3]); } else { w.z = 0u; w.w = 0u; }
                    pf[kk] = __builtin_bit_cast(bf16x8, w); }
#pragma unroll
                for (int dt = 0; dt < 4; ++dt) { f32x4 o = (f32x4){0.f, 0.f, 0.f, 0.f};
#pragma unroll
                    for (int kk = 0; kk < 5; ++kk) { const int kta = wave + 2 * kk, ktb = (kk < 4) ? wave + 2 * kk + 1 : wave + 8;
                        const LAS unsigned char* pa = lds + VOFF + (16 * kta + 4 * g + vq) * 144 + (16 * dt + 4 * vp) * 2;
                        const LAS unsigned char* pb = lds + VOFF + (16 * ktb + 4 * g + vq) * 144 + (16 * dt + 4 * vp) * 2;
                        const v4i16_t va = __builtin_amdgcn_ds_read_tr16_b64_v4i16((LAS v4i16_t*)pa), vb = __builtin_amdgcn_ds_read_tr16_b64_v4i16((LAS v4i16_t*)pb);
                        const bf16x8 vf = (bf16x8){va[0], va[1], va[2], va[3], vb[0], vb[1], vb[2], vb[3]};
                        o = __builtin_amdgcn_mfma_f32_16x16x32_bf16(vf, pf[kk], o, 0, 0, 0); }
                    o = o * inv; ssq += (o[0] * o[0] + o[1] * o[1]) + (o[2] * o[2] + o[3] * o[3]);
                    v2u w; w.x = pk2(o[0], o[1]); w.y = pk2(o[2], o[3]);
                    *(v2u*)(orow + h * 64 + 16 * dt) = w; }
            }
#undef KV_LOAD
#undef KV_WRITE
            ssq += __shfl_xor(ssq, 16); ssq += __shfl_xor(ssq, 32);
            if (g == 0) RA[t0 + 16 * wave + i16] = 1.0f / sqrtf(ssq * (1.0f / 512.0f) + RMS_EPS);
        }
        __syncthreads();
        {
            PHASE_IDS();
            const int cp = tid & 255, th = tid >> 8, c0 = 2 * cp;
            LAS float* tile = (LAS float*)lds;
            f32x2 wk[31];
#pragma unroll
            for (int j = 0; j < 31; ++j) wk[j] = *(const f32x2*)(w_dw + j * 512 + c0);
            const f32x2 bdw = *(const f32x2*)(b_dw + c0);
            const int s0 = n * 128 + 64 * th;
            const bf16* pbase = PROJ + (size_t)(b * SEQ) * PJW + COL_U + c0;
            f32x2 uu[38];
            unsigned ra_[8];
#define GLU_CVT(aw, dst) do { dst.x = bf_lo(aw); dst.y = bf_hi(aw); } while (0)
#pragma unroll
            for (int i = 0; i < 30; ++i) { const int pos = s0 - 30 + i; unsigned aw = 0u;
                if (pos >= 0) aw = *(const unsigned*)(pbase + (size_t)pos * PJW);
                GLU_CVT(aw, uu[i]); }
#pragma unroll
            for (int tt = 0; tt < 8; ++tt) { const int pos = s0 + tt; ra_[tt] = *(const unsigned*)(pbase + (size_t)pos * PJW); }
            LAS float* prm = tile + 16 * 512;
            prm[tid] = ln_g[tid]; prm[512 + tid] = ln_b[tid];
            for (int chunk = 0; chunk < 8; ++chunk) {
#pragma unroll
                for (int tt = 0; tt < 8; ++tt) GLU_CVT(ra_[tt], uu[30 + tt]);
                if (chunk < 7) {
#pragma unroll
                    for (int tt = 0; tt < 8; ++tt) { const int pos = s0 + 8 * (chunk + 1) + tt; ra_[tt] = *(const unsigned*)(pbase + (size_t)pos * PJW); }
                }
#pragma unroll
                for (int tt = 0; tt < 8; ++tt) { f32x2 a = bdw;
#pragma unroll
                    for (int j = 0; j < 31; ++j) a = a + wk[j] * uu[tt + j];
                    *(LAS f32x2*)(tile + (th * 8 + tt) * 512 + c0) = a; }
#pragma unroll
                for (int i = 0; i < 30; ++i) uu[i] = uu[i + 8];
                LDS_WAIT(); __builtin_amdgcn_s_barrier(); asm volatile("" ::: "memory");
#pragma unroll
                for (int q = 0; q < 2; ++q) { const int row = 2 * wave + q, rth = row >> 3, rtt = row & 7; const int tok = t0 + 64 * rth + 8 * chunk + rtt;
                    const f32x4 a0 = *(const LAS f32x4*)(tile + row * 512 + 8 * lane), a1 = *(const LAS f32x4*)(tile + row * 512 + 8 * lane + 4);
                    float v[8] = {a0[0], a0[1], a0[2], a0[3], a1[0], a1[1], a1[2], a1[3]};
                    float s = 0.f;
#pragma unroll
                    for (int j = 0; j < 8; ++j) s += v[j];
                    const float mean = wave_sum_dpp(s) * (1.0f / 512.0f);
                    float s2 = 0.f;
#pragma unroll
                    for (int j = 0; j < 8; ++j) { v[j] -= mean; s2 += v[j] * v[j]; }
                    const float rstd = 1.0f / sqrtf(wave_sum_dpp(s2) * (1.0f / 512.0f) + LN_EPS);
                    const f32x4 lg0 = *(const LAS f32x4*)(prm + 8 * lane), lg1 = *(const LAS f32x4*)(prm + 8 * lane + 4), lb0 = *(const LAS f32x4*)(prm + 512 + 8 * lane), lb1 = *(const LAS f32x4*)(prm + 512 + 8 * lane + 4);
                    const float lgv[8] = {lg0[0], lg0[1], lg0[2], lg0[3], lg1[0], lg1[1], lg1[2], lg1[3]}, lbv[8] = {lb0[0], lb0[1], lb0[2], lb0[3], lb1[0], lb1[1], lb1[2], lb1[3]};
                    float s3 = 0.f;
#pragma unroll
                    for (int j = 0; j < 8; ++j) { const float y = v[j] * rstd * lgv[j] + lbv[j]; const float z = y * __builtin_amdgcn_rcpf(1.0f + __builtin_amdgcn_exp2f(-y * LOG2E)); v[j] = z; s3 += z * z; }
                    const float rc = 1.0f / sqrtf(wave_sum_dpp(s3) * (1.0f / 512.0f) + RMS_EPS);
                    v4u w; w.x = pk2(v[0] * rc, v[1] * rc); w.y = pk2(v[2] * rc, v[3] * rc); w.z = pk2(v[4] * rc, v[5] * rc); w.w = pk2(v[6] * rc, v[7] * rc);
                    *(v4u*)(MIX + (size_t)tok * D + 512 + 8 * lane) = w; }
                LDS_WAIT(); __builtin_amdgcn_s_barrier(); asm volatile("" ::: "memory");
            }
#undef GLU_CVT
        }
    }
    xcd_barrier(bar);

    {
        const int grp = ((int)blockIdx.x >> 3) % 3;
        EpiRes E{XN, X1B, b_out, RA};
        {
            DenseSched S{(const char*)Wout_t, T / 256, D / 256, G, (int)blockIdx.x, 2048, 0, grp};
            pg8::gemm_phase<EpiRes, DenseSched, false>(lds, lds + EPI_OFF, (const char*)MIX, 2048, S, E);
        }
        {
            PHASE_IDS();
            __syncthreads();
            LAS unsigned* scr = (LAS unsigned*)(lds + wave * 16384);
            const int gw = vcu * NWAVES + wave, NGW = G * NWAVES;
            constexpr int NIT = 8192;
            f32x4 va[16], vb[16];
            int it = gw;
            W8Item ia = w8_item(8191 - (it < NIT ? it : 0), w1, w2, W1_t, W2_t), ib = ia;
            if (it < NIT) w8_load(ia, va, lane);
            while (it < NIT) {
                const int itb = it + NGW;
                if (itb < NIT) { ib = w8_item(8191 - itb, w1, w2, W1_t, W2_t); w8_load(ib, vb, lane); }
                w8_store(ia, va, scr, lane);
                if (itb >= NIT) break;
                const int ita = itb + NGW;
                if (ita < NIT) { ia = w8_item(8191 - ita, w1, w2, W1_t, W2_t); w8_load(ia, va, lane); }
                w8_store(ib, vb, scr, lane);
                it = ita;
            }
            __syncthreads();
        }
        {
            DenseSched S{(const char*)Wout_t, T / 256, D / 256, G, (int)blockIdx.x, 2048, grp, 1 << 30};
            pg8::gemm_phase<EpiRes, DenseSched, false>(lds, lds + EPI_OFF, (const char*)MIX, 2048, S, E);
        }
    }
    xcd_barrier(bar);

    {
        PHASE_IDS();
        if (wave < 4) __builtin_amdgcn_global_load_lds((const unsigned*)((const char*)g_ffn + wave * 1024 + lane * 16), (LAS unsigned*)(lds + P4_G_OFF + wave * 1024), 16, 0, 0);
#pragma unroll
        for (int i = 0; i < 16; ++i) __builtin_amdgcn_global_load_lds((const unsigned*)((const char*)WrHi + (size_t)(wave * 16 + i) * 1024 + lane * 16), (LAS unsigned*)(lds + (wave * 16 + i) * 1024), 16, 0, 0);
        VM_WAIT(); __syncthreads();
    }
    for (int unit = blockIdx.x; unit < T / 128; unit += G) {
        PHASE_IDS();
        const int i16 = lane & 15, g = lane >> 4;
        if (tid < 32) t_lcnt[tid] = 0;
        __syncthreads();
        const int tok = unit * 128 + wave * 16 + i16;
        const bf16* xr = X1B + (size_t)tok * D + 8 * g;
        float ss = 0.f;
#pragma unroll 8
        for (int s = 0; s < 32; ++s) { const v4u a = *(const v4u*)(xr + 32 * s);
            const float a0 = bf_lo(a.x), a1 = bf_hi(a.x), a2 = bf_lo(a.y), a3 = bf_hi(a.y), a4 = bf_lo(a.z), a5 = bf_hi(a.z), a6 = bf_lo(a.w), a7 = bf_hi(a.w);
            ss += (a0 * a0 + a1 * a1) + (a2 * a2 + a3 * a3) + (a4 * a4 + a5 * a5) + (a6 * a6 + a7 * a7); }
        ss += __shfl_xor(ss, 16); ss += __shfl_xor(ss, 32);
        const float rstd = 1.0f / sqrtf(ss * (1.0f / D) + RMS_EPS);
        f32x4 acc0 = (f32x4){0.f, 0.f, 0.f, 0.f}, acc1 = acc0;
        {
        unsigned char* hrow = XN8 + (size_t)tok * D + 8 * g;
        const bf16* wh0 = WrHi + lane * 8; const bf16* wl0 = WrLo + lane * 8;
        for (int s8 = 0; s8 < 4; ++s8) {
            v4u xc[8];
#pragma unroll
            for (int q = 0; q < 8; ++q) xc[q] = *(const v4u*)(xr + 32 * (8 * s8 + q));
            __builtin_amdgcn_sched_barrier(0);
#pragma unroll
            for (int q = 0; q < 8; ++q) { const int s = 8 * s8 + q; const v4u xa = xc[q];
            const f32x4 a = (f32x4){bf_lo(xa.x), bf_hi(xa.x), bf_lo(xa.y), bf_hi(xa.y)} * rstd * *(const LAS f32x4*)((const LAS float*)(lds + P4_G_OFF) + 8 * g + 32 * s), b = (f32x4){bf_lo(xa.z), bf_hi(xa.z), bf_lo(xa.w), bf_hi(xa.w)} * rstd * *(const LAS f32x4*)((const LAS float*)(lds + P4_G_OFF) + 8 * g + 32 * s + 4);
            v4u hp; hp.x = pk2(a[0], a[1]); hp.y = pk2(a[2], a[3]); hp.z = pk2(b[0], b[1]); hp.w = pk2(b[2], b[3]);
            v4u lp; lp.x = pk2(a[0] - bf_lo(hp.x), a[1] - bf_hi(hp.x)); lp.y = pk2(a[2] - bf_lo(hp.y), a[3] - bf_hi(hp.y)); lp.z = pk2(b[0] - bf_lo(hp.z), b[1] - bf_hi(hp.z)); lp.w = pk2(b[2] - bf_lo(hp.w), b[3] - bf_hi(hp.w));
            const bf16x8 hh = __builtin_bit_cast(bf16x8, hp), hl = __builtin_bit_cast(bf16x8, lp);
            const LAS unsigned char* wf = lds + lane * 16; const bf16x8 whA = *(const LAS bf16x8*)(wf + (0 * 32 + s) * 1024), whB = *(const LAS bf16x8*)(wf + (1 * 32 + s) * 1024), wlA = *(const LAS bf16x8*)(wf + (2 * 32 + s) * 1024), wlB = *(const LAS bf16x8*)(wf + (3 * 32 + s) * 1024);
            acc0 = __builtin_amdgcn_mfma_f32_16x16x32_bf16(whA, hh, acc0, 0, 0, 0); acc0 = __builtin_amdgcn_mfma_f32_16x16x32_bf16(whA, hl, acc0, 0, 0, 0); acc0 = __builtin_amdgcn_mfma_f32_16x16x32_bf16(wlA, hh, acc0, 0, 0, 0);
            acc1 = __builtin_amdgcn_mfma_f32_16x16x32_bf16(whB, hh, acc1, 0, 0, 0); acc1 = __builtin_amdgcn_mfma_f32_16x16x32_bf16(whB, hl, acc1, 0, 0, 0); acc1 = __builtin_amdgcn_mfma_f32_16x16x32_bf16(wlB, hh, acc1, 0, 0, 0); }
        }
        }
        {
            unsigned char* hrow = XN8 + (size_t)tok * D + 8 * g;
            const float rs8 = rstd * H_SCALE;
            for (int s8 = 0; s8 < 4; ++s8) {
                v4u xc[8];
#pragma unroll
                for (int q = 0; q < 8; ++q) xc[q] = *(const v4u*)(xr + 32 * (8 * s8 + q));
                __builtin_amdgcn_sched_barrier(0);
#pragma unroll
                for (int q = 0; q < 8; ++q) { const int s = 8 * s8 + q; const v4u xa = xc[q];
                    const f32x4 a = (f32x4){bf_lo(xa.x), bf_hi(xa.x), bf_lo(xa.y), bf_hi(xa.y)} * rs8 * *(const LAS f32x4*)((const LAS float*)(lds + P4_G_OFF) + 8 * g + 32 * s), b = (f32x4){bf_lo(xa.z), bf_hi(xa.z), bf_lo(xa.w), bf_hi(xa.w)} * rs8 * *(const LAS f32x4*)((const LAS float*)(lds + P4_G_OFF) + 8 * g + 32 * s + 4);
                    v2u h8; h8.x = pk4_fp8(a[0], a[1], a[2], a[3]); h8.y = pk4_fp8(b[0], b[1], b[2], b[3]); *(v2u*)(hrow + 32 * s) = h8; }
            }
        }
        LAS float* sc = (LAS float*)(lds + EPI_OFF + wave * 2112);
#pragma unroll
        for (int r = 0; r < 4; ++r) { sc[i16 * 33 + 4 * g + r] = acc0[r] + b_router[4 * g + r]; sc[i16 * 33 + 16 + 4 * g + r] = acc1[r] + b_router[16 + 4 * g + r]; }
        LDS_WAIT(); asm volatile("" ::: "memory");
        int idx[4], rank[4]; float gate[4];
        if (lane < 16) {
            float v[32];
#pragma unroll
            for (int e = 0; e < 32; ++e) v[e] = sc[lane * 33 + e];
            float val[4];
#pragma unroll
            for (int k = 0; k < 4; ++k) { float best = -INFINITY; int bi = 0;
#pragma unroll
                for (int e = 0; e < 32; ++e) if (v[e] > best) { best = v[e]; bi = e; }
                val[k] = best; idx[k] = bi;
#pragma unroll
                for (int e = 0; e < 32; ++e) v[e] = (e == bi) ? -INFINITY : v[e]; }
            float den = 0.f;
#pragma unroll
            for (int k = 0; k < 4; ++k) { gate[k] = __expf(val[k] - val[0]); den += gate[k]; }
            const float rden = 1.0f / den;
#pragma unroll
            for (int k = 0; k < 4; ++k) { gate[k] *= rden; rank[k] = atomicAdd((int*)(t_lcnt + idx[k]), 1); }
        }
        __syncthreads();
        if (tid < 32) { const int c = t_lcnt[tid]; t_gbase[tid] = c ? (int)__hip_atomic_fetch_add(gcnt + 16 * tid, (unsigned)c, __ATOMIC_RELAXED, __HIP_MEMORY_SCOPE_AGENT) : 0; }
        __syncthreads();
        if (lane < 16) {
            const int tk = unit * 128 + wave * 16 + lane;
#pragma unroll
            for (int k = 0; k < 4; ++k) { const int pos = t_gbase[idx[k]] + rank[k]; ltok[idx[k] * LIST_CAP + pos] = tk * 4 + k; lgate[idx[k] * LIST_CAP + pos] = gate[k]; }
        }
        __syncthreads();
    }
    xcd_barrier(bar);

    if (threadIdx.x < 32) t_cnt[threadIdx.x] = (int)__hip_atomic_load(gcnt + 16 * threadIdx.x, __ATOMIC_RELAXED, __HIP_MEMORY_SCOPE_AGENT);
    __syncthreads();
    if (threadIdx.x == 0) { int s = 0; for (int e = 0; e < 32; ++e) { t_rbs[e] = s; s += (t_cnt[e] + 255) >> 8; } t_rbs[32] = s; }
    __syncthreads();
    const int NB = __builtin_amdgcn_readfirstlane(t_rbs[32]);

    {
        MoeSched<true> S{(const char*)W1_t, (size_t)2048 * 1024, ltok, t_rbs, t_cnt, NB, 8, G, (int)blockIdx.x, 1024};
        EpiSwiglu E{ACT, b1p};
        pg8::gemm_phase<EpiSwiglu, MoeSched<true>, true>(lds, lds + EPI_OFF, (const char*)XN8, 1024, S, E);
    }
    xcd_barrier(bar);

    {
        MoeSched<false> S{(const char*)W2_t, (size_t)1024 * 1024, ltok, t_rbs, t_cnt, NB, 4, G, (int)blockIdx.x, 1024};
        EpiMoeOut E{YB, b2, ltok, lgate};
        pg8::gemm_phase<EpiMoeOut, MoeSched<false>, true, false>(lds, lds + EPI_OFF, (const char*)ACT, 1024, S, E);
    }
    xcd_barrier(bar);

    {
        PHASE_IDS();
        const int gw = vcu * NWAVES + wave, NGW = G * NWAVES;
        f32x4 gfin[4];
#pragma unroll
        for (int j = 0; j < 4; ++j) gfin[j] = *((const f32x4*)g_final + lane + 64 * j);
        for (int m0 = 2 * gw; m0 < T; m0 += 2 * NGW) {
            v2u xw_[2][4]; unsigned yw[2][4][4];
#pragma unroll
            for (int q = 0; q < 2; ++q) { const GAS v2u* xr = (const GAS v2u*)(X1B + (size_t)(m0 + q) * D) + lane;
#pragma unroll
                for (int j = 0; j < 4; ++j) xw_[q][j] = __builtin_nontemporal_load(xr + 64 * j);
#pragma unroll
                for (int k = 0; k < 4; ++k) { const GAS unsigned* yr = (const GAS unsigned*)(YB + ((size_t)(m0 + q) * 4 + k) * D) + lane;
#pragma unroll
                    for (int j = 0; j < 4; ++j) yw[q][k][j] = __builtin_nontemporal_load(yr + 64 * j); } }
#pragma unroll
            for (int q = 0; q < 2; ++q) {
                f32x4 v[4];
#pragma unroll
                for (int j = 0; j < 4; ++j) v[j] = (f32x4){bf_lo(xw_[q][j].x), bf_hi(xw_[q][j].x), bf_lo(xw_[q][j].y), bf_hi(xw_[q][j].y)};
#pragma unroll
                for (int k = 0; k < 4; ++k)
#pragma unroll
                    for (int j = 0; j < 4; ++j) { const f32x2 lo = __builtin_amdgcn_cvt_pk_f32_fp8((int)yw[q][k][j], false), hi = __builtin_amdgcn_cvt_pk_f32_fp8((int)yw[q][k][j], true);
                        v[j].x += lo.x * (1.0f / Y_SCALE); v[j].y += lo.y * (1.0f / Y_SCALE); v[j].z += hi.x * (1.0f / Y_SCALE); v[j].w += hi.y * (1.0f / Y_SCALE); }
                float s = 0.f;
#pragma unroll
                for (int j = 0; j < 4; ++j) s += (v[j].x * v[j].x + v[j].y * v[j].y) + (v[j].z * v[j].z + v[j].w * v[j].w);
                const float rstd = 1.0f / sqrtf(wave_sum_dpp(s) * (1.0f / D) + RMS_EPS);
                GAS f32x4* xw = (GAS f32x4*)(out + (size_t)(m0 + q) * D) + lane;
#pragma unroll
                for (int j = 0; j < 4; ++j) __builtin_nontemporal_store(v[j] * rstd * gfin[j], xw + 64 * j);
            }
        }
    }
}

extern "C" void kernel_launch(void* const* d_in, const int* in_sizes, int n_in, void* d_out, int out_size, void* d_ws, size_t ws_size, hipStream_t stream) {
    static int grid = 0;
    if (grid == 0) {
        if (n_in != 21 || in_sizes[0] != T * D || out_size != T * D || ws_size < WS_END) { fprintf(stderr, "kernel_launch: unexpected shapes (n_in %d, in0 %d, out %d, ws %zu)\n", n_in, n_in > 0 ? in_sizes[0] : -1, out_size, ws_size); grid = -1; return; }
        int dev = 0, cus = 0, per_cu = 0;
        if (hipGetDevice(&dev) != hipSuccess || hipDeviceGetAttribute(&cus, hipDeviceAttributeMultiprocessorCount, dev) != hipSuccess) { grid = -1; return; }
        if (hipFuncSetAttribute((const void*)hymba_fwd, hipFuncAttributeMaxDynamicSharedMemorySize, LDS_BYTES) != hipSuccess) { fprintf(stderr, "kernel_launch: hipFuncSetAttribute failed\n"); grid = -1; return; }
        if (hipOccupancyMaxActiveBlocksPerMultiprocessor(&per_cu, (const void*)hymba_fwd, NWAVES * 64, LDS_BYTES) != hipSuccess || per_cu < 1)
            fprintf(stderr, "kernel_launch: occupancy query reports %d workgroups per CU\n", per_cu);
        (void)hipGetLastError();
        grid = cus;
    }
    if (grid < 0) return;
    if (hipMemsetAsync((char*)d_ws + WS_CTL, 0, CTL_ZERO_BYTES, stream) != hipSuccess) return;
    Args a{};
    for (int i = 0; i < 21; ++i) a.in[i] = (const float*)d_in[i];
    a.out = (float*)d_out; a.ws = (unsigned char*)d_ws;
    hipLaunchKernelGGL(hymba_fwd, dim3(grid), dim3(NWAVES * 64), LDS_BYTES, stream, a);
}
```

```cpp
#include <hip/hip_runtime.h>
#include <cstdio>
#include <cstdint>

namespace pg8 {
#define PG8_LAS __attribute__((address_space(3)))
typedef unsigned short bf16_t;
typedef short bf16x8 __attribute__((ext_vector_type(8)));
typedef float f32x4 __attribute__((ext_vector_type(4)));
typedef unsigned u32x4 __attribute__((ext_vector_type(4)));
constexpr int BM = 256, BK = 64, HALF = 128, HTB = HALF * BK * 2, STAGE_BYTES = 8 * HTB, NXCD = 8, WGM = 8;

__host__ __device__ __forceinline__ int lds_byte(int r, int c) { const int st = (r >> 4) * 2 + (c >> 5), rr = r & 15, cc = c & 31, ob = rr * 64 + cc * 2; return st * 1024 + (ob ^ (((ob >> 9) & 1) << 5)); }
__host__ __device__ __forceinline__ void stage_rc(int b, int& R, int& C) { const int st = b / 1024, sb = b % 1024, swz = sb ^ (((sb >> 9) & 1) << 5); R = (st >> 1) * 16 + swz / 64; C = (st & 1) * 32 + (swz % 64) / 2; }
__host__ __device__ __forceinline__ int perm32(int rho) { const int n = rho >> 4, i = rho & 15; return 8 * (i >> 2) + 4 * n + (i & 3); }

struct Unit { int pm, pn, e, rb, cnt; };

__device__ __forceinline__ bool static_order(int i, int G, int c, int nM, int nN, int& pm, int& pn) {
    const int nwg = nM * nN; const long L = (long)i * G + c; if (L >= nwg) return false;
    int wgid = (int)L; { const int q = nwg / NXCD, r = nwg % NXCD, xcd = wgid % NXCD, off = wgid / NXCD; wgid = (xcd < r ? xcd * (q + 1) : r * (q + 1) + (xcd - r) * q) + off; }
    const int nig = WGM * nN, gid = wgid / nig, fm = gid * WGM, gsz = (nM - fm) < WGM ? (nM - fm) : WGM;
    pm = fm + ((wgid % nig) % gsz); pn = (wgid % nig) / gsz; return true;
}

__device__ __forceinline__ unsigned cvt_pk_bf16(float lo, float hi) { unsigned r; asm volatile("v_cvt_pk_bf16_f32 %0, %1, %2" : "=v"(r) : "v"(lo), "v"(hi)); return r; }

typedef int i32x8 __attribute__((ext_vector_type(8)));
typedef int i32x4v __attribute__((ext_vector_type(4)));
template <class Epi, class Sched, bool FP8, bool ALIGN = true>
__device__ __forceinline__ void gemm_phase(PG8_LAS unsigned char* lds, PG8_LAS unsigned char* epi, const char* Abase, const int rp, const Sched& S, const Epi& E) {
    int tid = threadIdx.x; asm volatile("" : "+v"(tid));
    const int wid = __builtin_amdgcn_readfirstlane(tid >> 6), lane = tid & 63, wr = wid >> 2, wc = wid & 3, fr = lane & 15, fq = lane >> 4;
    const int nt = rp / 128;
    int RA[2]; unsigned CA2[2], voffB[2];
#pragma unroll
    for (int i = 0; i < 2; ++i) { int R, C; stage_rc(tid * 16 + i * 8192, R, C); const int Rb = Epi::PERM ? ((R & ~31) + perm32(R & 31)) : R;
        RA[i] = R; CA2[i] = (unsigned)C * 2u; voffB[i] = (unsigned)(Rb * rp + C * 2); }
    const size_t kstep = (size_t)(BK * 2);
    const size_t hstepB = (size_t)HALF * rp;
    const unsigned ldsw = (unsigned)wid * 1024u;
    const int aoff = lds_byte(wr * 64 + fr, fq * 8), boff = lds_byte(wc * 32 + fr, fq * 8);
#define PG8_SA(b, h) (((b) * 2 + (h)) * HTB)
#define PG8_SB(b, h) ((4 + (b) * 2 + (h)) * HTB)
#define PG8_STAGE(bufoff, gbase, voff) do { _Pragma("unroll") for (int _i = 0; _i < 2; ++_i) { unsigned _vo = (voff)[_i]; asm volatile("" : "+v"(_vo));   \
        __builtin_amdgcn_global_load_lds((const unsigned*)((const char*)(gbase) + _vo), (PG8_LAS unsigned*)(lds + (bufoff) + ldsw + _i * 8192), 16, 0, 0); } } while (0)
#define PG8_LDA(dst, b, h) do { _Pragma("unroll") for (int m = 0; m < 4; ++m) _Pragma("unroll") for (int k = 0; k < 2; ++k) dst[m][k] = *(const PG8_LAS bf16x8*)(lds + PG8_SA(b, h) + aoff + m * 2048 + k * 1024); } while (0)
#define PG8_LDB(dst, b, h) do { _Pragma("unroll") for (int n = 0; n < 2; ++n) _Pragma("unroll") for (int k = 0; k < 2; ++k) dst[n][k] = *(const PG8_LAS bf16x8*)(lds + PG8_SB(b, h) + boff + n * 2048 + k * 1024); } while (0)
#define PG8_CAT8(x) __builtin_shufflevector(__builtin_bit_cast(i32x4v, x[0]), __builtin_bit_cast(i32x4v, x[1]), 0, 1, 2, 3, 4, 5, 6, 7)
#define PG8_MMA_(ai, bj, At, Bt, Z) do { __builtin_amdgcn_s_setprio(1); \
        if constexpr (FP8) { _Pragma("unroll") for (int m = 0; m < 4; ++m) _Pragma("unroll") for (int n = 0; n < 2; ++n) \
            { const i32x8 _b = PG8_CAT8(Bt[n]), _a = PG8_CAT8(At[m]);   \
              if (Z) asm volatile("v_mfma_f32_16x16x128_f8f6f4 %0, %1, %2, 0" : "=&v"(acc[ai][bj][m][n]) : "v"(_b), "v"(_a)); \
              else asm volatile("v_mfma_f32_16x16x128_f8f6f4 %0, %1, %2, %0" : "+v"(acc[ai][bj][m][n]) : "v"(_b), "v"(_a)); } } \
        else { _Pragma("unroll") for (int m = 0; m < 4; ++m) _Pragma("unroll") for (int n = 0; n < 2; ++n) _Pragma("unroll") for (int k = 0; k < 2; ++k) \
            acc[ai][bj][m][n] = __builtin_amdgcn_mfma_f32_16x16x32_bf16(Bt[n][k], At[m][k], acc[ai][bj][m][n], 0, 0, 0); } \
        __builtin_amdgcn_s_setprio(0); } while (0)
#define PG8_MMA(ai, bj, At, Bt) PG8_MMA_(ai, bj, At, Bt, false)
#define PG8_MMA0(ai, bj, At, Bt) do { if (FP8 && first) PG8_MMA_(ai, bj, At, Bt, true); else PG8_MMA_(ai, bj, At, Bt, false); } while (0)
#define PG8_WAIT_V(n) asm volatile("s_waitcnt vmcnt(" #n ")" ::: "memory")
#define PG8_WAIT_L(n) asm volatile("s_waitcnt lgkmcnt(" #n ")" ::: "memory")
#define PG8_BAR __builtin_amdgcn_s_barrier()
#define PG8_SCHED __builtin_amdgcn_sched_barrier(0)
#define PG8_ZERO() do { if constexpr (!FP8) { _Pragma("unroll") for (int a = 0; a < 2; ++a) _Pragma("unroll") for (int b = 0; b < 2; ++b) _Pragma("unroll") for (int m = 0; m < 4; ++m) _Pragma("unroll") for (int n = 0; n < 2; ++n) acc[a][b][m][n] = (f32x4){0.f, 0.f, 0.f, 0.f}; } } while (0)
#define PG8_VA(dst, u) do { _Pragma("unroll") for (int _h = 0; _h < 2; ++_h) _Pragma("unroll") for (int _i = 0; _i < 2; ++_i) dst[_h][_i] = S.a_off(u, _h * HALF + RA[_i]) + CA2[_i]; } while (0)
    Unit cur, nxt; int ui = 0;
    if (!S.next(0, cur)) return;
    f32x4 acc[2][2][4][2];
    PG8_ZERO();
    bf16x8 At[4][2], B0[2][2], B1[2][2];
    unsigned cvA[2][2], nvA[2][2];
    float rs[2][4];
    PG8_VA(cvA, cur);
    const char* cB = S.b_tile(cur);
    const char* cA = Abase + S.a_base(cur);
    E.side(cur, epi, wid, lane);
    PG8_STAGE(PG8_SB(0, 0), cB, voffB); PG8_STAGE(PG8_SB(0, 1), cB + hstepB, voffB); PG8_STAGE(PG8_SA(0, 0), cA, cvA[0]); PG8_STAGE(PG8_SA(0, 1), cA, cvA[1]);
    if (wr == 1) PG8_BAR;
    PG8_WAIT_V(2); PG8_BAR;
    PG8_STAGE(PG8_SB(1, 0), cB + kstep, voffB); PG8_STAGE(PG8_SA(1, 0), cA + kstep, cvA[0]); PG8_STAGE(PG8_SB(1, 1), cB + hstepB + kstep, voffB);
    PG8_WAIT_V(6); PG8_BAR;
    for (;;) {
        const bool has_next = S.next(ui + 1, nxt);
        if constexpr (Sched::GATHER) { if (has_next) S.gather_dma(nxt, epi + ((ui + 1) & 1) * 4096 + 3072, wid, lane); }
        const char* nB = has_next ? S.b_tile(nxt) : cB;
        const char* nA = has_next ? Abase + S.a_base(nxt) : cA;
        PG8_LAS unsigned char* area = epi + (ui & 1) * 4096;
        for (int t = 0; t < nt; t += 2) {
            const bool last = (t == nt - 2), first = (t == 0);
            if constexpr (Epi::MIDSCALE) { if (t == nt / 2) {
#pragma unroll
                for (int a = 0; a < 2; ++a)
#pragma unroll
                    for (int m = 0; m < 4; ++m) rs[a][m] = *(const PG8_LAS float*)(area + 1024 + 4 * (a * 128 + wr * 64 + m * 16 + fr));
#pragma unroll
                for (int a = 0; a < 2; ++a)
#pragma unroll
                    for (int b = 0; b < 2; ++b)
#pragma unroll
                        for (int m = 0; m < 4; ++m)
#pragma unroll
                            for (int n = 0; n < 2; ++n) acc[a][b][m][n] = acc[a][b][m][n] * rs[a][m]; } }
            const char* a1 = cA + (size_t)(t + 1) * kstep;
            const char* a2 = last ? nA : cA + (size_t)(t + 2) * kstep; const char* b2 = last ? nB : cB + (size_t)(t + 2) * kstep;
            const char* a3 = a2 + kstep; const char* b3 = b2 + kstep;
            if constexpr (Sched::GATHER) { if (last) {
#pragma unroll
                for (int h = 0; h < 2; ++h)
#pragma unroll
                    for (int i = 0; i < 2; ++i) nvA[h][i] = has_next ? S.a_fin(nxt, h * HALF + RA[i], *(const PG8_LAS int*)(epi + ((ui + 1) & 1) * 4096 + 3072 + 4 * (h * HALF + RA[i]))) + CA2[i] : cvA[h][i]; } }
            unsigned sA[2][2];
#pragma unroll
            for (int h = 0; h < 2; ++h)
#pragma unroll
                for (int i = 0; i < 2; ++i) sA[h][i] = (Sched::GATHER && last) ? nvA[h][i] : cvA[h][i];
            PG8_LDB(B0, 0, 0); PG8_LDB(B1, 0, 1); PG8_SCHED; PG8_LDA(At, 0, 0); PG8_STAGE(PG8_SA(1, 1), a1, cvA[1]);
            PG8_WAIT_V(8); PG8_WAIT_L(0); PG8_BAR; PG8_MMA0(0, 0, At, B0); PG8_MMA0(0, 1, At, B1); PG8_BAR; PG8_SCHED;
            PG8_LDA(At, 0, 1); PG8_STAGE(PG8_SB(0, 0), b2, voffB); PG8_STAGE(PG8_SB(0, 1), b2 + hstepB, voffB); PG8_STAGE(PG8_SA(0, 0), a2, sA[0]);
            PG8_WAIT_V(8); PG8_WAIT_L(0); PG8_BAR; PG8_MMA0(1, 0, At, B0); PG8_MMA0(1, 1, At, B1); PG8_BAR; PG8_SCHED;
            PG8_LDB(B0, 1, 0); PG8_LDB(B1, 1, 1); PG8_SCHED; PG8_LDA(At, 1, 0); PG8_STAGE(PG8_SA(0, 1), a2, sA[1]);
            PG8_WAIT_V(8); PG8_WAIT_L(0); PG8_BAR; PG8_MMA(0, 0, At, B0); PG8_MMA(0, 1, At, B1); PG8_BAR; PG8_SCHED;
            PG8_LDA(At, 1, 1); PG8_STAGE(PG8_SB(1, 0), b3, voffB); PG8_STAGE(PG8_SB(1, 1), b3 + hstepB, voffB); PG8_STAGE(PG8_SA(1, 0), a3, sA[0]);
            PG8_WAIT_V(8); PG8_WAIT_L(0); PG8_BAR; PG8_MMA(1, 0, At, B0); PG8_MMA(1, 1, At, B1); PG8_BAR; PG8_SCHED;
        }
        if constexpr (ALIGN) { if (wr == 0) PG8_BAR; }
        if constexpr (FP8) asm volatile("s_nop 15\n\ts_nop 15" ::: "memory");
        E(acc, cur, wr, wc, fr, fq, area);
        if (!has_next) break;
        PG8_ZERO();
        cur = nxt; cB = nB; cA = nA; ++ui;
        E.side(cur, epi + (ui & 1) * 4096, wid, lane);
        if constexpr (Sched::GATHER) {
#pragma unroll
            for (int h = 0; h < 2; ++h)
#pragma unroll
                for (int i = 0; i < 2; ++i) cvA[h][i] = nvA[h][i]; }
        if constexpr (ALIGN) { if (wr == 1) PG8_BAR; }
    }
    PG8_WAIT_V(0);
    if constexpr (!ALIGN) { if (wr == 0) PG8_BAR; }
    PG8_BAR;
#undef PG8_SA
#undef PG8_SB
#undef PG8_STAGE
#undef PG8_LDA
#undef PG8_LDB
#undef PG8_MMA
#undef PG8_MMA_
#undef PG8_MMA0
#undef PG8_CAT8
#undef PG8_WAIT_V
#undef PG8_WAIT_L
#undef PG8_BAR
#undef PG8_SCHED
#undef PG8_ZERO
#undef PG8_VA
}
}

constexpr int NWAVES = 8;
constexpr int T = 32768, SEQ = 2048, D = 1024, INW = 1792, NEXP = 32, TOPK = 4;
constexpr int COL_K = 512, COL_V = 640, COL_U = 768;
constexpr int PJW = 1280;
constexpr float RMS_EPS = 1e-5f, LN_EPS = 1e-5f;
constexpr float LOG2E = 1.4426950408889634f;
constexpr float QSCALE = 0.125f * LOG2E;
constexpr int LIST_CAP = 32768;
constexpr int MAX_RB = 544;

constexpr size_t MiB = 1u << 20;
constexpr size_t WS_CTL = 0, CTL_ZERO_BYTES = 16 * 1024;
constexpr size_t WS_WIN = 2 * MiB;
constexpr size_t WS_WOUT = 6 * MiB;
constexpr size_t WS_W1 = 8 * MiB;
constexpr size_t WS_W2 = 136 * MiB;
constexpr size_t WS_XN = 200 * MiB;
constexpr size_t WS_LTOK = 264 * MiB;
constexpr size_t WS_LGATE = 268 * MiB;
constexpr size_t WS_B1P = 272 * MiB;
constexpr size_t WS_RA = 272 * MiB + 512 * 1024;
constexpr size_t WS_WR = 273 * MiB;
constexpr size_t WS_ACT = 274 * MiB;
constexpr size_t WS_PROJ = 546 * MiB;
constexpr size_t WS_MIX = 658 * MiB;
constexpr size_t WS_Y = 546 * MiB;
constexpr size_t WS_XN8 = 674 * MiB;
constexpr size_t WS_END = 802 * MiB;
static_assert(WS_ACT + (size_t)MAX_RB * 256 * 1024 * 2 <= WS_PROJ && WS_MIX + (size_t)T * 1024 * 2 <= WS_END && WS_Y + (size_t)T * 4 * 1024 * 2 <= WS_END, "ws map");
constexpr int CW_BAR = 0;
constexpr int CW_GCNT = 3584;
static_assert((CW_BAR + 3456) * 4 <= (int)CTL_ZERO_BYTES && (CW_GCNT + 32 * 16) * 4 <= (int)CTL_ZERO_BYTES, "control words inside the per-call memset");

constexpr int RING_BYTES = 131072;
constexpr int MISC_OFF = RING_BYTES;
constexpr int TAB_OFF = MISC_OFF + 256;
constexpr int EPI_OFF = RING_BYTES + 2048;
constexpr int P4_G_OFF = EPI_OFF + 8 * 2112;
constexpr int LDS_BYTES = 154624;

#define GAS __attribute__((address_space(1)))
#define LAS __attribute__((address_space(3)))
typedef unsigned short bf16;
typedef unsigned v4u __attribute__((ext_vector_type(4)));
typedef unsigned v2u __attribute__((ext_vector_type(2)));
typedef float f32x4 __attribute__((ext_vector_type(4)));
typedef float f32x2 __attribute__((ext_vector_type(2)));
typedef short bf16x8 __attribute__((ext_vector_type(8)));
typedef short v4i16_t __attribute__((ext_vector_type(4)));
#define LDS_WAIT() asm volatile("s_waitcnt lgkmcnt(0)" ::: "memory")
#define VM_WAIT() asm volatile("s_waitcnt vmcnt(0)" ::: "memory")
__device__ __forceinline__ unsigned pk2(float lo, float hi) { return pg8::cvt_pk_bf16(lo, hi); }
__device__ __forceinline__ unsigned pk4_fp8(float a, float b, float c, float d) { int w = 0; w = __builtin_amdgcn_cvt_pk_fp8_f32(a, b, w, false); w = __builtin_amdgcn_cvt_pk_fp8_f32(c, d, w, true); return (unsigned)w; }
constexpr float W_SCALE = 64.0f, H_SCALE = 8.0f, ACT_SCALE = 4.0f, Y_SCALE = 16.0f;
__device__ __forceinline__ float bf_lo(unsigned w) { return __uint_as_float(w << 16); }
__device__ __forceinline__ float bf_hi(unsigned w) { return __uint_as_float(w & 0xffff0000u); }

#define XB_TMO      128
#define XB_XCNT(j)  (256  + 64 * (j))
#define XB_XSUB(j)  (1280 + 64 * (j))
#define XB_XGEN(j)  (2304 + 64 * (j))
#define XB_TOP      3328
#define XB_TOPGEN   3392
#define XCD_BAR_WORDS 3456
#define XB_SPIN_CAP (1u << 18)

__device__ __forceinline__ unsigned xb_ld(unsigned* p)              { return __hip_atomic_load(p, __ATOMIC_RELAXED, __HIP_MEMORY_SCOPE_AGENT); }
__device__ __forceinline__ unsigned xb_add(unsigned* p, unsigned v) { return __hip_atomic_fetch_add(p, v, __ATOMIC_RELAXED, __HIP_MEMORY_SCOPE_AGENT); }
__device__ __forceinline__ unsigned xb_xcc_id() { return (unsigned)__builtin_amdgcn_s_getreg((3 << 11) | 20) & 0xFu; }
#define XB_SPIN(cond, bar) do { unsigned _sp = 0; while (cond) { __builtin_amdgcn_s_sleep(1); \
    if ((++_sp & 255u) == 0u) { if (xb_ld(&(bar)[XB_TMO])) break; if (_sp > XB_SPIN_CAP) { atomicAdd(&(bar)[XB_TMO], 1u); break; } } } } while (0)

struct XcdBarrier { unsigned* bar; unsigned x; volatile LAS unsigned* st; };

__device__ __forceinline__ XcdBarrier xcd_barrier_post(unsigned* bar, volatile LAS unsigned* st) {
    XcdBarrier b; b.bar = bar; b.x = xb_xcc_id(); b.st = st;
    if (threadIdx.x == 0) (void)xb_add(&bar[XB_XCNT(b.x)], 1u);
    return b;
}
__device__ __forceinline__ void xcd_barrier_complete(unsigned* bar, unsigned x, unsigned& nloc, unsigned& nx) {
    const unsigned G = gridDim.x * gridDim.y * gridDim.z;
    unsigned sum, cnt, mine, sp = 0u;
    for (;;) {
        sum = 0u; cnt = 0u; mine = 0u;
#pragma unroll
        for (unsigned j = 0; j < 16; ++j) { const unsigned c = xb_ld(&bar[XB_XCNT(j)]); sum += c; cnt += (c > 0u) ? 1u : 0u; mine = (j == x) ? c : mine; }
        if (sum == G) break;
        __builtin_amdgcn_s_sleep(1);
        if ((++sp & 255u) == 0u) { if (xb_ld(&bar[XB_TMO])) break; if (sp > XB_SPIN_CAP) { atomicAdd(&bar[XB_TMO], 1u); break; } }
    }
    nloc = mine > 0u ? mine : 1u; nx = cnt > 0u ? cnt : 1u;
}
__device__ __forceinline__ void xcd_barrier(const XcdBarrier& b) {
    asm volatile("s_waitcnt vmcnt(0)" ::: "memory");
    __syncthreads();
    if (threadIdx.x == 0) {
        unsigned* bar = b.bar;
        __builtin_amdgcn_s_waitcnt(0);
        unsigned nloc = b.st[0], nx = b.st[1];
        if (nloc == 0u) { xcd_barrier_complete(bar, b.x, nloc, nx); b.st[0] = nloc; b.st[1] = nx; }
        const unsigned old = xb_add(&bar[XB_XSUB(b.x)], 1u);
        const unsigned gen = old / nloc;
        if (old + 1u == (gen + 1u) * nloc) {
            __builtin_amdgcn_fence(__ATOMIC_RELEASE, "agent");
            asm volatile("s_waitcnt vmcnt(0)" ::: "memory");
            const unsigned og = xb_add(&bar[XB_TOP], 1u);
            const unsigned tg = og / nx;
            if (og + 1u == (tg + 1u) * nx) xb_add(&bar[XB_TOPGEN], 1u);
            else XB_SPIN(xb_ld(&bar[XB_TOPGEN]) == tg, bar);
            __builtin_amdgcn_fence(__ATOMIC_ACQUIRE, "agent");
            xb_add(&bar[XB_XGEN(b.x)], 1u);
            asm volatile("s_waitcnt vmcnt(0)" ::: "memory");
        } else {
            XB_SPIN(xb_ld(&bar[XB_XGEN(b.x)]) == gen, bar);
            __builtin_amdgcn_fence(__ATOMIC_ACQUIRE, "agent");
            asm volatile("s_waitcnt vmcnt(0)" ::: "memory");
        }
    }
    __syncthreads();
}

template <int CTRL, int RMASK> __device__ __forceinline__ float dpp_add(float v) { return v + __builtin_bit_cast(float, __builtin_amdgcn_update_dpp(0, __builtin_bit_cast(int, v), CTRL, RMASK, 0xf, false)); }
__device__ __forceinline__ float wave_sum_dpp(float v) {
    v = dpp_add<0xB1, 0xf>(v); v = dpp_add<0x4E, 0xf>(v); v = dpp_add<0x141, 0xf>(v); v = dpp_add<0x140, 0xf>(v);
    v = dpp_add<0x142, 0xa>(v); v = dpp_add<0x143, 0xc>(v);
    return __builtin_bit_cast(float, __builtin_amdgcn_readlane(__builtin_bit_cast(int, v), 63));
}
__device__ __forceinline__ float wave_sum(float v) {
#pragma unroll
    for (int o = 1; o < 64; o <<= 1) v += __shfl_xor(v, o);
    return v;
}

struct DenseSched {
    static constexpr bool GATHER = false;
    const char* Bt; int nM, nN, G, c, rp, ibeg, iend;
    __device__ __forceinline__ size_t a_base(const pg8::Unit& u) const { return (size_t)u.pm * 256 * (size_t)rp; }
    __device__ __forceinline__ bool next(int i, pg8::Unit& u) const { u.e = 0; u.rb = 0; u.cnt = 0; if (i + ibeg >= iend) return false; return pg8::static_order(i + ibeg, G, c, nM, nN, u.pm, u.pn); }
    __device__ __forceinline__ const char* b_tile(const pg8::Unit& u) const { return Bt + (size_t)u.pn * 256 * rp; }
    __device__ __forceinline__ unsigned a_off(const pg8::Unit&, int r) const { return (unsigned)r * (unsigned)rp; }
    __device__ __forceinline__ int a_raw(const pg8::Unit&, int) const { return 0; }
    __device__ __forceinline__ unsigned a_fin(const pg8::Unit&, int r, int) const { return (unsigned)r * (unsigned)rp; }
};
template <bool GATHER_> struct MoeSched {
    static constexpr bool GATHER = GATHER_;
    const char* Bt; size_t bexp;
    const int* ltok; const LAS int* rbs; const LAS int* cnt; int nM, nN, G, c, rp;
    __device__ __forceinline__ size_t a_base(const pg8::Unit& u) const { return GATHER_ ? (size_t)0 : (size_t)u.pm * 256 * (size_t)rp; }
    __device__ __forceinline__ bool next(int i, pg8::Unit& u) const {
        if (!pg8::static_order(i, G, c, nM, nN, u.pm, u.pn)) return false;
        const int lane = threadIdx.x & 63;
        const int v = (lane < 32) ? rbs[lane + 1] : 0x7fffffff;
        const unsigned long long m = __ballot(v <= u.pm);
        const int e = __builtin_amdgcn_readfirstlane((int)__popcll(m));
        u.e = e; u.rb = u.pm - __builtin_amdgcn_readfirstlane(rbs[e]); u.cnt = __builtin_amdgcn_readfirstlane(cnt[e]);
        return true;
    }
    __device__ __forceinline__ const char* b_tile(const pg8::Unit& u) const { return Bt + (size_t)u.e * bexp + (size_t)u.pn * 256 * rp; }
    __device__ __forceinline__ unsigned a_off(const pg8::Unit& u, int r) const {
        return a_fin(u, r, a_raw(u, r));
    }
    __device__ __forceinline__ int a_raw(const pg8::Unit& u, int r) const { if constexpr (GATHER_) return ltok[u.e * LIST_CAP + u.rb * 256 + r]; else return 0; }
    __device__ __forceinline__ void gather_dma(const pg8::Unit& u, LAS unsigned char* dst, int wid, int lane) const {
        if (wid < 4) __builtin_amdgcn_global_load_lds((const unsigned*)(ltok + (size_t)u.e * LIST_CAP + u.rb * 256 + wid * 64 + lane), (LAS unsigned*)(dst + wid * 256), 4, 0, 0); }
    __device__ __forceinline__ unsigned a_fin(const pg8::Unit& u, int r, int raw) const {
        if constexpr (GATHER_) { const int t4 = (u.rb * 256 + r < u.cnt) ? raw : 0; return (unsigned)(t4 >> 2) * (unsigned)rp; }
        else return (unsigned)r * (unsigned)rp;
    }
};

__device__ __forceinline__ void side_dma(const void* src_lane, LAS unsigned char* dst_wave) { __builtin_amdgcn_global_load_lds((const unsigned*)src_lane, (LAS unsigned*)dst_wave, 4, 0, 0); }

struct EpiProj {
    static constexpr bool PERM = true, MIDSCALE = false;
    bf16* O; const float* bias; const float* rowscale;
    __device__ __forceinline__ void side(const pg8::Unit& u, LAS unsigned char* area, int wid, int lane) const {
        if (wid < 4) side_dma(bias + u.pn * 256 + wid * 64 + lane, area + wid * 256);
        else side_dma(rowscale + u.pm * 256 + (wid - 4) * 64 + lane, area + 1024 + (wid - 4) * 256); }
    __device__ __forceinline__ void operator()(const f32x4 (&acc)[2][2][4][2], const pg8::Unit& u, int wr, int wc, int fr, int fq, const LAS unsigned char* area) const {
        const int row0 = u.pm * 256 + wr * 64 + fr;
        f32x4 bv[2][2];
#pragma unroll
        for (int bj = 0; bj < 2; ++bj)
#pragma unroll
            for (int n = 0; n < 2; ++n) bv[bj][n] = *(const LAS f32x4*)(area + 4 * (wc * 32 + 8 * fq + bj * 128 + 4 * n));
        if (u.pn < 3) {
            const int col0 = u.pn * 256 + wc * 32 + 8 * fq;
            const float sc = (u.pn < 2) ? QSCALE : 1.0f;
#pragma unroll
            for (int ai = 0; ai < 2; ++ai)
#pragma unroll
                for (int m = 0; m < 4; ++m) { bf16* rowp = O + (size_t)(row0 + ai * 128 + m * 16) * PJW + col0;
                    const float rs = *(const LAS float*)(area + 1024 + 4 * (ai * 128 + wr * 64 + m * 16 + fr));
#pragma unroll
                    for (int bj = 0; bj < 2; ++bj) { const f32x4 v0 = (acc[ai][bj][m][0] * rs + bv[bj][0]) * sc, v1 = (acc[ai][bj][m][1] * rs + bv[bj][1]) * sc;
                        v4u w; w.x = pk2(v0[0], v0[1]); w.y = pk2(v0[2], v0[3]); w.z = pk2(v1[0], v1[1]); w.w = pk2(v1[2], v1[3]);
                        *(v4u*)(rowp + bj * 128) = w; } }
        } else {
            const int col0 = COL_U + (u.pn - 3) * 128 + wc * 32 + 8 * fq;
#pragma unroll
            for (int ai = 0; ai < 2; ++ai)
#pragma unroll
                for (int m = 0; m < 4; ++m) { bf16* rowp = O + (size_t)(row0 + ai * 128 + m * 16) * PJW + col0;
                    const float rs = *(const LAS float*)(area + 1024 + 4 * (ai * 128 + wr * 64 + m * 16 + fr));
                    f32x2 uv[4];
#pragma unroll
                    for (int n = 0; n < 2; ++n)
#pragma unroll
                        for (int p = 0; p < 2; ++p) {
                            const f32x2 av = (f32x2){acc[ai][0][m][n][2 * p], acc[ai][0][m][n][2 * p + 1]} * rs + (f32x2){bv[0][n][2 * p], bv[0][n][2 * p + 1]};
                            const f32x2 gv = (f32x2){acc[ai][1][m][n][2 * p], acc[ai][1][m][n][2 * p + 1]} * rs + (f32x2){bv[1][n][2 * p], bv[1][n][2 * p + 1]};
                            const f32x2 z = gv * (-LOG2E);
                            const f32x2 d = (f32x2){__builtin_amdgcn_exp2f(z.x), __builtin_amdgcn_exp2f(z.y)} + 1.0f;
                            uv[2 * n + p] = av * (f32x2){__builtin_amdgcn_rcpf(d.x), __builtin_amdgcn_rcpf(d.y)}; }
                    v4u w; w.x = pk2(uv[0].x, uv[0].y); w.y = pk2(uv[1].x, uv[1].y); w.z = pk2(uv[2].x, uv[2].y); w.w = pk2(uv[3].x, uv[3].y);
                    *(v4u*)rowp = w; }
        }
    }
};
struct EpiRes {
    static constexpr bool PERM = true, MIDSCALE = true;
    const bf16* base; bf16* out; const float* bias; const float* rowscale;
    __device__ __forceinline__ void side(const pg8::Unit& u, LAS unsigned char* area, int wid, int lane) const {
        if (wid < 4) side_dma(bias + u.pn * 256 + wid * 64 + lane, area + wid * 256);
        else side_dma(rowscale + u.pm * 256 + (wid - 4) * 64 + lane, area + 1024 + (wid - 4) * 256); }
    __device__ __forceinline__ void operator()(const f32x4 (&acc)[2][2][4][2], const pg8::Unit& u, int wr, int wc, int fr, int fq, const LAS unsigned char* area) const {
        const int col0 = u.pn * 256 + wc * 32 + 8 * fq;
        f32x4 bv[2][2];
#pragma unroll
        for (int bj = 0; bj < 2; ++bj)
#pragma unroll
            for (int n = 0; n < 2; ++n) bv[bj][n] = *(const LAS f32x4*)(area + 4 * (wc * 32 + 8 * fq + bj * 128 + 4 * n));
#pragma unroll
        for (int ai = 0; ai < 2; ++ai) {
            v4u xr[4][2];
#pragma unroll
            for (int m = 0; m < 4; ++m) { const size_t off = (size_t)(u.pm * 256 + ai * 128 + wr * 64 + m * 16 + fr) * D + col0;
#pragma unroll
                for (int bj = 0; bj < 2; ++bj) xr[m][bj] = *(const v4u*)(base + off + bj * 128); }
            __builtin_amdgcn_sched_barrier(0);
#pragma unroll
            for (int m = 0; m < 4; ++m) { const size_t off = (size_t)(u.pm * 256 + ai * 128 + wr * 64 + m * 16 + fr) * D + col0;
#pragma unroll
                for (int bj = 0; bj < 2; ++bj) { const v4u xw = xr[m][bj];
                    const f32x4 v0 = (f32x4){bf_lo(xw.x), bf_hi(xw.x), bf_lo(xw.y), bf_hi(xw.y)} + acc[ai][bj][m][0] + bv[bj][0], v1 = (f32x4){bf_lo(xw.z), bf_hi(xw.z), bf_lo(xw.w), bf_hi(xw.w)} + acc[ai][bj][m][1] + bv[bj][1];
                    v4u w; w.x = pk2(v0[0], v0[1]); w.y = pk2(v0[2], v0[3]); w.z = pk2(v1[0], v1[1]); w.w = pk2(v1[2], v1[3]);
                    *(v4u*)(out + off + bj * 128) = w; } }
        }
    }
};
struct EpiSwiglu {
    static constexpr bool PERM = true, MIDSCALE = false;
    unsigned char* O; const float* b1p;
    __device__ __forceinline__ void side(const pg8::Unit& u, LAS unsigned char* area, int wid, int lane) const { if (wid < 4) side_dma(b1p + (size_t)u.e * 2048 + u.pn * 256 + wid * 64 + lane, area + wid * 256); }
    __device__ __forceinline__ void operator()(const f32x4 (&acc)[2][2][4][2], const pg8::Unit& u, int wr, int wc, int fr, int fq, const LAS unsigned char* area) const {
        const int row0 = u.pm * 256 + wr * 64 + fr, ocol0 = u.pn * 128 + wc * 32 + 8 * fq;
        f32x4 bg[2], bl[2];
#pragma unroll
        for (int n = 0; n < 2; ++n) { bg[n] = *(const LAS f32x4*)(area + 4 * (wc * 32 + 8 * fq + 4 * n)); bl[n] = *(const LAS f32x4*)(area + 4 * (128 + wc * 32 + 8 * fq + 4 * n)); }
        constexpr float SI = 1.0f / (H_SCALE * W_SCALE);
        const int odd = fq & 1, ocolw = u.pn * 128 + wc * 32 + 8 * (fq & ~1);
#pragma unroll
        for (int ai = 0; ai < 2; ++ai)
#pragma unroll
            for (int j2 = 0; j2 < 2; ++j2) {
                v2u w[2];
#pragma unroll
                for (int mm = 0; mm < 2; ++mm) { const int m = 2 * j2 + mm;
                f32x2 a[4];
#pragma unroll
                for (int n = 0; n < 2; ++n)
#pragma unroll
                    for (int p = 0; p < 2; ++p) {
                        const f32x2 gv = (f32x2){acc[ai][0][m][n][2 * p], acc[ai][0][m][n][2 * p + 1]} * SI + (f32x2){bg[n][2 * p], bg[n][2 * p + 1]};
                        const f32x2 lv = (f32x2){acc[ai][1][m][n][2 * p], acc[ai][1][m][n][2 * p + 1]} * SI + (f32x2){bl[n][2 * p], bl[n][2 * p + 1]};
                        const f32x2 gg = (f32x2){fminf(gv.x, 7.0f), fminf(gv.y, 7.0f)};
                        const f32x2 ll = (f32x2){__builtin_amdgcn_fmed3f(lv.x, -7.0f, 7.0f), __builtin_amdgcn_fmed3f(lv.y, -7.0f, 7.0f)};
                        const f32x2 z = gg * (-1.702f * LOG2E);
                        const f32x2 d = (f32x2){__builtin_amdgcn_exp2f(z.x), __builtin_amdgcn_exp2f(z.y)} + 1.0f;
                        const f32x2 r = (f32x2){__builtin_amdgcn_rcpf(d.x), __builtin_amdgcn_rcpf(d.y)};
                        a[2 * n + p] = (gg * r) * (ll * ACT_SCALE + ACT_SCALE); }
                w[mm].x = pk4_fp8(a[0].x, a[0].y, a[1].x, a[1].y); w[mm].y = pk4_fp8(a[2].x, a[2].y, a[3].x, a[3].y); }
                const auto rx = __builtin_amdgcn_permlane16_swap(w[0].x, w[1].x, false, false), ry = __builtin_amdgcn_permlane16_swap(w[0].y, w[1].y, false, false);
                v4u o; o.x = rx[0]; o.y = ry[0]; o.z = rx[1]; o.w = ry[1];
                *(v4u*)(O + (size_t)(row0 + ai * 128 + (2 * j2 + odd) * 16) * 1024 + ocolw) = o; }
    }
};
struct EpiMoeOut {
    static constexpr bool PERM = true, MIDSCALE = false;
    unsigned char* Y; const float* b2; const int* ltok; const float* lgate;
    __device__ __forceinline__ void side(const pg8::Unit& u, LAS unsigned char* area, int wid, int lane) const {
        if (wid < 4) { side_dma(b2 + (size_t)u.e * 1024 + u.pn * 256 + wid * 64 + lane, area + wid * 256); side_dma(ltok + (size_t)u.e * LIST_CAP + u.rb * 256 + wid * 64 + lane, area + 1024 + wid * 256); }
        else side_dma(lgate + (size_t)u.e * LIST_CAP + u.rb * 256 + (wid - 4) * 64 + lane, area + 2048 + (wid - 4) * 256); }
    __device__ __forceinline__ void operator()(const f32x4 (&acc)[2][2][4][2], const pg8::Unit& u, int wr, int wc, int fr, int fq, const LAS unsigned char* area) const {
        const int col0 = u.pn * 256 + wc * 32 + 8 * fq;
        f32x4 bv[2][2];
#pragma unroll
        for (int bj = 0; bj < 2; ++bj)
#pragma unroll
            for (int n = 0; n < 2; ++n) bv[bj][n] = *(const LAS f32x4*)(area + 4 * (wc * 32 + 8 * fq + bj * 128 + 4 * n));
        const int odd = fq & 1, colw = u.pn * 256 + wc * 32 + 8 * (fq & ~1);
#pragma unroll
        for (int ai = 0; ai < 2; ++ai)
#pragma unroll
            for (int j2 = 0; j2 < 2; ++j2) {
                int t4[2]; float gt[2]; bool ok[2];
#pragma unroll
                for (int mm = 0; mm < 2; ++mm) { const int r = ai * 128 + wr * 64 + (2 * j2 + mm) * 16 + fr;
                    t4[mm] = *(const LAS int*)(area + 1024 + 4 * r); gt[mm] = *(const LAS float*)(area + 2048 + 4 * r) * Y_SCALE; ok[mm] = (u.rb * 256 + r < u.cnt); }
                const int t4s = odd ? t4[1] : t4[0]; const bool oks = odd ? ok[1] : ok[0];
#pragma unroll
                for (int bj = 0; bj < 2; ++bj) {
                    v2u w[2];
#pragma unroll
                    for (int mm = 0; mm < 2; ++mm) { const int m = 2 * j2 + mm;
                        const f32x4 v0 = (acc[ai][bj][m][0] * (1.0f / (ACT_SCALE * W_SCALE)) + bv[bj][0]) * gt[mm], v1 = (acc[ai][bj][m][1] * (1.0f / (ACT_SCALE * W_SCALE)) + bv[bj][1]) * gt[mm];
                        w[mm].x = pk4_fp8(v0[0], v0[1], v0[2], v0[3]); w[mm].y = pk4_fp8(v1[0], v1[1], v1[2], v1[3]); }
                    const auto rx = __builtin_amdgcn_permlane16_swap(w[0].x, w[1].x, false, false), ry = __builtin_amdgcn_permlane16_swap(w[0].y, w[1].y, false, false);
                    v4u o; o.x = rx[0]; o.y = ry[0]; o.z = rx[1]; o.w = ry[1];
                    if (oks) *(v4u*)(Y + (size_t)t4s * 1024 + colw + bj * 128) = o; } }
    }
};

__host__ __device__ __forceinline__ int win_row(int c) { if (c < 768) return c; const int cc = c - 768, ch = cc & 511; return 768 + (ch >> 7) * 256 + ((cc >> 9) & 1) * 128 + (ch & 127); }
template <int ESZ, int MODE  >
__device__ __forceinline__ void p0_item(const float* W, int N, unsigned char* WT, size_t rowpitch, LAS unsigned* scr, int kb, int nb, int lane, float scale, const float* kscale = nullptr, const float* kscale_hi = nullptr) {
    constexpr int KT = (ESZ == 2) ? 64 : 128, NT = (ESZ == 2) ? 64 : 32, LPR = NT / 4;
    const int k0 = KT * kb, n0 = NT * nb, lg = lane / LPR, nc = lane % LPR;
    const float* src = W + (size_t)(k0 + 16 * lg) * N + n0 + 4 * nc;
    f32x4 v[16];
#pragma unroll
    for (int i = 0; i < 16; ++i) v[i] = *(const f32x4*)(src + (size_t)i * N);
    if (kscale) {
#pragma unroll
        for (int i = 0; i < 16; ++i) { const int k = k0 + 16 * lg + i; v[i] = v[i] * ((kscale_hi && k >= 512) ? kscale_hi[k - 512] : kscale[k]); } }
#pragma unroll
    for (int e = 0; e < 4; ++e) {
        LAS unsigned* row = scr + (4 * nc + e) * 36;
        if (ESZ == 2) {
            v4u a, b;
            a.x = pk2(v[0][e] * scale, v[1][e] * scale); a.y = pk2(v[2][e] * scale, v[3][e] * scale); a.z = pk2(v[4][e] * scale, v[5][e] * scale); a.w = pk2(v[6][e] * scale, v[7][e] * scale);
            b.x = pk2(v[8][e] * scale, v[9][e] * scale); b.y = pk2(v[10][e] * scale, v[11][e] * scale); b.z = pk2(v[12][e] * scale, v[13][e] * scale); b.w = pk2(v[14][e] * scale, v[15][e] * scale);
            *(LAS v4u*)(row + 8 * lg) = a; *(LAS v4u*)(row + 8 * lg + 4) = b;
        } else {
            v4u a;
            a.x = pk4_fp8(v[0][e] * scale, v[1][e] * scale, v[2][e] * scale, v[3][e] * scale); a.y = pk4_fp8(v[4][e] * scale, v[5][e] * scale, v[6][e] * scale, v[7][e] * scale);
            a.z = pk4_fp8(v[8][e] * scale, v[9][e] * scale, v[10][e] * scale, v[11][e] * scale); a.w = pk4_fp8(v[12][e] * scale, v[13][e] * scale, v[14][e] * scale, v[15][e] * scale);
            *(LAS v4u*)(row + 4 * lg) = a;
        }
    }
    LDS_WAIT(); asm volatile("" ::: "memory");
    const int c = lane & 7;
#pragma unroll
    for (int j = 0; j < NT / 8; ++j) { const int n = (lane >> 3) + 8 * j; const v4u o = *(const LAS v4u*)(scr + n * 36 + 4 * c);
        const int col = n0 + n; const int row = (MODE == 1) ? ((col & ~255) + 128 * (col & 1) + ((col >> 1) & 127)) : (MODE == 2) ? win_row(col) : col;
        *(GAS v4u*)(WT + (size_t)row * rowpitch + (size_t)k0 * ESZ + 16 * c) = o; }
    LDS_WAIT(); asm volatile("" ::: "memory");
}

struct W8Item { const float* src; unsigned char* dst; int N, k0, n0, mode; };
__device__ __forceinline__ W8Item w8_item(int r, const float* w1, const float* w2, unsigned char* W1_t, unsigned char* W2_t) {
    W8Item it;
    if (r < 32 * 8 * 64) { const int e = r >> 9, q = r & 511; it.src = w1 + (size_t)e * 1024 * 2048; it.dst = W1_t + (size_t)e * 2048 * 1024; it.N = 2048; it.k0 = 128 * (q >> 6); it.n0 = 32 * (q & 63); it.mode = 1; }
    else { r -= 32 * 8 * 64; const int e = r >> 8, q = r & 255; it.src = w2 + (size_t)e * 1024 * 1024; it.dst = W2_t + (size_t)e * 1024 * 1024; it.N = 1024; it.k0 = 128 * (q >> 5); it.n0 = 32 * (q & 31); it.mode = 0; }
    return it;
}
__device__ __forceinline__ void w8_load(const W8Item& it, f32x4 (&v)[16], int lane) {
    const float* src = it.src + (size_t)(it.k0 + 16 * (lane >> 3)) * it.N + it.n0 + 4 * (lane & 7);
#pragma unroll
    for (int i = 0; i < 16; ++i) v[i] = __builtin_nontemporal_load((const f32x4*)(src + (size_t)i * it.N));
}
__device__ __forceinline__ void w8_store(const W8Item& it, const f32x4 (&v)[16], LAS unsigned* scr, int lane) {
    const int lg = lane >> 3, nc = lane & 7;
#pragma unroll
    for (int e = 0; e < 4; ++e) { v4u a;
        a.x = pk4_fp8(v[0][e] * W_SCALE, v[1][e] * W_SCALE, v[2][e] * W_SCALE, v[3][e] * W_SCALE); a.y = pk4_fp8(v[4][e] * W_SCALE, v[5][e] * W_SCALE, v[6][e] * W_SCALE, v[7][e] * W_SCALE);
        a.z = pk4_fp8(v[8][e] * W_SCALE, v[9][e] * W_SCALE, v[10][e] * W_SCALE, v[11][e] * W_SCALE); a.w = pk4_fp8(v[12][e] * W_SCALE, v[13][e] * W_SCALE, v[14][e] * W_SCALE, v[15][e] * W_SCALE);
        *(LAS v4u*)(scr + (4 * nc + e) * 36 + 4 * lg) = a; }
    LDS_WAIT(); asm volatile("" ::: "memory");
    const int c = lane & 7;
#pragma unroll
    for (int j = 0; j < 4; ++j) { const int n = (lane >> 3) + 8 * j; const v4u o = *(const LAS v4u*)(scr + n * 36 + 4 * c);
        const int col = it.n0 + n; const int row = it.mode ? ((col & ~255) + 128 * (col & 1) + ((col >> 1) & 127)) : col;
        *(GAS v4u*)(it.dst + (size_t)row * 1024 + it.k0 + 16 * c) = o; }
    LDS_WAIT(); asm volatile("" ::: "memory");
}

struct Args { const float* in[21]; float* out; unsigned char* ws; };

__global__ void __launch_bounds__(NWAVES * 64, 2) hymba_fwd(Args args) {
    extern __shared__ __attribute__((aligned(16))) unsigned char lds_raw[];
    LAS unsigned char* lds = (LAS unsigned char*)lds_raw;
    volatile LAS unsigned* MISC = (volatile LAS unsigned*)(lds + MISC_OFF);
    LAS int* TAB = (LAS int*)(lds + TAB_OFF);
    LAS int* t_rbs = TAB; LAS int* t_cnt = TAB + 40; LAS int* t_lcnt = TAB + 72; LAS int* t_gbase = TAB + 104;
#define PHASE_IDS() int tid = threadIdx.x; asm volatile("" : "+v"(tid)); const int lane = tid & 63, wave = __builtin_amdgcn_readfirstlane(tid >> 6); (void)lane; (void)wave
    const int G = gridDim.x;
    const int vcu = (G % 8 == 0) ? ((int)blockIdx.x % 8) * (G / 8) + (int)blockIdx.x / 8 : (int)blockIdx.x;

    const float* x = args.in[0]; const float* g_mix = args.in[1]; const float* w_in = args.in[2]; const float* b_in = args.in[3];
    const float* sinks = args.in[4]; const float* w_dw = args.in[5]; const float* b_dw = args.in[6]; const float* ln_g = args.in[7]; const float* ln_b = args.in[8];
    const float* g_attn = args.in[9]; const float* g_conv = args.in[10]; const float* w_out = args.in[11]; const float* b_out = args.in[12];
    const float* g_ffn = args.in[13]; const float* w_router = args.in[14]; const float* b_router = args.in[15];
    const float* w1 = args.in[16]; const float* b1 = args.in[17]; const float* w2 = args.in[18]; const float* b2 = args.in[19]; const float* g_final = args.in[20];
    float* out = args.out; unsigned char* ws = args.ws;
    unsigned* ctl = (unsigned*)(ws + WS_CTL);
    bf16* Win_t = (bf16*)(ws + WS_WIN); bf16* Wout_t = (bf16*)(ws + WS_WOUT); unsigned char* W1_t = ws + WS_W1; unsigned char* W2_t = ws + WS_W2; unsigned char* XN8 = ws + WS_XN8; bf16* X1B = (bf16*)(ws + WS_XN);
    bf16* XN = (bf16*)(ws + WS_XN); int* ltok = (int*)(ws + WS_LTOK); float* lgate = (float*)(ws + WS_LGATE); float* b1p = (float*)(ws + WS_B1P);
    float* RA = (float*)(ws + WS_RA); float* RS = RA + T; float* BINP = RS + T + 256;   bf16* WrHi = (bf16*)(ws + WS_WR); bf16* WrLo = WrHi + 32 * 1024;
    unsigned char* ACT = ws + WS_ACT; bf16* PROJ = (bf16*)(ws + WS_PROJ); bf16* MIX = (bf16*)(ws + WS_MIX); unsigned char* YB = ws + WS_Y;
    unsigned* gcnt = ctl + CW_GCNT;

    for (int u = threadIdx.x; u < (LDS_BYTES - MISC_OFF) / 4; u += NWAVES * 64) ((LAS unsigned*)(lds + MISC_OFF))[u] = 0u;
    __syncthreads();
    XcdBarrier bar = xcd_barrier_post(ctl + CW_BAR, MISC + 8);

    {
        PHASE_IDS();
        LAS unsigned* scr = (LAS unsigned*)(lds + wave * 16384);
        const int gw = vcu * NWAVES + wave, NGW = G * NWAVES;
        constexpr int I_IN = 16 * 28, I_OUT = 16 * 16;
        for (int it = gw; it < I_IN + I_OUT; it += NGW) {
            int r = it;
            if (r < I_IN) { p0_item<2, 2>(w_in, INW, (unsigned char*)Win_t, 2048, scr, r / 28, r % 28, lane, 1.0f, g_mix); continue; } r -= I_IN;
            p0_item<2, 0>(w_out, 1024, (unsigned char*)Wout_t, 2048, scr, r >> 4, r & 15, lane, 1.0f, g_attn, g_conv);
        }
        for (int m = 2 * gw; m < T; m += 2 * NGW) {
            const GAS f32x4* xr = (const GAS f32x4*)(x + (size_t)m * D) + lane;
            f32x4 v[2][4]; float s[2] = {0.f, 0.f};
#pragma unroll
            for (int q = 0; q < 2; ++q)
#pragma unroll
                for (int j = 0; j < 4; ++j) v[q][j] = __builtin_nontemporal_load(xr + q * 256 + 64 * j);
#pragma unroll
            for (int q = 0; q < 2; ++q)
#pragma unroll
                for (int j = 0; j < 4; ++j) s[q] += (v[q][j].x * v[q][j].x + v[q][j].y * v[q][j].y) + (v[q][j].z * v[q][j].z + v[q][j].w * v[q][j].w);
#pragma unroll
            for (int q = 0; q < 2; ++q) {
                const float rstd = 1.0f / sqrtf(wave_sum(s[q]) * (1.0f / D) + RMS_EPS);
                if (lane == 0) RS[m + q] = rstd;
                GAS v2u* o8 = (GAS v2u*)(XN + (size_t)(m + q) * D) + lane;
#pragma unroll
                for (int j = 0; j < 4; ++j) { v2u o; o.x = pk2(v[q][j].x, v[q][j].y); o.y = pk2(v[q][j].z, v[q][j].w); o8[64 * j] = o; }
            }
        }
        const int gt = vcu * (NWAVES * 64) + tid, NGT = G * NWAVES * 64;
        for (int i = gt; i < INW; i += NGT) BINP[win_row(i)] = b_in[i];
        for (int i = gt; i < 32 * 2048; i += NGT) { const int e = i >> 11, col = i & 2047; const int row = (col & ~255) + 128 * (col & 1) + ((col >> 1) & 127); b1p[e * 2048 + row] = b1[i]; }
        for (int i = gt; i < 32 * 1024; i += NGT) { const int e = i >> 10, k = i & 1023; const float v = w_router[k * 32 + e];
            const unsigned h = pk2(v, 0.f) & 0xffffu; const float lo = v - __uint_as_float(h << 16);
            const int fi = ((((e >> 4) * 32 + (k >> 5)) * 64 + 16 * ((k >> 3) & 3) + (e & 15)) * 8) + (k & 7);
            WrHi[fi] = (bf16)h; WrLo[fi] = (bf16)(pk2(lo, 0.f) & 0xffffu); }
    }
    xcd_barrier(bar);

    {
        const int grp = ((int)blockIdx.x >> 3) & 3;
        EpiProj E{PROJ, BINP, RS};
        {
            DenseSched S{(const char*)Win_t, T / 256, INW / 256, G, (int)blockIdx.x, 2048, 0, grp};
            pg8::gemm_phase<EpiProj, DenseSched, false>(lds, lds + EPI_OFF, (const char*)XN, 2048, S, E);
        }
        {
            PHASE_IDS();
            __syncthreads();
            LAS unsigned* scr = (LAS unsigned*)(lds + wave * 16384);
            const int gw = vcu * NWAVES + wave, NGW = G * NWAVES;
            constexpr int NIT_ALL = 16384;
            int it = gw, NIT = NIT_ALL, NGW_ = NGW;
            if (G == 256) { const int c = (int)blockIdx.x; NGW_ = 1024;
                if (c >= 128) { it = (c - 128) * NWAVES + wave; NIT = 10240; } else { it = 10240 + c * NWAVES + wave; NIT = NIT_ALL; } }
            f32x4 va[16], vb[16];
            W8Item ia = w8_item(24575 - (it < NIT ? it : 0), w1, w2, W1_t, W2_t), ib = ia;
            if (it < NIT) w8_load(ia, va, lane);
            while (it < NIT) {
                const int itb = it + NGW_;
                if (itb < NIT) { ib = w8_item(24575 - itb, w1, w2, W1_t, W2_t); w8_load(ib, vb, lane); }
                w8_store(ia, va, scr, lane);
                if (itb >= NIT) break;
                const int ita = itb + NGW_;
                if (ita < NIT) { ia = w8_item(24575 - ita, w1, w2, W1_t, W2_t); w8_load(ia, va, lane); }
                w8_store(ib, vb, scr, lane);
                it = ita;
            }
            __syncthreads();
        }
        {
            DenseSched S{(const char*)Win_t, T / 256, INW / 256, G, (int)blockIdx.x, 2048, grp, 1 << 30};
            pg8::gemm_phase<EpiProj, DenseSched, false>(lds, lds + EPI_OFF, (const char*)XN, 2048, S, E);
        }
    }
    xcd_barrier(bar);

    for (int unit = blockIdx.x; unit < T / 128; unit += G) {
        const int b = unit >> 4, n = unit & 15, t0 = b * SEQ + n * 128;
        {
            PHASE_IDS();
            constexpr int KOFF = 0, VOFF = 36864;
            const int i16 = lane & 15, g = lane >> 4;
            const int vq = i16 >> 2, vp = i16 & 3;
            float ssq = 0.f;
            const bf16* qrow = PROJ + (size_t)(t0 + 16 * wave + i16) * PJW + 8 * g;
            bf16* orow = MIX + (size_t)(t0 + 16 * wave + i16) * D + 4 * g;
            bf16x8 q0n = *(const bf16x8*)qrow, q1n = *(const bf16x8*)(qrow + 32);
            v4u kpre[4], vpre[4];
#define KV_LOAD(kvh) do { _Pragma("unroll") for (int c4 = 0; c4 < 4; ++c4) { const int c = tid + 512 * c4, row = c >> 3, ch = c & 7; kpre[c4] = (v4u){0u, 0u, 0u, 0u}; vpre[c4] = kpre[c4]; \
                if (n > 0 || row >= 128) { const bf16* p = PROJ + (size_t)(t0 - 128 + row) * PJW + (kvh) * 64 + ch * 8; kpre[c4] = *(const v4u*)(p + COL_K); vpre[c4] = *(const v4u*)(p + COL_V); } } } while (0)
#define KV_WRITE() do { _Pragma("unroll") for (int c4 = 0; c4 < 4; ++c4) { const int c = tid + 512 * c4, row = c >> 3, ch = c & 7; \
                *(LAS v4u*)(lds + KOFF + row * 144 + ch * 16) = kpre[c4]; *(LAS v4u*)(lds + VOFF + row * 144 + ch * 16) = vpre[c4]; } } while (0)
            KV_LOAD(0);
            __syncthreads();
            KV_WRITE();
            KV_LOAD(1);
            __syncthreads();
            for (int h = 0; h < 8; ++h) {
                if (h == 4) { __syncthreads(); KV_WRITE(); __syncthreads(); }
                const bf16x8 q0 = q0n, q1 = q1n;
                if (h < 7) { q0n = *(const bf16x8*)(qrow + (h + 1) * 64); q1n = *(const bf16x8*)(qrow + (h + 1) * 64 + 32); }
                f32x4 st[9];
#pragma unroll
                for (int j = 0; j < 9; ++j) { const LAS unsigned char* kp = lds + KOFF + (16 * (wave + j) + i16) * 144 + 16 * g;
                    const bf16x8 k0 = *(const LAS bf16x8*)kp, k1 = *(const LAS bf16x8*)(kp + 64);
                    st[j] = __builtin_amdgcn_mfma_f32_16x16x32_bf16(k0, q0, (f32x4){0.f, 0.f, 0.f, 0.f}, 0, 0, 0);
                    st[j] = __builtin_amdgcn_mfma_f32_16x16x32_bf16(k1, q1, st[j], 0, 0, 0); }
                const float NEG = -INFINITY;
#pragma unroll
                for (int j = 0; j < 9; ++j) { const bool dead = (n == 0) && (wave + j < 8);
#pragma unroll
                    for (int r = 0; r < 4; ++r) { const int kr = 4 * g + r; bool ok = !dead; if (j == 0) ok = ok && (kr > i16); if (j == 8) ok = ok && (kr <= i16); if (!ok) st[j][r] = NEG; } }
                const float sink2 = sinks[h] * LOG2E;
                float mx = sink2;
#pragma unroll
                for (int j = 0; j < 9; ++j) mx = fmaxf(fmaxf(mx, fmaxf(st[j][0], st[j][1])), fmaxf(st[j][2], st[j][3]));
                mx = fmaxf(mx, __shfl_xor(mx, 16)); mx = fmaxf(mx, __shfl_xor(mx, 32));
                float ls = 0.f;
#pragma unroll
                for (int j = 0; j < 9; ++j)
#pragma unroll
                    for (int r = 0; r < 4; ++r) { st[j][r] = __builtin_amdgcn_exp2f(st[j][r] - mx); ls += st[j][r]; }
                ls += __shfl_xor(ls, 16); ls += __shfl_xor(ls, 32);
                ls += __builtin_amdgcn_exp2f(sink2 - mx);
                const float inv = 1.0f / ls;
                bf16x8 pf[5];
#pragma unroll
                for (int kk = 0; kk < 5; ++kk) { v4u w; w.x = pk2(st[2 * kk][0], st[2 * kk][1]); w.y = pk2(st[2 * kk][2], st[2 * kk][3]);
                    if (kk < 4) { w.z = pk2(st[2 * kk + 1][0], st[2 * kk + 1][1]); w.w = pk2(st[2 * kk + 1][2], st[2 * kk + 1][3]); } else { w.z = 0u; w.w = 0u; }
                    pf[kk] = __builtin_bit_cast(bf16x8, w); }
                v2u ow[4];
#pragma unroll
                for (int dt = 0; dt < 4; ++dt) { f32x4 o = (f32x4){0.f, 0.f, 0.f, 0.f};
#pragma unroll
                    for (int kk = 0; kk < 5; ++kk) { const int kta = wave + 2 * kk, ktb = (kk < 4) ? wave + 2 * kk + 1 : wave + 8;
                        const LAS unsigned char* pa = lds + VOFF + (16 * kta + 4 * g + vq) * 144 + (16 * dt + 4 * vp) * 2;
                        const LAS unsigned char* pb = lds + VOFF + (16 * ktb + 4 * g + vq) * 144 + (16 * dt + 4 * vp) * 2;
                        const v4i16_t va = __builtin_amdgcn_ds_read_tr16_b64_v4i16((LAS v4i16_t*)pa), vb = __builtin_amdgcn_ds_read_tr16_b64_v4i16((LAS v4i16_t*)pb);
                        const bf16x8 vf = (bf16x8){va[0], va[1], va[2], va[3], vb[0], vb[1], vb[2], vb[3]};
                        o = __builtin_amdgcn_mfma_f32_16x16x32_bf16(vf, pf[kk], o, 0, 0, 0); }
                    o = o * inv; ssq += (o[0] * o[0] + o[1] * o[1]) + (o[2] * o[2] + o[3] * o[3]);
                    ow[dt].x = pk2(o[0], o[1]); ow[dt].y = pk2(o[2], o[3]); }
#pragma unroll
                for (int dp = 0; dp < 2; ++dp) {
                    const auto rx = __builtin_amdgcn_permlane16_swap(ow[2 * dp].x, ow[2 * dp + 1].x, false, false), ry = __builtin_amdgcn_permlane16_swap(ow[2 * dp].y, ow[2 * dp + 1].y, false, false);
                    v4u o4; o4.x = rx[0]; o4.y = ry[0]; o4.z = rx[1]; o4.w = ry[1];
                    *(v4u*)(orow - 4 * g + h * 64 + 16 * (2 * dp + (g & 1)) + 4 * (g & ~1)) = o4; }
            }
#undef KV_LOAD
#undef KV_WRITE
            ssq += __shfl_xor(ssq, 16); ssq += __shfl_xor(ssq, 32);
            if (g == 0) RA[t0 + 16 * wave + i16] = 1.0f / sqrtf(ssq * (1.0f / 512.0f) + RMS_EPS);
        }
        __syncthreads();
        {
            PHASE_IDS();
            const int cp = tid & 255, th = tid >> 8, c0 = 2 * cp;
            LAS float* tile = (LAS float*)lds;
            f32x2 wk[31];
#pragma unroll
            for (int j = 0; j < 31; ++j) wk[j] = *(const f32x2*)(w_dw + j * 512 + c0);
            const f32x2 bdw = *(const f32x2*)(b_dw + c0);
            const int s0 = n * 128 + 64 * th;
            const bf16* pbase = PROJ + (size_t)(b * SEQ) * PJW + COL_U + c0;
            f32x2 uu[38];
            unsigned ra_[8];
#define GLU_CVT(aw, dst) do { dst.x = bf_lo(aw); dst.y = bf_hi(aw); } while (0)
#pragma unroll
            for (int i = 0; i < 30; ++i) { const int pos = s0 - 30 + i; unsigned aw = 0u;
                if (pos >= 0) aw = *(const unsigned*)(pbase + (size_t)pos * PJW);
                GLU_CVT(aw, uu[i]); }
#pragma unroll
            for (int tt = 0; tt < 8; ++tt) { const int pos = s0 + tt; ra_[tt] = *(const unsigned*)(pbase + (size_t)pos * PJW); }
            LAS float* prm = tile + 16 * 512;
            prm[tid] = ln_g[tid]; prm[512 + tid] = ln_b[tid];
            for (int chunk = 0; chunk < 8; ++chunk) {
#pragma unroll
                for (int tt = 0; tt < 8; ++tt) GLU_CVT(ra_[tt], uu[30 + tt]);
                if (chunk < 7) {
#pragma unroll
                    for (int tt = 0; tt < 8; ++tt) { const int pos = s0 + 8 * (chunk + 1) + tt; ra_[tt] = *(const unsigned*)(pbase + (size_t)pos * PJW); }
                }
#pragma unroll
                for (int tt = 0; tt < 8; ++tt) { f32x2 a = bdw;
#pragma unroll
                    for (int j = 0; j < 31; ++j) a = a + wk[j] * uu[tt + j];
                    *(LAS f32x2*)(tile + (th * 8 + tt) * 512 + c0) = a; }
#pragma unroll
                for (int i = 0; i < 30; ++i) uu[i] = uu[i + 8];
                LDS_WAIT(); __builtin_amdgcn_s_barrier(); asm volatile("" ::: "memory");
#pragma unroll
                for (int q = 0; q < 2; ++q) { const int row = 2 * wave + q, rth = row >> 3, rtt = row & 7; const int tok = t0 + 64 * rth + 8 * chunk + rtt;
                    const f32x4 a0 = *(const LAS f32x4*)(tile + row * 512 + 8 * lane), a1 = *(const LAS f32x4*)(tile + row * 512 + 8 * lane + 4);
                    float v[8] = {a0[0], a0[1], a0[2], a0[3], a1[0], a1[1], a1[2], a1[3]};
                    float s = 0.f;
#pragma unroll
                    for (int j = 0; j < 8; ++j) s += v[j];
                    const float mean = wave_sum_dpp(s) * (1.0f / 512.0f);
                    float s2 = 0.f;
#pragma unroll
                    for (int j = 0; j < 8; ++j) { v[j] -= mean; s2 += v[j] * v[j]; }
                    const float rstd = 1.0f / sqrtf(wave_sum_dpp(s2) * (1.0f / 512.0f) + LN_EPS);
                    const f32x4 lg0 = *(const LAS f32x4*)(prm + 8 * lane), lg1 = *(const LAS f32x4*)(prm + 8 * lane + 4), lb0 = *(const LAS f32x4*)(prm + 512 + 8 * lane), lb1 = *(const LAS f32x4*)(prm + 512 + 8 * lane + 4);
                    const float lgv[8] = {lg0[0], lg0[1], lg0[2], lg0[3], lg1[0], lg1[1], lg1[2], lg1[3]}, lbv[8] = {lb0[0], lb0[1], lb0[2], lb0[3], lb1[0], lb1[1], lb1[2], lb1[3]};
                    float s3 = 0.f;
#pragma unroll
                    for (int j = 0; j < 8; ++j) { const float y = v[j] * rstd * lgv[j] + lbv[j]; const float z = y * __builtin_amdgcn_rcpf(1.0f + __builtin_amdgcn_exp2f(-y * LOG2E)); v[j] = z; s3 += z * z; }
                    const float rc = 1.0f / sqrtf(wave_sum_dpp(s3) * (1.0f / 512.0f) + RMS_EPS);
                    v4u w; w.x = pk2(v[0] * rc, v[1] * rc); w.y = pk2(v[2] * rc, v[3] * rc); w.z = pk2(v[4] * rc, v[5] * rc); w.w = pk2(v[6] * rc, v[7] * rc);
                    *(v4u*)(MIX + (size_t)tok * D + 512 + 8 * lane) = w; }
                LDS_WAIT(); __builtin_amdgcn_s_barrier(); asm volatile("" ::: "memory");
            }
#undef GLU_CVT
        }
    }
    xcd_barrier(bar);

    {
        const int grp = ((int)blockIdx.x >> 3) % 3;
        EpiRes E{XN, X1B, b_out, RA};
        {
            DenseSched S{(const char*)Wout_t, T / 256, D / 256, G, (int)blockIdx.x, 2048, 0, grp};
            pg8::gemm_phase<EpiRes, DenseSched, false>(lds, lds + EPI_OFF, (const char*)MIX, 2048, S, E);
        }
        {
            PHASE_IDS();
            __syncthreads();
            LAS unsigned* scr = (LAS unsigned*)(lds + wave * 16384);
            const int gw = vcu * NWAVES + wave, NGW = G * NWAVES;
            constexpr int NIT = 8192;
            f32x4 va[16], vb[16];
            int it = gw;
            W8Item ia = w8_item(8191 - (it < NIT ? it : 0), w1, w2, W1_t, W2_t), ib = ia;
            if (it < NIT) w8_load(ia, va, lane);
            while (it < NIT) {
                const int itb = it + NGW;
                if (itb < NIT) { ib = w8_item(8191 - itb, w1, w2, W1_t, W2_t); w8_load(ib, vb, lane); }
                w8_store(ia, va, scr, lane);
                if (itb >= NIT) break;
                const int ita = itb + NGW;
                if (ita < NIT) { ia = w8_item(8191 - ita, w1, w2, W1_t, W2_t); w8_load(ia, va, lane); }
                w8_store(ib, vb, scr, lane);
                it = ita;
            }
            __syncthreads();
        }
        {
            DenseSched S{(const char*)Wout_t, T / 256, D / 256, G, (int)blockIdx.x, 2048, grp, 1 << 30};
            pg8::gemm_phase<EpiRes, DenseSched, false>(lds, lds + EPI_OFF, (const char*)MIX, 2048, S, E);
        }
    }
    xcd_barrier(bar);

    {
        PHASE_IDS();
        if (wave < 4) __builtin_amdgcn_global_load_lds((const unsigned*)((const char*)g_ffn + wave * 1024 + lane * 16), (LAS unsigned*)(lds + P4_G_OFF + wave * 1024), 16, 0, 0);
#pragma unroll
        for (int i = 0; i < 16; ++i) __builtin_amdgcn_global_load_lds((const unsigned*)((const char*)WrHi + (size_t)(wave * 16 + i) * 1024 + lane * 16), (LAS unsigned*)(lds + (wave * 16 + i) * 1024), 16, 0, 0);
        VM_WAIT(); __syncthreads();
    }
    for (int unit = blockIdx.x; unit < T / 128; unit += G) {
        PHASE_IDS();
        const int i16 = lane & 15, g = lane >> 4;
        if (tid < 32) t_lcnt[tid] = 0;
        __syncthreads();
        const int tok = unit * 128 + wave * 16 + i16;
        const bf16* xr = X1B + (size_t)tok * D + 8 * g;
        float ss = 0.f;
#pragma unroll 8
        for (int s = 0; s < 32; ++s) { const v4u a = *(const v4u*)(xr + 32 * s);
            const float a0 = bf_lo(a.x), a1 = bf_hi(a.x), a2 = bf_lo(a.y), a3 = bf_hi(a.y), a4 = bf_lo(a.z), a5 = bf_hi(a.z), a6 = bf_lo(a.w), a7 = bf_hi(a.w);
            ss += (a0 * a0 + a1 * a1) + (a2 * a2 + a3 * a3) + (a4 * a4 + a5 * a5) + (a6 * a6 + a7 * a7); }
        ss += __shfl_xor(ss, 16); ss += __shfl_xor(ss, 32);
        const float rstd = 1.0f / sqrtf(ss * (1.0f / D) + RMS_EPS);
        f32x4 acc0 = (f32x4){0.f, 0.f, 0.f, 0.f}, acc1 = acc0;
        {
        unsigned char* hrow = XN8 + (size_t)tok * D + 8 * g;
        const bf16* wh0 = WrHi + lane * 8; const bf16* wl0 = WrLo + lane * 8;
        for (int s8 = 0; s8 < 4; ++s8) {
            v4u xc[8];
#pragma unroll
            for (int q = 0; q < 8; ++q) xc[q] = *(const v4u*)(xr + 32 * (8 * s8 + q));
            __builtin_amdgcn_sched_barrier(0);
#pragma unroll
            for (int q = 0; q < 8; ++q) { const int s = 8 * s8 + q; const v4u xa = xc[q];
            const f32x4 a = (f32x4){bf_lo(xa.x), bf_hi(xa.x), bf_lo(xa.y), bf_hi(xa.y)} * rstd * *(const LAS f32x4*)((const LAS float*)(lds + P4_G_OFF) + 8 * g + 32 * s), b = (f32x4){bf_lo(xa.z), bf_hi(xa.z), bf_lo(xa.w), bf_hi(xa.w)} * rstd * *(const LAS f32x4*)((const LAS float*)(lds + P4_G_OFF) + 8 * g + 32 * s + 4);
            v4u hp; hp.x = pk2(a[0], a[1]); hp.y = pk2(a[2], a[3]); hp.z = pk2(b[0], b[1]); hp.w = pk2(b[2], b[3]);
            v4u lp; lp.x = pk2(a[0] - bf_lo(hp.x), a[1] - bf_hi(hp.x)); lp.y = pk2(a[2] - bf_lo(hp.y), a[3] - bf_hi(hp.y)); lp.z = pk2(b[0] - bf_lo(hp.z), b[1] - bf_hi(hp.z)); lp.w = pk2(b[2] - bf_lo(hp.w), b[3] - bf_hi(hp.w));
            const bf16x8 hh = __builtin_bit_cast(bf16x8, hp), hl = __builtin_bit_cast(bf16x8, lp);
            const LAS unsigned char* wf = lds + lane * 16; const bf16x8 whA = *(const LAS bf16x8*)(wf + (0 * 32 + s) * 1024), whB = *(const LAS bf16x8*)(wf + (1 * 32 + s) * 1024), wlA = *(const LAS bf16x8*)(wf + (2 * 32 + s) * 1024), wlB = *(const LAS bf16x8*)(wf + (3 * 32 + s) * 1024);
            acc0 = __builtin_amdgcn_mfma_f32_16x16x32_bf16(whA, hh, acc0, 0, 0, 0); acc0 = __builtin_amdgcn_mfma_f32_16x16x32_bf16(whA, hl, acc0, 0, 0, 0); acc0 = __builtin_amdgcn_mfma_f32_16x16x32_bf16(wlA, hh, acc0, 0, 0, 0);
            acc1 = __builtin_amdgcn_mfma_f32_16x16x32_bf16(whB, hh, acc1, 0, 0, 0); acc1 = __builtin_amdgcn_mfma_f32_16x16x32_bf16(whB, hl, acc1, 0, 0, 0); acc1 = __builtin_amdgcn_mfma_f32_16x16x32_bf16(wlB, hh, acc1, 0, 0, 0); }
        }
        }
        {
            unsigned char* hrow = XN8 + (size_t)tok * D + 8 * g;
            const float rs8 = rstd * H_SCALE;
            for (int s8 = 0; s8 < 4; ++s8) {
                v4u xc[8];
#pragma unroll
                for (int q = 0; q < 8; ++q) xc[q] = *(const v4u*)(xr + 32 * (8 * s8 + q));
                __builtin_amdgcn_sched_barrier(0);
#pragma unroll
                for (int q2 = 0; q2 < 4; ++q2) { v2u h8[2];
#pragma unroll
                    for (int qq = 0; qq < 2; ++qq) { const int q = 2 * q2 + qq, s = 8 * s8 + q; const v4u xa = xc[q];
                    const f32x4 a = (f32x4){bf_lo(xa.x), bf_hi(xa.x), bf_lo(xa.y), bf_hi(xa.y)} * rs8 * *(const LAS f32x4*)((const LAS float*)(lds + P4_G_OFF) + 8 * g + 32 * s), b = (f32x4){bf_lo(xa.z), bf_hi(xa.z), bf_lo(xa.w), bf_hi(xa.w)} * rs8 * *(const LAS f32x4*)((const LAS float*)(lds + P4_G_OFF) + 8 * g + 32 * s + 4);
                    h8[qq].x = pk4_fp8(a[0], a[1], a[2], a[3]); h8[qq].y = pk4_fp8(b[0], b[1], b[2], b[3]); }
                    const auto rx = __builtin_amdgcn_permlane16_swap(h8[0].x, h8[1].x, false, false), ry = __builtin_amdgcn_permlane16_swap(h8[0].y, h8[1].y, false, false);
                    v4u o4; o4.x = rx[0]; o4.y = ry[0]; o4.z = rx[1]; o4.w = ry[1];
                    *(v4u*)(hrow - 8 * g + 32 * (8 * s8 + 2 * q2 + (g & 1)) + 8 * (g & ~1)) = o4; }
            }
        }
        LAS float* sc = (LAS float*)(lds + EPI_OFF + wave * 2112);
#pragma unroll
        for (int r = 0; r < 4; ++r) { sc[i16 * 33 + 4 * g + r] = acc0[r] + b_router[4 * g + r]; sc[i16 * 33 + 16 + 4 * g + r] = acc1[r] + b_router[16 + 4 * g + r]; }
        LDS_WAIT(); asm volatile("" ::: "memory");
        int idx[4], rank[4]; float gate[4];
        if (lane < 16) {
            float v[32];
#pragma unroll
            for (int e = 0; e < 32; ++e) v[e] = sc[lane * 33 + e];
            float val[4];
#pragma unroll
            for (int k = 0; k < 4; ++k) { float best = -INFINITY; int bi = 0;
#pragma unroll
                for (int e = 0; e < 32; ++e) if (v[e] > best) { best = v[e]; bi = e; }
                val[k] = best; idx[k] = bi;
#pragma unroll
                for (int e = 0; e < 32; ++e) v[e] = (e == bi) ? -INFINITY : v[e]; }
            float den = 0.f;
#pragma unroll
            for (int k = 0; k < 4; ++k) { gate[k] = __expf(val[k] - val[0]); den += gate[k]; }
            const float rden = 1.0f / den;
#pragma unroll
            for (int k = 0; k < 4; ++k) { gate[k] *= rden; rank[k] = atomicAdd((int*)(t_lcnt + idx[k]), 1); }
        }
        __syncthreads();
        if (tid < 32) { const int c = t_lcnt[tid]; t_gbase[tid] = c ? (int)__hip_atomic_fetch_add(gcnt + 16 * tid, (unsigned)c, __ATOMIC_RELAXED, __HIP_MEMORY_SCOPE_AGENT) : 0; }
        __syncthreads();
        if (lane < 16) {
            const int tk = unit * 128 + wave * 16 + lane;
#pragma unroll
            for (int k = 0; k < 4; ++k) { const int pos = t_gbase[idx[k]] + rank[k]; ltok[idx[k] * LIST_CAP + pos] = tk * 4 + k; lgate[idx[k] * LIST_CAP + pos] = gate[k]; }
        }
        __syncthreads();
    }
    xcd_barrier(bar);

    if (threadIdx.x < 32) t_cnt[threadIdx.x] = (int)__hip_atomic_load(gcnt + 16 * threadIdx.x, __ATOMIC_RELAXED, __HIP_MEMORY_SCOPE_AGENT);
    __syncthreads();
    if (threadIdx.x == 0) { int s = 0; for (int e = 0; e < 32; ++e) { t_rbs[e] = s; s += (t_cnt[e] + 255) >> 8; } t_rbs[32] = s; }
    __syncthreads();
    const int NB = __builtin_amdgcn_readfirstlane(t_rbs[32]);

    {
        MoeSched<true> S{(const char*)W1_t, (size_t)2048 * 1024, ltok, t_rbs, t_cnt, NB, 8, G, (int)blockIdx.x, 1024};
        EpiSwiglu E{ACT, b1p};
        pg8::gemm_phase<EpiSwiglu, MoeSched<true>, true>(lds, lds + EPI_OFF, (const char*)XN8, 1024, S, E);
    }
    xcd_barrier(bar);

    {
        MoeSched<false> S{(const char*)W2_t, (size_t)1024 * 1024, ltok, t_rbs, t_cnt, NB, 4, G, (int)blockIdx.x, 1024};
        EpiMoeOut E{YB, b2, ltok, lgate};
        pg8::gemm_phase<EpiMoeOut, MoeSched<false>, true, false>(lds, lds + EPI_OFF, (const char*)ACT, 1024, S, E);
    }
    xcd_barrier(bar);

    {
        PHASE_IDS();
        const int gw = vcu * NWAVES + wave, NGW = G * NWAVES;
        f32x4 gfin[4];
#pragma unroll
        for (int j = 0; j < 4; ++j) gfin[j] = *((const f32x4*)g_final + lane + 64 * j);
        for (int m0 = 2 * gw; m0 < T; m0 += 2 * NGW) {
            v2u xw_[2][4]; unsigned yw[2][4][4];
#pragma unroll
            for (int q = 0; q < 2; ++q) { const GAS v2u* xr = (const GAS v2u*)(X1B + (size_t)(m0 + q) * D) + lane;
#pragma unroll
                for (int j = 0; j < 4; ++j) xw_[q][j] = __builtin_nontemporal_load(xr + 64 * j);
#pragma unroll
                for (int k = 0; k < 4; ++k) { const GAS unsigned* yr = (const GAS unsigned*)(YB + ((size_t)(m0 + q) * 4 + k) * D) + lane;
#pragma unroll
                    for (int j = 0; j < 4; ++j) yw[q][k][j] = __builtin_nontemporal_load(yr + 64 * j); } }
#pragma unroll
            for (int q = 0; q < 2; ++q) {
                f32x4 v[4];
#pragma unroll
                for (int j = 0; j < 4; ++j) v[j] = (f32x4){bf_lo(xw_[q][j].x), bf_hi(xw_[q][j].x), bf_lo(xw_[q][j].y), bf_hi(xw_[q][j].y)};
#pragma unroll
                for (int k = 0; k < 4; ++k)
#pragma unroll
                    for (int j = 0; j < 4; ++j) { const f32x2 lo = __builtin_amdgcn_cvt_pk_f32_fp8((int)yw[q][k][j], false), hi = __builtin_amdgcn_cvt_pk_f32_fp8((int)yw[q][k][j], true);
                        v[j].x += lo.x * (1.0f / Y_SCALE); v[j].y += lo.y * (1.0f / Y_SCALE); v[j].z += hi.x * (1.0f / Y_SCALE); v[j].w += hi.y * (1.0f / Y_SCALE); }
                float s = 0.f;
#pragma unroll
                for (int j = 0; j < 4; ++j) s += (v[j].x * v[j].x + v[j].y * v[j].y) + (v[j].z * v[j].z + v[j].w * v[j].w);
                const float rstd = 1.0f / sqrtf(wave_sum_dpp(s) * (1.0f / D) + RMS_EPS);
                GAS f32x4* xw = (GAS f32x4*)(out + (size_t)(m0 + q) * D) + lane;
#pragma unroll
                for (int j = 0; j < 4; ++j) __builtin_nontemporal_store(v[j] * rstd * gfin[j], xw + 64 * j);
            }
        }
    }
}

extern "C" void kernel_launch(void* const* d_in, const int* in_sizes, int n_in, void* d_out, int out_size, void* d_ws, size_t ws_size, hipStream_t stream) {
    static int grid = 0;
    if (grid == 0) {
        if (n_in != 21 || in_sizes[0] != T * D || out_size != T * D || ws_size < WS_END) { fprintf(stderr, "kernel_launch: unexpected shapes (n_in %d, in0 %d, out %d, ws %zu)\n", n_in, n_in > 0 ? in_sizes[0] : -1, out_size, ws_size); grid = -1; return; }
        int dev = 0, cus = 0, per_cu = 0;
        if (hipGetDevice(&dev) != hipSuccess || hipDeviceGetAttribute(&cus, hipDeviceAttributeMultiprocessorCount, dev) != hipSuccess) { grid = -1; return; }
        if (hipFuncSetAttribute((const void*)hymba_fwd, hipFuncAttributeMaxDynamicSharedMemorySize, LDS_BYTES) != hipSuccess) { fprintf(stderr, "kernel_launch: hipFuncSetAttribute failed\n"); grid = -1; return; }
        if (hipOccupancyMaxActiveBlocksPerMultiprocessor(&per_cu, (const void*)hymba_fwd, NWAVES * 64, LDS_BYTES) != hipSuccess || per_cu < 1)
            fprintf(stderr, "kernel_launch: occupancy query reports %d workgroups per CU\n", per_cu);
        (void)hipGetLastError();
        grid = cus;
    }
    if (grid < 0) return;
    if (hipMemsetAsync((char*)d_ws + WS_CTL, 0, CTL_ZERO_BYTES, stream) != hipSuccess) return;
    Args a{};
    for (int i = 0; i < 21; ++i) a.in[i] = (const float*)d_in[i];
    a.out = (float*)d_out; a.ws = (unsigned char*)d_ws;
    hipLaunchKernelGGL(hymba_fwd, dim3(grid), dim3(NWAVES * 64), LDS_BYTES, stream, a);
}
```

```cpp
#include <hip/hip_runtime.h>
#include <cstdio>
#include <cstdint>

namespace pg8 {
#define PG8_LAS __attribute__((address_space(3)))
typedef unsigned short bf16_t;
typedef short bf16x8 __attribute__((ext_vector_type(8)));
typedef float f32x4 __attribute__((ext_vector_type(4)));
typedef unsigned u32x4 __attribute__((ext_vector_type(4)));
constexpr int BM = 256, BK = 64, HALF = 128, HTB = HALF * BK * 2, STAGE_BYTES = 8 * HTB, NXCD = 8, WGM = 8;

__host__ __device__ __forceinline__ int lds_byte(int r, int c) { const int st = (r >> 4) * 2 + (c >> 5), rr = r & 15, cc = c & 31, ob = rr * 64 + cc * 2; return st * 1024 + (ob ^ (((ob >> 9) & 1) << 5)); }
__host__ __device__ __forceinline__ void stage_rc(int b, int& R, int& C) { const int st = b / 1024, sb = b % 1024, swz = sb ^ (((sb >> 9) & 1) << 5); R = (st >> 1) * 16 + swz / 64; C = (st & 1) * 32 + (swz % 64) / 2; }
__host__ __device__ __forceinline__ int perm32(int rho) { const int n = rho >> 4, i = rho & 15; return 8 * (i >> 2) + 4 * n + (i & 3); }

struct Unit { int pm, pn, e, rb, cnt; };

__device__ __forceinline__ bool static_order(int i, int G, int c, int nM, int nN, int& pm, int& pn) {
    const int nwg = nM * nN; const long L = (long)i * G + c; if (L >= nwg) return false;
    int wgid = (int)L; { const int q = nwg / NXCD, r = nwg % NXCD, xcd = wgid % NXCD, off = wgid / NXCD; wgid = (xcd < r ? xcd * (q + 1) : r * (q + 1) + (xcd - r) * q) + off; }
    const int nig = WGM * nN, gid = wgid / nig, fm = gid * WGM, gsz = (nM - fm) < WGM ? (nM - fm) : WGM;
    pm = fm + ((wgid % nig) % gsz); pn = (wgid % nig) / gsz; return true;
}

__device__ __forceinline__ unsigned cvt_pk_bf16(float lo, float hi) { unsigned r; asm volatile("v_cvt_pk_bf16_f32 %0, %1, %2" : "=v"(r) : "v"(lo), "v"(hi)); return r; }

typedef int i32x8 __attribute__((ext_vector_type(8)));
typedef int i32x4v __attribute__((ext_vector_type(4)));
template <class Epi, class Sched, bool FP8, bool ALIGN = true>
__device__ __forceinline__ void gemm_phase(PG8_LAS unsigned char* lds, PG8_LAS unsigned char* epi, const char* Abase, const int rp, const Sched& S, const Epi& E) {
    int tid = threadIdx.x; asm volatile("" : "+v"(tid));
    const int wid = __builtin_amdgcn_readfirstlane(tid >> 6), lane = tid & 63, wr = wid >> 2, wc = wid & 3, fr = lane & 15, fq = lane >> 4;
    const int nt = rp / 128;
    int RA[2]; unsigned CA2[2], voffB[2];
#pragma unroll
    for (int i = 0; i < 2; ++i) { int R, C; stage_rc(tid * 16 + i * 8192, R, C); const int Rb = Epi::PERM ? ((R & ~31) + perm32(R & 31)) : R;
        RA[i] = R; CA2[i] = (unsigned)C * 2u; voffB[i] = (unsigned)(Rb * rp + C * 2); }
    const size_t kstep = (size_t)(BK * 2);
    const size_t hstepB = (size_t)HALF * rp;
    const unsigned ldsw = (unsigned)wid * 1024u;
    const int aoff = lds_byte(wr * 64 + fr, fq * 8), boff = lds_byte(wc * 32 + fr, fq * 8);
#define PG8_SA(b, h) (((b) * 2 + (h)) * HTB)
#define PG8_SB(b, h) ((4 + (b) * 2 + (h)) * HTB)
#define PG8_STAGE(bufoff, gbase, voff) do { _Pragma("unroll") for (int _i = 0; _i < 2; ++_i) { unsigned _vo = (voff)[_i]; asm volatile("" : "+v"(_vo));   \
        __builtin_amdgcn_global_load_lds((const unsigned*)((const char*)(gbase) + _vo), (PG8_LAS unsigned*)(lds + (bufoff) + ldsw + _i * 8192), 16, 0, 0); } } while (0)
#define PG8_LDA(dst, b, h) do { _Pragma("unroll") for (int m = 0; m < 4; ++m) _Pragma("unroll") for (int k = 0; k < 2; ++k) dst[m][k] = *(const PG8_LAS bf16x8*)(lds + PG8_SA(b, h) + aoff + m * 2048 + k * 1024); } while (0)
#define PG8_LDB(dst, b, h) do { _Pragma("unroll") for (int n = 0; n < 2; ++n) _Pragma("unroll") for (int k = 0; k < 2; ++k) dst[n][k] = *(const PG8_LAS bf16x8*)(lds + PG8_SB(b, h) + boff + n * 2048 + k * 1024); } while (0)
#define PG8_CAT8(x) __builtin_shufflevector(__builtin_bit_cast(i32x4v, x[0]), __builtin_bit_cast(i32x4v, x[1]), 0, 1, 2, 3, 4, 5, 6, 7)
#define PG8_MMA_(ai, bj, At, Bt, Z) do { __builtin_amdgcn_s_setprio(1); \
        if constexpr (FP8) { _Pragma("unroll") for (int m = 0; m < 4; ++m) _Pragma("unroll") for (int n = 0; n < 2; ++n) \
            { const i32x8 _b = PG8_CAT8(Bt[n]), _a = PG8_CAT8(At[m]);   \
              if (Z) asm volatile("v_mfma_f32_16x16x128_f8f6f4 %0, %1, %2, 0" : "=&v"(acc[ai][bj][m][n]) : "v"(_b), "v"(_a)); \
              else asm volatile("v_mfma_f32_16x16x128_f8f6f4 %0, %1, %2, %0" : "+v"(acc[ai][bj][m][n]) : "v"(_b), "v"(_a)); } } \
        else { _Pragma("unroll") for (int m = 0; m < 4; ++m) _Pragma("unroll") for (int n = 0; n < 2; ++n) _Pragma("unroll") for (int k = 0; k < 2; ++k) \
            acc[ai][bj][m][n] = __builtin_amdgcn_mfma_f32_16x16x32_bf16(Bt[n][k], At[m][k], acc[ai][bj][m][n], 0, 0, 0); } \
        __builtin_amdgcn_s_setprio(0); } while (0)
#define PG8_MMA(ai, bj, At, Bt) PG8_MMA_(ai, bj, At, Bt, false)
#define PG8_MMA0(ai, bj, At, Bt) do { if (FP8 && first) PG8_MMA_(ai, bj, At, Bt, true); else PG8_MMA_(ai, bj, At, Bt, false); } while (0)
#define PG8_WAIT_V(n) asm volatile("s_waitcnt vmcnt(" #n ")" ::: "memory")
#define PG8_WAIT_L(n) asm volatile("s_waitcnt lgkmcnt(" #n ")" ::: "memory")
#define PG8_BAR __builtin_amdgcn_s_barrier()
#define PG8_SCHED __builtin_amdgcn_sched_barrier(0)
#define PG8_ZERO() do { if constexpr (!FP8) { _Pragma("unroll") for (int a = 0; a < 2; ++a) _Pragma("unroll") for (int b = 0; b < 2; ++b) _Pragma("unroll") for (int m = 0; m < 4; ++m) _Pragma("unroll") for (int n = 0; n < 2; ++n) acc[a][b][m][n] = (f32x4){0.f, 0.f, 0.f, 0.f}; } } while (0)
#define PG8_VA(dst, u) do { _Pragma("unroll") for (int _h = 0; _h < 2; ++_h) _Pragma("unroll") for (int _i = 0; _i < 2; ++_i) dst[_h][_i] = S.a_off(u, _h * HALF + RA[_i]) + CA2[_i]; } while (0)
    Unit cur, nxt; int ui = 0;
    if (!S.next(0, cur)) return;
    f32x4 acc[2][2][4][2];
    PG8_ZERO();
    bf16x8 At[4][2], B0[2][2], B1[2][2];
    unsigned cvA[2][2], nvA[2][2];
    float rs[2][4];
    PG8_VA(cvA, cur);
    const char* cB = S.b_tile(cur);
    const char* cA = Abase + S.a_base(cur);
    E.side(cur, epi, wid, lane);
    PG8_STAGE(PG8_SB(0, 0), cB, voffB); PG8_STAGE(PG8_SB(0, 1), cB + hstepB, voffB); PG8_STAGE(PG8_SA(0, 0), cA, cvA[0]); PG8_STAGE(PG8_SA(0, 1), cA, cvA[1]);
    if (wr == 1) PG8_BAR;
    PG8_WAIT_V(2); PG8_BAR;
    PG8_STAGE(PG8_SB(1, 0), cB + kstep, voffB); PG8_STAGE(PG8_SA(1, 0), cA + kstep, cvA[0]); PG8_STAGE(PG8_SB(1, 1), cB + hstepB + kstep, voffB);
    PG8_WAIT_V(6); PG8_BAR;
    for (;;) {
        const bool has_next = S.next(ui + 1, nxt);
        if constexpr (Sched::GATHER) { if (has_next) S.gather_dma(nxt, epi + ((ui + 1) & 1) * 4096 + 3072, wid, lane); }
        const char* nB = has_next ? S.b_tile(nxt) : cB;
        const char* nA = has_next ? Abase + S.a_base(nxt) : cA;
        PG8_LAS unsigned char* area = epi + (ui & 1) * 4096;
        for (int t = 0; t < nt; t += 2) {
            const bool last = (t == nt - 2), first = (t == 0);
            if constexpr (Epi::MIDSCALE) { if (t == nt / 2) {
#pragma unroll
                for (int a = 0; a < 2; ++a)
#pragma unroll
                    for (int m = 0; m < 4; ++m) rs[a][m] = *(const PG8_LAS float*)(area + 1024 + 4 * (a * 128 + wr * 64 + m * 16 + fr));
#pragma unroll
                for (int a = 0; a < 2; ++a)
#pragma unroll
                    for (int b = 0; b < 2; ++b)
#pragma unroll
                        for (int m = 0; m < 4; ++m)
#pragma unroll
                            for (int n = 0; n < 2; ++n) acc[a][b][m][n] = acc[a][b][m][n] * rs[a][m]; } }
            const char* a1 = cA + (size_t)(t + 1) * kstep;
            const char* a2 = last ? nA : cA + (size_t)(t + 2) * kstep; const char* b2 = last ? nB : cB + (size_t)(t + 2) * kstep;
            const char* a3 = a2 + kstep; const char* b3 = b2 + kstep;
            if constexpr (Sched::GATHER) { if (last) {
#pragma unroll
                for (int h = 0; h < 2; ++h)
#pragma unroll
                    for (int i = 0; i < 2; ++i) nvA[h][i] = has_next ? S.a_fin(nxt, h * HALF + RA[i], *(const PG8_LAS int*)(epi + ((ui + 1) & 1) * 4096 + 3072 + 4 * (h * HALF + RA[i]))) + CA2[i] : cvA[h][i]; } }
            unsigned sA[2][2];
#pragma unroll
            for (int h = 0; h < 2; ++h)
#pragma unroll
                for (int i = 0; i < 2; ++i) sA[h][i] = (Sched::GATHER && last) ? nvA[h][i] : cvA[h][i];
            PG8_LDB(B0, 0, 0); PG8_LDB(B1, 0, 1); PG8_SCHED; PG8_LDA(At, 0, 0); PG8_STAGE(PG8_SA(1, 1), a1, cvA[1]);
            PG8_WAIT_V(8); PG8_WAIT_L(0); PG8_BAR; PG8_MMA0(0, 0, At, B0); PG8_MMA0(0, 1, At, B1); PG8_BAR; PG8_SCHED;
            PG8_LDA(At, 0, 1); PG8_STAGE(PG8_SB(0, 0), b2, voffB); PG8_STAGE(PG8_SB(0, 1), b2 + hstepB, voffB); PG8_STAGE(PG8_SA(0, 0), a2, sA[0]);
            PG8_WAIT_V(8); PG8_WAIT_L(0); PG8_BAR; PG8_MMA0(1, 0, At, B0); PG8_MMA0(1, 1, At, B1); PG8_BAR; PG8_SCHED;
            PG8_LDB(B0, 1, 0); PG8_LDB(B1, 1, 1); PG8_SCHED; PG8_LDA(At, 1, 0); PG8_STAGE(PG8_SA(0, 1), a2, sA[1]);
            PG8_WAIT_V(8); PG8_WAIT_L(0); PG8_BAR; PG8_MMA(0, 0, At, B0); PG8_MMA(0, 1, At, B1); PG8_BAR; PG8_SCHED;
            PG8_LDA(At, 1, 1); PG8_STAGE(PG8_SB(1, 0), b3, voffB); PG8_STAGE(PG8_SB(1, 1), b3 + hstepB, voffB); PG8_STAGE(PG8_SA(1, 0), a3, sA[0]);
            PG8_WAIT_V(8); PG8_WAIT_L(0); PG8_BAR; PG8_MMA(1, 0, At, B0); PG8_MMA(1, 1, At, B1); PG8_BAR; PG8_SCHED;
        }
        if constexpr (ALIGN) { if (wr == 0) PG8_BAR; }
        if constexpr (FP8) asm volatile("s_nop 15\n\ts_nop 15" ::: "memory");
        E(acc, cur, wr, wc, fr, fq, area);
        if (!has_next) break;
        PG8_ZERO();
        cur = nxt; cB = nB; cA = nA; ++ui;
        E.side(cur, epi + (ui & 1) * 4096, wid, lane);
        if constexpr (Sched::GATHER) {
#pragma unroll
            for (int h = 0; h < 2; ++h)
#pragma unroll
                for (int i = 0; i < 2; ++i) cvA[h][i] = nvA[h][i]; }
        if constexpr (ALIGN) { if (wr == 1) PG8_BAR; }
    }
    PG8_WAIT_V(0);
    if constexpr (!ALIGN) { if (wr == 0) PG8_BAR; }
    PG8_BAR;
#undef PG8_SA
#undef PG8_SB
#undef PG8_STAGE
#undef PG8_LDA
#undef PG8_LDB
#undef PG8_MMA
#undef PG8_MMA_
#undef PG8_MMA0
#undef PG8_CAT8
#undef PG8_WAIT_V
#undef PG8_WAIT_L
#undef PG8_BAR
#undef PG8_SCHED
#undef PG8_ZERO
#undef PG8_VA
}
}

constexpr int NWAVES = 8;
constexpr int T = 32768, SEQ = 2048, D = 1024, INW = 1792, NEXP = 32, TOPK = 4;
constexpr int COL_K = 512, COL_V = 640, COL_U = 768;
constexpr int PJW = 1280;
constexpr float RMS_EPS = 1e-5f, LN_EPS = 1e-5f;
constexpr float LOG2E = 1.4426950408889634f;
constexpr float QSCALE = 0.125f * LOG2E;
constexpr int LIST_CAP = 32768;
constexpr int MAX_RB = 544;

constexpr size_t MiB = 1u << 20;
constexpr size_t WS_CTL = 0, CTL_ZERO_BYTES = 16 * 1024;
constexpr size_t WS_WIN = 2 * MiB;
constexpr size_t WS_WOUT = 6 * MiB;
constexpr size_t WS_W1 = 8 * MiB;
constexpr size_t WS_W2 = 136 * MiB;
constexpr size_t WS_XN = 200 * MiB;
constexpr size_t WS_LTOK = 264 * MiB;
constexpr size_t WS_LGATE = 268 * MiB;
constexpr size_t WS_B1P = 272 * MiB;
constexpr size_t WS_RA = 272 * MiB + 512 * 1024;
constexpr size_t WS_WR = 273 * MiB;
constexpr size_t WS_ACT = 274 * MiB;
constexpr size_t WS_PROJ = 546 * MiB;
constexpr size_t WS_MIX = 658 * MiB;
constexpr size_t WS_Y = 546 * MiB;
constexpr size_t WS_XN8 = 674 * MiB;
constexpr size_t WS_END = 802 * MiB;
static_assert(WS_ACT + (size_t)MAX_RB * 256 * 1024 * 2 <= WS_PROJ && WS_MIX + (size_t)T * 1024 * 2 <= WS_END && WS_Y + (size_t)T * 4 * 1024 * 2 <= WS_END, "ws map");
constexpr int CW_BAR = 0;
constexpr int CW_GCNT = 3584;
static_assert((CW_BAR + 3456) * 4 <= (int)CTL_ZERO_BYTES && (CW_GCNT + 32 * 16) * 4 <= (int)CTL_ZERO_BYTES, "control words inside the per-call memset");

constexpr int RING_BYTES = 131072;
constexpr int MISC_OFF = RING_BYTES;
constexpr int TAB_OFF = MISC_OFF + 256;
constexpr int EPI_OFF = RING_BYTES + 2048;
constexpr int P4_G_OFF = EPI_OFF + 8 * 2112;
constexpr int LDS_BYTES = 154624;

#define GAS __attribute__((address_space(1)))
#define LAS __attribute__((address_space(3)))
typedef unsigned short bf16;
typedef unsigned v4u __attribute__((ext_vector_type(4)));
typedef unsigned v2u __attribute__((ext_vector_type(2)));
typedef float f32x4 __attribute__((ext_vector_type(4)));
typedef float f32x2 __attribute__((ext_vector_type(2)));
typedef short bf16x8 __attribute__((ext_vector_type(8)));
typedef short v4i16_t __attribute__((ext_vector_type(4)));
#define LDS_WAIT() asm volatile("s_waitcnt lgkmcnt(0)" ::: "memory")
#define VM_WAIT() asm volatile("s_waitcnt vmcnt(0)" ::: "memory")
__device__ __forceinline__ unsigned pk2(float lo, float hi) { return pg8::cvt_pk_bf16(lo, hi); }
__device__ __forceinline__ unsigned pk4_fp8(float a, float b, float c, float d) { int w = 0; w = __builtin_amdgcn_cvt_pk_fp8_f32(a, b, w, false); w = __builtin_amdgcn_cvt_pk_fp8_f32(c, d, w, true); return (unsigned)w; }
constexpr float W_SCALE = 64.0f, H_SCALE = 8.0f, ACT_SCALE = 4.0f, Y_SCALE = 16.0f;
__device__ __forceinline__ float bf_lo(unsigned w) { return __uint_as_float(w << 16); }
__device__ __forceinline__ float bf_hi(unsigned w) { return __uint_as_float(w & 0xffff0000u); }

#define XB_TMO      128
#define XB_XCNT(j)  (256  + 64 * (j))
#define XB_XSUB(j)  (1280 + 64 * (j))
#define XB_XGEN(j)  (2304 + 64 * (j))
#define XB_TOP      3328
#define XB_TOPGEN   3392
#define XCD_BAR_WORDS 3456
#define XB_SPIN_CAP (1u << 18)

__device__ __forceinline__ unsigned xb_ld(unsigned* p)              { return __hip_atomic_load(p, __ATOMIC_RELAXED, __HIP_MEMORY_SCOPE_AGENT); }
__device__ __forceinline__ unsigned xb_add(unsigned* p, unsigned v) { return __hip_atomic_fetch_add(p, v, __ATOMIC_RELAXED, __HIP_MEMORY_SCOPE_AGENT); }
__device__ __forceinline__ unsigned xb_xcc_id() { return (unsigned)__builtin_amdgcn_s_getreg((3 << 11) | 20) & 0xFu; }
#define XB_SPIN(cond, bar) do { unsigned _sp = 0; while (cond) { __builtin_amdgcn_s_sleep(1); \
    if ((++_sp & 255u) == 0u) { if (xb_ld(&(bar)[XB_TMO])) break; if (_sp > XB_SPIN_CAP) { atomicAdd(&(bar)[XB_TMO], 1u); break; } } } } while (0)

struct XcdBarrier { unsigned* bar; unsigned x; volatile LAS unsigned* st; };

__device__ __forceinline__ XcdBarrier xcd_barrier_post(unsigned* bar, volatile LAS unsigned* st) {
    XcdBarrier b; b.bar = bar; b.x = xb_xcc_id(); b.st = st;
    if (threadIdx.x == 0) (void)xb_add(&bar[XB_XCNT(b.x)], 1u);
    return b;
}
__device__ __forceinline__ void xcd_barrier_complete(unsigned* bar, unsigned x, unsigned& nloc, unsigned& nx) {
    const unsigned G = gridDim.x * gridDim.y * gridDim.z;
    unsigned sum, cnt, mine, sp = 0u;
    for (;;) {
        sum = 0u; cnt = 0u; mine = 0u;
#pragma unroll
        for (unsigned j = 0; j < 16; ++j) { const unsigned c = xb_ld(&bar[XB_XCNT(j)]); sum += c; cnt += (c > 0u) ? 1u : 0u; mine = (j == x) ? c : mine; }
        if (sum == G) break;
        __builtin_amdgcn_s_sleep(1);
        if ((++sp & 255u) == 0u) { if (xb_ld(&bar[XB_TMO])) break; if (sp > XB_SPIN_CAP) { atomicAdd(&bar[XB_TMO], 1u); break; } }
    }
    nloc = mine > 0u ? mine : 1u; nx = cnt > 0u ? cnt : 1u;
}
__device__ __forceinline__ void xcd_barrier(const XcdBarrier& b) {
    asm volatile("s_waitcnt vmcnt(0)" ::: "memory");
    __syncthreads();
    if (threadIdx.x == 0) {
        unsigned* bar = b.bar;
        __builtin_amdgcn_s_waitcnt(0);
        unsigned nloc = b.st[0], nx = b.st[1];
        if (nloc == 0u) { xcd_barrier_complete(bar, b.x, nloc, nx); b.st[0] = nloc; b.st[1] = nx; }
        const unsigned old = xb_add(&bar[XB_XSUB(b.x)], 1u);
        const unsigned gen = old / nloc;
        if (old + 1u == (gen + 1u) * nloc) {
            __builtin_amdgcn_fence(__ATOMIC_RELEASE, "agent");
            asm volatile("s_waitcnt vmcnt(0)" ::: "memory");
            const unsigned og = xb_add(&bar[XB_TOP], 1u);
            const unsigned tg = og / nx;
            if (og + 1u == (tg + 1u) * nx) xb_add(&bar[XB_TOPGEN], 1u);
            else XB_SPIN(xb_ld(&bar[XB_TOPGEN]) == tg, bar);
            __builtin_amdgcn_fence(__ATOMIC_ACQUIRE, "agent");
            xb_add(&bar[XB_XGEN(b.x)], 1u);
            asm volatile("s_waitcnt vmcnt(0)" ::: "memory");
        } else {
            XB_SPIN(xb_ld(&bar[XB_XGEN(b.x)]) == gen, bar);
            __builtin_amdgcn_fence(__ATOMIC_ACQUIRE, "agent");
            asm volatile("s_waitcnt vmcnt(0)" ::: "memory");
        }
    }
    __syncthreads();
}

template <int CTRL, int RMASK> __device__ __forceinline__ float dpp_add(float v) { return v + __builtin_bit_cast(float, __builtin_amdgcn_update_dpp(0, __builtin_bit_cast(int, v), CTRL, RMASK, 0xf, false)); }
__device__ __forceinline__ float wave_sum_dpp(float v) {
    v = dpp_add<0xB1, 0xf>(v); v = dpp_add<0x4E, 0xf>(v); v = dpp_add<0x141, 0xf>(v); v = dpp_add<0x140, 0xf>(v);
    v = dpp_add<0x142, 0xa>(v); v = dpp_add<0x143, 0xc>(v);
    return __builtin_bit_cast(float, __builtin_amdgcn_readlane(__builtin_bit_cast(int, v), 63));
}
__device__ __forceinline__ float wave_sum(float v) {
#pragma unroll
    for (int o = 1; o < 64; o <<= 1) v += __shfl_xor(v, o);
    return v;
}

struct DenseSched {
    static constexpr bool GATHER = false;
    const char* Bt; int nM, nN, G, c, rp, ibeg, iend;
    __device__ __forceinline__ size_t a_base(const pg8::Unit& u) const { return (size_t)u.pm * 256 * (size_t)rp; }
    __device__ __forceinline__ bool next(int i, pg8::Unit& u) const { u.e = 0; u.rb = 0; u.cnt = 0; if (i + ibeg >= iend) return false; return pg8::static_order(i + ibeg, G, c, nM, nN, u.pm, u.pn); }
    __device__ __forceinline__ const char* b_tile(const pg8::Unit& u) const { return Bt + (size_t)u.pn * 256 * rp; }
    __device__ __forceinline__ unsigned a_off(const pg8::Unit&, int r) const { return (unsigned)r * (unsigned)rp; }
    __device__ __forceinline__ int a_raw(const pg8::Unit&, int) const { return 0; }
    __device__ __forceinline__ unsigned a_fin(const pg8::Unit&, int r, int) const { return (unsigned)r * (unsigned)rp; }
};
template <bool GATHER_> struct MoeSched {
    static constexpr bool GATHER = GATHER_;
    const char* Bt; size_t bexp;
    const int* ltok; const LAS int* rbs; const LAS int* cnt; int nM, nN, G, c, rp, nrev;
    __device__ __forceinline__ size_t a_base(const pg8::Unit& u) const { return GATHER_ ? (size_t)0 : (size_t)u.pm * 256 * (size_t)rp; }
    __device__ __forceinline__ bool next(int i, pg8::Unit& u) const {
        const int ii = nrev >= 0 ? nrev - 1 - i : i; if (ii < 0) return false;
        if (!pg8::static_order(ii, G, c, nM, nN, u.pm, u.pn)) return false;
        const int lane = threadIdx.x & 63;
        const int v = (lane < 32) ? rbs[lane + 1] : 0x7fffffff;
        const unsigned long long m = __ballot(v <= u.pm);
        const int e = __builtin_amdgcn_readfirstlane((int)__popcll(m));
        u.e = e; u.rb = u.pm - __builtin_amdgcn_readfirstlane(rbs[e]); u.cnt = __builtin_amdgcn_readfirstlane(cnt[e]);
        return true;
    }
    __device__ __forceinline__ const char* b_tile(const pg8::Unit& u) const { return Bt + (size_t)u.e * bexp + (size_t)u.pn * 256 * rp; }
    __device__ __forceinline__ unsigned a_off(const pg8::Unit& u, int r) const {
        return a_fin(u, r, a_raw(u, r));
    }
    __device__ __forceinline__ int a_raw(const pg8::Unit& u, int r) const { if constexpr (GATHER_) return ltok[u.e * LIST_CAP + u.rb * 256 + r]; else return 0; }
    __device__ __forceinline__ void gather_dma(const pg8::Unit& u, LAS unsigned char* dst, int wid, int lane) const {
        if (wid < 4) __builtin_amdgcn_global_load_lds((const unsigned*)(ltok + (size_t)u.e * LIST_CAP + u.rb * 256 + wid * 64 + lane), (LAS unsigned*)(dst + wid * 256), 4, 0, 0); }
    __device__ __forceinline__ unsigned a_fin(const pg8::Unit& u, int r, int raw) const {
        if constexpr (GATHER_) { const int t4 = (u.rb * 256 + r < u.cnt) ? raw : 0; return (unsigned)(t4 >> 2) * (unsigned)rp; }
        else return (unsigned)r * (unsigned)rp;
    }
};

__device__ __forceinline__ void side_dma(const void* src_lane, LAS unsigned char* dst_wave) { __builtin_amdgcn_global_load_lds((const unsigned*)src_lane, (LAS unsigned*)dst_wave, 4, 0, 0); }

struct EpiProj {
    static constexpr bool PERM = true, MIDSCALE = false;
    bf16* O; const float* bias; const float* rowscale;
    __device__ __forceinline__ void side(const pg8::Unit& u, LAS unsigned char* area, int wid, int lane) const {
        if (wid < 4) side_dma(bias + u.pn * 256 + wid * 64 + lane, area + wid * 256);
        else side_dma(rowscale + u.pm * 256 + (wid - 4) * 64 + lane, area + 1024 + (wid - 4) * 256); }
    __device__ __forceinline__ void operator()(const f32x4 (&acc)[2][2][4][2], const pg8::Unit& u, int wr, int wc, int fr, int fq, const LAS unsigned char* area) const {
        const int row0 = u.pm * 256 + wr * 64 + fr;
        f32x4 bv[2][2];
#pragma unroll
        for (int bj = 0; bj < 2; ++bj)
#pragma unroll
            for (int n = 0; n < 2; ++n) bv[bj][n] = *(const LAS f32x4*)(area + 4 * (wc * 32 + 8 * fq + bj * 128 + 4 * n));
        if (u.pn < 3) {
            const int col0 = u.pn * 256 + wc * 32 + 8 * fq;
            const float sc = (u.pn < 2) ? QSCALE : 1.0f;
#pragma unroll
            for (int ai = 0; ai < 2; ++ai)
#pragma unroll
                for (int m = 0; m < 4; ++m) { bf16* rowp = O + (size_t)(row0 + ai * 128 + m * 16) * PJW + col0;
                    const float rs = *(const LAS float*)(area + 1024 + 4 * (ai * 128 + wr * 64 + m * 16 + fr));
#pragma unroll
                    for (int bj = 0; bj < 2; ++bj) { const f32x4 v0 = (acc[ai][bj][m][0] * rs + bv[bj][0]) * sc, v1 = (acc[ai][bj][m][1] * rs + bv[bj][1]) * sc;
                        v4u w; w.x = pk2(v0[0], v0[1]); w.y = pk2(v0[2], v0[3]); w.z = pk2(v1[0], v1[1]); w.w = pk2(v1[2], v1[3]);
                        *(v4u*)(rowp + bj * 128) = w; } }
        } else {
            const int col0 = COL_U + (u.pn - 3) * 128 + wc * 32 + 8 * fq;
#pragma unroll
            for (int ai = 0; ai < 2; ++ai)
#pragma unroll
                for (int m = 0; m < 4; ++m) { bf16* rowp = O + (size_t)(row0 + ai * 128 + m * 16) * PJW + col0;
                    const float rs = *(const LAS float*)(area + 1024 + 4 * (ai * 128 + wr * 64 + m * 16 + fr));
                    f32x2 uv[4];
#pragma unroll
                    for (int n = 0; n < 2; ++n)
#pragma unroll
                        for (int p = 0; p < 2; ++p) {
                            const f32x2 av = (f32x2){acc[ai][0][m][n][2 * p], acc[ai][0][m][n][2 * p + 1]} * rs + (f32x2){bv[0][n][2 * p], bv[0][n][2 * p + 1]};
                            const f32x2 gv = (f32x2){acc[ai][1][m][n][2 * p], acc[ai][1][m][n][2 * p + 1]} * rs + (f32x2){bv[1][n][2 * p], bv[1][n][2 * p + 1]};
                            const f32x2 z = gv * (-LOG2E);
                            const f32x2 d = (f32x2){__builtin_amdgcn_exp2f(z.x), __builtin_amdgcn_exp2f(z.y)} + 1.0f;
                            uv[2 * n + p] = av * (f32x2){__builtin_amdgcn_rcpf(d.x), __builtin_amdgcn_rcpf(d.y)}; }
                    v4u w; w.x = pk2(uv[0].x, uv[0].y); w.y = pk2(uv[1].x, uv[1].y); w.z = pk2(uv[2].x, uv[2].y); w.w = pk2(uv[3].x, uv[3].y);
                    *(v4u*)rowp = w; }
        }
    }
};
struct EpiRes {
    static constexpr bool PERM = true, MIDSCALE = true;
    const bf16* base; bf16* out; const float* bias; const float* rowscale;
    __device__ __forceinline__ void side(const pg8::Unit& u, LAS unsigned char* area, int wid, int lane) const {
        if (wid < 4) side_dma(bias + u.pn * 256 + wid * 64 + lane, area + wid * 256);
        else side_dma(rowscale + u.pm * 256 + (wid - 4) * 64 + lane, area + 1024 + (wid - 4) * 256); }
    __device__ __forceinline__ void operator()(const f32x4 (&acc)[2][2][4][2], const pg8::Unit& u, int wr, int wc, int fr, int fq, const LAS unsigned char* area) const {
        const int col0 = u.pn * 256 + wc * 32 + 8 * fq;
        f32x4 bv[2][2];
#pragma unroll
        for (int bj = 0; bj < 2; ++bj)
#pragma unroll
            for (int n = 0; n < 2; ++n) bv[bj][n] = *(const LAS f32x4*)(area + 4 * (wc * 32 + 8 * fq + bj * 128 + 4 * n));
#pragma unroll
        for (int ai = 0; ai < 2; ++ai) {
            v4u xr[4][2];
#pragma unroll
            for (int m = 0; m < 4; ++m) { const size_t off = (size_t)(u.pm * 256 + ai * 128 + wr * 64 + m * 16 + fr) * D + col0;
#pragma unroll
                for (int bj = 0; bj < 2; ++bj) xr[m][bj] = *(const v4u*)(base + off + bj * 128); }
            __builtin_amdgcn_sched_barrier(0);
#pragma unroll
            for (int m = 0; m < 4; ++m) { const size_t off = (size_t)(u.pm * 256 + ai * 128 + wr * 64 + m * 16 + fr) * D + col0;
#pragma unroll
                for (int bj = 0; bj < 2; ++bj) { const v4u xw = xr[m][bj];
                    const f32x4 v0 = (f32x4){bf_lo(xw.x), bf_hi(xw.x), bf_lo(xw.y), bf_hi(xw.y)} + acc[ai][bj][m][0] + bv[bj][0], v1 = (f32x4){bf_lo(xw.z), bf_hi(xw.z), bf_lo(xw.w), bf_hi(xw.w)} + acc[ai][bj][m][1] + bv[bj][1];
                    v4u w; w.x = pk2(v0[0], v0[1]); w.y = pk2(v0[2], v0[3]); w.z = pk2(v1[0], v1[1]); w.w = pk2(v1[2], v1[3]);
                    *(v4u*)(out + off + bj * 128) = w; } }
        }
    }
};
struct EpiSwiglu {
    static constexpr bool PERM = true, MIDSCALE = false;
    unsigned char* O; const float* b1p;
    __device__ __forceinline__ void side(const pg8::Unit& u, LAS unsigned char* area, int wid, int lane) const { if (wid < 4) side_dma(b1p + (size_t)u.e * 2048 + u.pn * 256 + wid * 64 + lane, area + wid * 256); }
    __device__ __forceinline__ void operator()(const f32x4 (&acc)[2][2][4][2], const pg8::Unit& u, int wr, int wc, int fr, int fq, const LAS unsigned char* area) const {
        const int row0 = u.pm * 256 + wr * 64 + fr, ocol0 = u.pn * 128 + wc * 32 + 8 * fq;
        f32x4 bg[2], bl[2];
#pragma unroll
        for (int n = 0; n < 2; ++n) { bg[n] = *(const LAS f32x4*)(area + 4 * (wc * 32 + 8 * fq + 4 * n)); bl[n] = *(const LAS f32x4*)(area + 4 * (128 + wc * 32 + 8 * fq + 4 * n)); }
        constexpr float SI = 1.0f / (H_SCALE * W_SCALE);
        const int odd = fq & 1, ocolw = u.pn * 128 + wc * 32 + 8 * (fq & ~1);
#pragma unroll
        for (int ai = 0; ai < 2; ++ai)
#pragma unroll
            for (int j2 = 0; j2 < 2; ++j2) {
                v2u w[2];
#pragma unroll
                for (int mm = 0; mm < 2; ++mm) { const int m = 2 * j2 + mm;
                f32x2 a[4];
#pragma unroll
                for (int n = 0; n < 2; ++n)
#pragma unroll
                    for (int p = 0; p < 2; ++p) {
                        const f32x2 gv = (f32x2){acc[ai][0][m][n][2 * p], acc[ai][0][m][n][2 * p + 1]} * SI + (f32x2){bg[n][2 * p], bg[n][2 * p + 1]};
                        const f32x2 lv = (f32x2){acc[ai][1][m][n][2 * p], acc[ai][1][m][n][2 * p + 1]} * SI + (f32x2){bl[n][2 * p], bl[n][2 * p + 1]};
                        const f32x2 gg = (f32x2){fminf(gv.x, 7.0f), fminf(gv.y, 7.0f)};
                        const f32x2 ll = (f32x2){__builtin_amdgcn_fmed3f(lv.x, -7.0f, 7.0f), __builtin_amdgcn_fmed3f(lv.y, -7.0f, 7.0f)};
                        const f32x2 z = gg * (-1.702f * LOG2E);
                        const f32x2 d = (f32x2){__builtin_amdgcn_exp2f(z.x), __builtin_amdgcn_exp2f(z.y)} + 1.0f;
                        const f32x2 r = (f32x2){__builtin_amdgcn_rcpf(d.x), __builtin_amdgcn_rcpf(d.y)};
                        a[2 * n + p] = (gg * r) * (ll * ACT_SCALE + ACT_SCALE); }
                w[mm].x = pk4_fp8(a[0].x, a[0].y, a[1].x, a[1].y); w[mm].y = pk4_fp8(a[2].x, a[2].y, a[3].x, a[3].y); }
                const auto rx = __builtin_amdgcn_permlane16_swap(w[0].x, w[1].x, false, false), ry = __builtin_amdgcn_permlane16_swap(w[0].y, w[1].y, false, false);
                v4u o; o.x = rx[0]; o.y = ry[0]; o.z = rx[1]; o.w = ry[1];
                *(v4u*)(O + (size_t)(row0 + ai * 128 + (2 * j2 + odd) * 16) * 1024 + ocolw) = o; }
    }
};
struct EpiMoeOut {
    static constexpr bool PERM = true, MIDSCALE = false;
    unsigned char* Y; const float* b2; const int* ltok; const float* lgate;
    __device__ __forceinline__ void side(const pg8::Unit& u, LAS unsigned char* area, int wid, int lane) const {
        if (wid < 4) { side_dma(b2 + (size_t)u.e * 1024 + u.pn * 256 + wid * 64 + lane, area + wid * 256); side_dma(ltok + (size_t)u.e * LIST_CAP + u.rb * 256 + wid * 64 + lane, area + 1024 + wid * 256); }
        else side_dma(lgate + (size_t)u.e * LIST_CAP + u.rb * 256 + (wid - 4) * 64 + lane, area + 2048 + (wid - 4) * 256); }
    __device__ __forceinline__ void operator()(const f32x4 (&acc)[2][2][4][2], const pg8::Unit& u, int wr, int wc, int fr, int fq, const LAS unsigned char* area) const {
        const int col0 = u.pn * 256 + wc * 32 + 8 * fq;
        f32x4 bv[2][2];
#pragma unroll
        for (int bj = 0; bj < 2; ++bj)
#pragma unroll
            for (int n = 0; n < 2; ++n) bv[bj][n] = *(const LAS f32x4*)(area + 4 * (wc * 32 + 8 * fq + bj * 128 + 4 * n));
        const int odd = fq & 1, colw = u.pn * 256 + wc * 32 + 8 * (fq & ~1);
#pragma unroll
        for (int ai = 0; ai < 2; ++ai)
#pragma unroll
            for (int j2 = 0; j2 < 2; ++j2) {
                int t4[2]; float gt[2]; bool ok[2];
#pragma unroll
                for (int mm = 0; mm < 2; ++mm) { const int r = ai * 128 + wr * 64 + (2 * j2 + mm) * 16 + fr;
                    t4[mm] = *(const LAS int*)(area + 1024 + 4 * r); gt[mm] = *(const LAS float*)(area + 2048 + 4 * r) * Y_SCALE; ok[mm] = (u.rb * 256 + r < u.cnt); }
                const int t4s = odd ? t4[1] : t4[0]; const bool oks = odd ? ok[1] : ok[0];
#pragma unroll
                for (int bj = 0; bj < 2; ++bj) {
                    v2u w[2];
#pragma unroll
                    for (int mm = 0; mm < 2; ++mm) { const int m = 2 * j2 + mm;
                        const f32x4 v0 = (acc[ai][bj][m][0] * (1.0f / (ACT_SCALE * W_SCALE)) + bv[bj][0]) * gt[mm], v1 = (acc[ai][bj][m][1] * (1.0f / (ACT_SCALE * W_SCALE)) + bv[bj][1]) * gt[mm];
                        w[mm].x = pk4_fp8(v0[0], v0[1], v0[2], v0[3]); w[mm].y = pk4_fp8(v1[0], v1[1], v1[2], v1[3]); }
                    const auto rx = __builtin_amdgcn_permlane16_swap(w[0].x, w[1].x, false, false), ry = __builtin_amdgcn_permlane16_swap(w[0].y, w[1].y, false, false);
                    v4u o; o.x = rx[0]; o.y = ry[0]; o.z = rx[1]; o.w = ry[1];
                    if (oks) *(v4u*)(Y + (size_t)t4s * 1024 + colw + bj * 128) = o; } }
    }
};

__host__ __device__ __forceinline__ int win_row(int c) { if (c < 768) return c; const int cc = c - 768, ch = cc & 511; return 768 + (ch >> 7) * 256 + ((cc >> 9) & 1) * 128 + (ch & 127); }
template <int ESZ, int MODE  >
__device__ __forceinline__ void p0_item(const float* W, int N, unsigned char* WT, size_t rowpitch, LAS unsigned* scr, int kb, int nb, int lane, float scale, const float* kscale = nullptr, const float* kscale_hi = nullptr) {
    constexpr int KT = (ESZ == 2) ? 64 : 128, NT = (ESZ == 2) ? 64 : 32, LPR = NT / 4;
    const int k0 = KT * kb, n0 = NT * nb, lg = lane / LPR, nc = lane % LPR;
    const float* src = W + (size_t)(k0 + 16 * lg) * N + n0 + 4 * nc;
    f32x4 v[16];
#pragma unroll
    for (int i = 0; i < 16; ++i) v[i] = *(const f32x4*)(src + (size_t)i * N);
    if (kscale) {
#pragma unroll
        for (int i = 0; i < 16; ++i) { const int k = k0 + 16 * lg + i; v[i] = v[i] * ((kscale_hi && k >= 512) ? kscale_hi[k - 512] : kscale[k]); } }
#pragma unroll
    for (int e = 0; e < 4; ++e) {
        LAS unsigned* row = scr + (4 * nc + e) * 36;
        if (ESZ == 2) {
            v4u a, b;
            a.x = pk2(v[0][e] * scale, v[1][e] * scale); a.y = pk2(v[2][e] * scale, v[3][e] * scale); a.z = pk2(v[4][e] * scale, v[5][e] * scale); a.w = pk2(v[6][e] * scale, v[7][e] * scale);
            b.x = pk2(v[8][e] * scale, v[9][e] * scale); b.y = pk2(v[10][e] * scale, v[11][e] * scale); b.z = pk2(v[12][e] * scale, v[13][e] * scale); b.w = pk2(v[14][e] * scale, v[15][e] * scale);
            *(LAS v4u*)(row + 8 * lg) = a; *(LAS v4u*)(row + 8 * lg + 4) = b;
        } else {
            v4u a;
            a.x = pk4_fp8(v[0][e] * scale, v[1][e] * scale, v[2][e] * scale, v[3][e] * scale); a.y = pk4_fp8(v[4][e] * scale, v[5][e] * scale, v[6][e] * scale, v[7][e] * scale);
            a.z = pk4_fp8(v[8][e] * scale, v[9][e] * scale, v[10][e] * scale, v[11][e] * scale); a.w = pk4_fp8(v[12][e] * scale, v[13][e] * scale, v[14][e] * scale, v[15][e] * scale);
            *(LAS v4u*)(row + 4 * lg) = a;
        }
    }
    LDS_WAIT(); asm volatile("" ::: "memory");
    const int c = lane & 7;
#pragma unroll
    for (int j = 0; j < NT / 8; ++j) { const int n = (lane >> 3) + 8 * j; const v4u o = *(const LAS v4u*)(scr + n * 36 + 4 * c);
        const int col = n0 + n; const int row = (MODE == 1) ? ((col & ~255) + 128 * (col & 1) + ((col >> 1) & 127)) : (MODE == 2) ? win_row(col) : col;
        *(GAS v4u*)(WT + (size_t)row * rowpitch + (size_t)k0 * ESZ + 16 * c) = o; }
    LDS_WAIT(); asm volatile("" ::: "memory");
}

struct W8Item { const float* src; unsigned char* dst; int N, k0, n0, mode; };
__device__ __forceinline__ W8Item w8_item(int r, const float* w1, const float* w2, unsigned char* W1_t, unsigned char* W2_t) {
    W8Item it;
    if (r < 32 * 8 * 64) { const int e = r >> 9, q = r & 511; it.src = w1 + (size_t)e * 1024 * 2048; it.dst = W1_t + (size_t)e * 2048 * 1024; it.N = 2048; it.k0 = 128 * (q >> 6); it.n0 = 32 * (q & 63); it.mode = 1; }
    else { r -= 32 * 8 * 64; const int e = r >> 8, q = r & 255; it.src = w2 + (size_t)e * 1024 * 1024; it.dst = W2_t + (size_t)e * 1024 * 1024; it.N = 1024; it.k0 = 128 * (q >> 5); it.n0 = 32 * (q & 31); it.mode = 0; }
    return it;
}
__device__ __forceinline__ void w8_load(const W8Item& it, f32x4 (&v)[16], int lane) {
    const float* src = it.src + (size_t)(it.k0 + 16 * (lane >> 3)) * it.N + it.n0 + 4 * (lane & 7);
#pragma unroll
    for (int i = 0; i < 16; ++i) v[i] = __builtin_nontemporal_load((const f32x4*)(src + (size_t)i * it.N));
}
__device__ __forceinline__ void w8_store(const W8Item& it, const f32x4 (&v)[16], LAS unsigned* scr, int lane) {
    const int lg = lane >> 3, nc = lane & 7;
#pragma unroll
    for (int e = 0; e < 4; ++e) { v4u a;
        a.x = pk4_fp8(v[0][e] * W_SCALE, v[1][e] * W_SCALE, v[2][e] * W_SCALE, v[3][e] * W_SCALE); a.y = pk4_fp8(v[4][e] * W_SCALE, v[5][e] * W_SCALE, v[6][e] * W_SCALE, v[7][e] * W_SCALE);
        a.z = pk4_fp8(v[8][e] * W_SCALE, v[9][e] * W_SCALE, v[10][e] * W_SCALE, v[11][e] * W_SCALE); a.w = pk4_fp8(v[12][e] * W_SCALE, v[13][e] * W_SCALE, v[14][e] * W_SCALE, v[15][e] * W_SCALE);
        *(LAS v4u*)(scr + (4 * nc + e) * 36 + 4 * lg) = a; }
    LDS_WAIT(); asm volatile("" ::: "memory");
    const int c = lane & 7;
#pragma unroll
    for (int j = 0; j < 4; ++j) { const int n = (lane >> 3) + 8 * j; const v4u o = *(const LAS v4u*)(scr + n * 36 + 4 * c);
        const int col = it.n0 + n; const int row = it.mode ? ((col & ~255) + 128 * (col & 1) + ((col >> 1) & 127)) : col;
        *(GAS v4u*)(it.dst + (size_t)row * 1024 + it.k0 + 16 * c) = o; }
    LDS_WAIT(); asm volatile("" ::: "memory");
}

struct Args { const float* in[21]; float* out; unsigned char* ws; };

__global__ void __launch_bounds__(NWAVES * 64, 2) hymba_fwd(Args args) {
    extern __shared__ __attribute__((aligned(16))) unsigned char lds_raw[];
    LAS unsigned char* lds = (LAS unsigned char*)lds_raw;
    volatile LAS unsigned* MISC = (volatile LAS unsigned*)(lds + MISC_OFF);
    LAS int* TAB = (LAS int*)(lds + TAB_OFF);
    LAS int* t_rbs = TAB; LAS int* t_cnt = TAB + 40; LAS int* t_lcnt = TAB + 72; LAS int* t_gbase = TAB + 104;
#define PHASE_IDS() int tid = threadIdx.x; asm volatile("" : "+v"(tid)); const int lane = tid & 63, wave = __builtin_amdgcn_readfirstlane(tid >> 6); (void)lane; (void)wave
    const int G = gridDim.x;
    const int vcu = (G % 8 == 0) ? ((int)blockIdx.x % 8) * (G / 8) + (int)blockIdx.x / 8 : (int)blockIdx.x;

    const float* x = args.in[0]; const float* g_mix = args.in[1]; const float* w_in = args.in[2]; const float* b_in = args.in[3];
    const float* sinks = args.in[4]; const float* w_dw = args.in[5]; const float* b_dw = args.in[6]; const float* ln_g = args.in[7]; const float* ln_b = args.in[8];
    const float* g_attn = args.in[9]; const float* g_conv = args.in[10]; const float* w_out = args.in[11]; const float* b_out = args.in[12];
    const float* g_ffn = args.in[13]; const float* w_router = args.in[14]; const float* b_router = args.in[15];
    const float* w1 = args.in[16]; const float* b1 = args.in[17]; const float* w2 = args.in[18]; const float* b2 = args.in[19]; const float* g_final = args.in[20];
    float* out = args.out; unsigned char* ws = args.ws;
    unsigned* ctl = (unsigned*)(ws + WS_CTL);
    bf16* Win_t = (bf16*)(ws + WS_WIN); bf16* Wout_t = (bf16*)(ws + WS_WOUT); unsigned char* W1_t = ws + WS_W1; unsigned char* W2_t = ws + WS_W2; unsigned char* XN8 = ws + WS_XN8; bf16* X1B = (bf16*)(ws + WS_XN);
    bf16* XN = (bf16*)(ws + WS_XN); int* ltok = (int*)(ws + WS_LTOK); float* lgate = (float*)(ws + WS_LGATE); float* b1p = (float*)(ws + WS_B1P);
    float* RA = (float*)(ws + WS_RA); float* RS = RA + T; float* BINP = RS + T + 256;   bf16* WrHi = (bf16*)(ws + WS_WR); bf16* WrLo = WrHi + 32 * 1024;
    unsigned char* ACT = ws + WS_ACT; bf16* PROJ = (bf16*)(ws + WS_PROJ); bf16* MIX = (bf16*)(ws + WS_MIX); unsigned char* YB = ws + WS_Y;
    unsigned* gcnt = ctl + CW_GCNT;

    for (int u = threadIdx.x; u < (LDS_BYTES - MISC_OFF) / 4; u += NWAVES * 64) ((LAS unsigned*)(lds + MISC_OFF))[u] = 0u;
    __syncthreads();
    XcdBarrier bar = xcd_barrier_post(ctl + CW_BAR, MISC + 8);

    {
        PHASE_IDS();
        LAS unsigned* scr = (LAS unsigned*)(lds + wave * 16384);
        const int gw = vcu * NWAVES + wave, NGW = G * NWAVES;
        constexpr int I_IN = 16 * 28, I_OUT = 16 * 16;
        for (int it = gw; it < I_IN + I_OUT; it += NGW) {
            int r = it;
            if (r < I_IN) { p0_item<2, 2>(w_in, INW, (unsigned char*)Win_t, 2048, scr, r / 28, r % 28, lane, 1.0f, g_mix); continue; } r -= I_IN;
            p0_item<2, 0>(w_out, 1024, (unsigned char*)Wout_t, 2048, scr, r >> 4, r & 15, lane, 1.0f, g_attn, g_conv);
        }
        for (int m = 2 * gw; m < T; m += 2 * NGW) {
            const GAS f32x4* xr = (const GAS f32x4*)(x + (size_t)m * D) + lane;
            f32x4 v[2][4]; float s[2] = {0.f, 0.f};
#pragma unroll
            for (int q = 0; q < 2; ++q)
#pragma unroll
                for (int j = 0; j < 4; ++j) v[q][j] = __builtin_nontemporal_load(xr + q * 256 + 64 * j);
#pragma unroll
            for (int q = 0; q < 2; ++q)
#pragma unroll
                for (int j = 0; j < 4; ++j) s[q] += (v[q][j].x * v[q][j].x + v[q][j].y * v[q][j].y) + (v[q][j].z * v[q][j].z + v[q][j].w * v[q][j].w);
#pragma unroll
            for (int q = 0; q < 2; ++q) {
                const float rstd = 1.0f / sqrtf(wave_sum(s[q]) * (1.0f / D) + RMS_EPS);
                if (lane == 0) RS[m + q] = rstd;
                GAS v2u* o8 = (GAS v2u*)(XN + (size_t)(m + q) * D) + lane;
#pragma unroll
                for (int j = 0; j < 4; ++j) { v2u o; o.x = pk2(v[q][j].x, v[q][j].y); o.y = pk2(v[q][j].z, v[q][j].w); o8[64 * j] = o; }
            }
        }
        const int gt = vcu * (NWAVES * 64) + tid, NGT = G * NWAVES * 64;
        for (int i = gt; i < INW; i += NGT) BINP[win_row(i)] = b_in[i];
        for (int i = gt; i < 32 * 2048; i += NGT) { const int e = i >> 11, col = i & 2047; const int row = (col & ~255) + 128 * (col & 1) + ((col >> 1) & 127); b1p[e * 2048 + row] = b1[i]; }
        for (int i = gt; i < 32 * 1024; i += NGT) { const int e = i >> 10, k = i & 1023; const float v = w_router[k * 32 + e];
            const unsigned h = pk2(v, 0.f) & 0xffffu; const float lo = v - __uint_as_float(h << 16);
            const int fi = ((((e >> 4) * 32 + (k >> 5)) * 64 + 16 * ((k >> 3) & 3) + (e & 15)) * 8) + (k & 7);
            WrHi[fi] = (bf16)h; WrLo[fi] = (bf16)(pk2(lo, 0.f) & 0xffffu); }
    }
    xcd_barrier(bar);

    {
        const int grp = ((int)blockIdx.x >> 3) & 3;
        EpiProj E{PROJ, BINP, RS};
        {
            DenseSched S{(const char*)Win_t, T / 256, INW / 256, G, (int)blockIdx.x, 2048, 0, grp};
            pg8::gemm_phase<EpiProj, DenseSched, false>(lds, lds + EPI_OFF, (const char*)XN, 2048, S, E);
        }
        {
            PHASE_IDS();
            __syncthreads();
            LAS unsigned* scr = (LAS unsigned*)(lds + wave * 16384);
            const int gw = vcu * NWAVES + wave, NGW = G * NWAVES;
            constexpr int NIT_ALL = 16384;
            int it = gw, NIT = NIT_ALL, NGW_ = NGW;
            if (G == 256) { const int c = (int)blockIdx.x; NGW_ = 1024;
                if (c >= 128) { it = (c - 128) * NWAVES + wave; NIT = 10240; } else { it = 10240 + c * NWAVES + wave; NIT = NIT_ALL; } }
            f32x4 va[16], vb[16];
            W8Item ia = w8_item(24575 - (it < NIT ? it : 0), w1, w2, W1_t, W2_t), ib = ia;
            if (it < NIT) w8_load(ia, va, lane);
            while (it < NIT) {
                const int itb = it + NGW_;
                if (itb < NIT) { ib = w8_item(24575 - itb, w1, w2, W1_t, W2_t); w8_load(ib, vb, lane); }
                w8_store(ia, va, scr, lane);
                if (itb >= NIT) break;
                const int ita = itb + NGW_;
                if (ita < NIT) { ia = w8_item(24575 - ita, w1, w2, W1_t, W2_t); w8_load(ia, va, lane); }
                w8_store(ib, vb, scr, lane);
                it = ita;
            }
            __syncthreads();
        }
        {
            DenseSched S{(const char*)Win_t, T / 256, INW / 256, G, (int)blockIdx.x, 2048, grp, 1 << 30};
            pg8::gemm_phase<EpiProj, DenseSched, false>(lds, lds + EPI_OFF, (const char*)XN, 2048, S, E);
        }
    }
    xcd_barrier(bar);

    for (int unit = blockIdx.x; unit < T / 128; unit += G) {
        const int b = unit >> 4, n = unit & 15, t0 = b * SEQ + n * 128;
        {
            PHASE_IDS();
            constexpr int KOFF = 0, VOFF = 36864;
            const int i16 = lane & 15, g = lane >> 4;
            const int vq = i16 >> 2, vp = i16 & 3;
            float ssq = 0.f;
            const bf16* qrow = PROJ + (size_t)(t0 + 16 * wave + i16) * PJW + 8 * g;
            bf16* orow = MIX + (size_t)(t0 + 16 * wave + i16) * D + 4 * g;
            bf16x8 q0n = *(const bf16x8*)qrow, q1n = *(const bf16x8*)(qrow + 32);
            v4u kpre[4], vpre[4];
#define KV_LOAD(kvh) do { _Pragma("unroll") for (int c4 = 0; c4 < 4; ++c4) { const int c = tid + 512 * c4, row = c >> 3, ch = c & 7; kpre[c4] = (v4u){0u, 0u, 0u, 0u}; vpre[c4] = kpre[c4]; \
                if (n > 0 || row >= 128) { const bf16* p = PROJ + (size_t)(t0 - 128 + row) * PJW + (kvh) * 64 + ch * 8; kpre[c4] = *(const v4u*)(p + COL_K); vpre[c4] = *(const v4u*)(p + COL_V); } } } while (0)
#define KV_WRITE() do { _Pragma("unroll") for (int c4 = 0; c4 < 4; ++c4) { const int c = tid + 512 * c4, row = c >> 3, ch = c & 7; \
                *(LAS v4u*)(lds + KOFF + row * 144 + ch * 16) = kpre[c4]; *(LAS v4u*)(lds + VOFF + row * 144 + ch * 16) = vpre[c4]; } } while (0)
            KV_LOAD(0);
            __syncthreads();
            KV_WRITE();
            KV_LOAD(1);
            __syncthreads();
            for (int h = 0; h < 8; ++h) {
                if (h == 4) { __syncthreads(); KV_WRITE(); __syncthreads(); }
                const bf16x8 q0 = q0n, q1 = q1n;
                if (h < 7) { q0n = *(const bf16x8*)(qrow + (h + 1) * 64); q1n = *(const bf16x8*)(qrow + (h + 1) * 64 + 32); }
                f32x4 st[9];
#pragma unroll
                for (int j = 0; j < 9; ++j) { const LAS unsigned char* kp = lds + KOFF + (16 * (wave + j) + i16) * 144 + 16 * g;
                    const bf16x8 k0 = *(const LAS bf16x8*)kp, k1 = *(const LAS bf16x8*)(kp + 64);
                    st[j] = __builtin_amdgcn_mfma_f32_16x16x32_bf16(k0, q0, (f32x4){0.f, 0.f, 0.f, 0.f}, 0, 0, 0);
                    st[j] = __builtin_amdgcn_mfma_f32_16x16x32_bf16(k1, q1, st[j], 0, 0, 0); }
                const float NEG = -INFINITY;
#pragma unroll
                for (int j = 0; j < 9; ++j) { const bool dead = (n == 0) && (wave + j < 8);
#pragma unroll
                    for (int r = 0; r < 4; ++r) { const int kr = 4 * g + r; bool ok = !dead; if (j == 0) ok = ok && (kr > i16); if (j == 8) ok = ok && (kr <= i16); if (!ok) st[j][r] = NEG; } }
                const float sink2 = sinks[h] * LOG2E;
                float mx = sink2;
#pragma unroll
                for (int j = 0; j < 9; ++j) mx = fmaxf(fmaxf(mx, fmaxf(st[j][0], st[j][1])), fmaxf(st[j][2], st[j][3]));
                mx = fmaxf(mx, __shfl_xor(mx, 16)); mx = fmaxf(mx, __shfl_xor(mx, 32));
                float ls = 0.f;
#pragma unroll
                for (int j = 0; j < 9; ++j)
#pragma unroll
                    for (int r = 0; r < 4; ++r) { st[j][r] = __builtin_amdgcn_exp2f(st[j][r] - mx); ls += st[j][r]; }
                ls += __shfl_xor(ls, 16); ls += __shfl_xor(ls, 32);
                ls += __builtin_amdgcn_exp2f(sink2 - mx);
                const float inv = 1.0f / ls;
                bf16x8 pf[5];
#pragma unroll
                for (int kk = 0; kk < 5; ++kk) { v4u w; w.x = pk2(st[2 * kk][0], st[2 * kk][1]); w.y = pk2(st[2 * kk][2], st[2 * kk][3]);
                    if (kk < 4) { w.z = pk2(st[2 * kk + 1][0], st[2 * kk + 1][1]); w.w = pk2(st[2 * kk + 1][2], st[2 * kk + 1][3]); } else { w.z = 0u; w.w = 0u; }
                    pf[kk] = __builtin_bit_cast(bf16x8, w); }
                v2u ow[4];
#pragma unroll
                for (int dt = 0; dt < 4; ++dt) { f32x4 o = (f32x4){0.f, 0.f, 0.f, 0.f};
#pragma unroll
                    for (int kk = 0; kk < 5; ++kk) { const int kta = wave + 2 * kk, ktb = (kk < 4) ? wave + 2 * kk + 1 : wave + 8;
                        const LAS unsigned char* pa = lds + VOFF + (16 * kta + 4 * g + vq) * 144 + (16 * dt + 4 * vp) * 2;
                        const LAS unsigned char* pb = lds + VOFF + (16 * ktb + 4 * g + vq) * 144 + (16 * dt + 4 * vp) * 2;
                        const v4i16_t va = __builtin_amdgcn_ds_read_tr16_b64_v4i16((LAS v4i16_t*)pa), vb = __builtin_amdgcn_ds_read_tr16_b64_v4i16((LAS v4i16_t*)pb);
                        const bf16x8 vf = (bf16x8){va[0], va[1], va[2], va[3], vb[0], vb[1], vb[2], vb[3]};
                        o = __builtin_amdgcn_mfma_f32_16x16x32_bf16(vf, pf[kk], o, 0, 0, 0); }
                    o = o * inv; ssq += (o[0] * o[0] + o[1] * o[1]) + (o[2] * o[2] + o[3] * o[3]);
                    ow[dt].x = pk2(o[0], o[1]); ow[dt].y = pk2(o[2], o[3]); }
#pragma unroll
                for (int dp = 0; dp < 2; ++dp) {
                    const auto rx = __builtin_amdgcn_permlane16_swap(ow[2 * dp].x, ow[2 * dp + 1].x, false, false), ry = __builtin_amdgcn_permlane16_swap(ow[2 * dp].y, ow[2 * dp + 1].y, false, false);
                    v4u o4; o4.x = rx[0]; o4.y = ry[0]; o4.z = rx[1]; o4.w = ry[1];
                    *(v4u*)(orow - 4 * g + h * 64 + 16 * (2 * dp + (g & 1)) + 4 * (g & ~1)) = o4; }
            }
#undef KV_LOAD
#undef KV_WRITE
            ssq += __shfl_xor(ssq, 16); ssq += __shfl_xor(ssq, 32);
            if (g == 0) RA[t0 + 16 * wave + i16] = 1.0f / sqrtf(ssq * (1.0f / 512.0f) + RMS_EPS);
        }
        __syncthreads();
        {
            PHASE_IDS();
            const int cp = tid & 255, th = tid >> 8, c0 = 2 * cp;
            LAS float* tile = (LAS float*)lds;
            f32x2 wk[31];
#pragma unroll
            for (int j = 0; j < 31; ++j) wk[j] = *(const f32x2*)(w_dw + j * 512 + c0);
            const f32x2 bdw = *(const f32x2*)(b_dw + c0);
            const int s0 = n * 128 + 64 * th;
            const bf16* pbase = PROJ + (size_t)(b * SEQ) * PJW + COL_U + c0;
            f32x2 uu[38];
            unsigned ra_[8];
#define GLU_CVT(aw, dst) do { dst.x = bf_lo(aw); dst.y = bf_hi(aw); } while (0)
#pragma unroll
            for (int i = 0; i < 30; ++i) { const int pos = s0 - 30 + i; unsigned aw = 0u;
                if (pos >= 0) aw = *(const unsigned*)(pbase + (size_t)pos * PJW);
                GLU_CVT(aw, uu[i]); }
#pragma unroll
            for (int tt = 0; tt < 8; ++tt) { const int pos = s0 + tt; ra_[tt] = *(const unsigned*)(pbase + (size_t)pos * PJW); }
            LAS float* prm = tile + 16 * 512;
            prm[tid] = ln_g[tid]; prm[512 + tid] = ln_b[tid];
            for (int chunk = 0; chunk < 8; ++chunk) {
#pragma unroll
                for (int tt = 0; tt < 8; ++tt) GLU_CVT(ra_[tt], uu[30 + tt]);
                if (chunk < 7) {
#pragma unroll
                    for (int tt = 0; tt < 8; ++tt) { const int pos = s0 + 8 * (chunk + 1) + tt; ra_[tt] = *(const unsigned*)(pbase + (size_t)pos * PJW); }
                }
#pragma unroll
                for (int tt = 0; tt < 8; ++tt) { f32x2 a = bdw;
#pragma unroll
                    for (int j = 0; j < 31; ++j) a = a + wk[j] * uu[tt + j];
                    *(LAS f32x2*)(tile + (th * 8 + tt) * 512 + c0) = a; }
#pragma unroll
                for (int i = 0; i < 30; ++i) uu[i] = uu[i + 8];
                LDS_WAIT(); __builtin_amdgcn_s_barrier(); asm volatile("" ::: "memory");
#pragma unroll
                for (int q = 0; q < 2; ++q) { const int row = 2 * wave + q, rth = row >> 3, rtt = row & 7; const int tok = t0 + 64 * rth + 8 * chunk + rtt;
                    const f32x4 a0 = *(const LAS f32x4*)(tile + row * 512 + 8 * lane), a1 = *(const LAS f32x4*)(tile + row * 512 + 8 * lane + 4);
                    float v[8] = {a0[0], a0[1], a0[2], a0[3], a1[0], a1[1], a1[2], a1[3]};
                    float s = 0.f;
#pragma unroll
                    for (int j = 0; j < 8; ++j) s += v[j];
                    const float mean = wave_sum_dpp(s) * (1.0f / 512.0f);
                    float s2 = 0.f;
#pragma unroll
                    for (int j = 0; j < 8; ++j) { v[j] -= mean; s2 += v[j] * v[j]; }
                    const float rstd = 1.0f / sqrtf(wave_sum_dpp(s2) * (1.0f / 512.0f) + LN_EPS);
                    const f32x4 lg0 = *(const LAS f32x4*)(prm + 8 * lane), lg1 = *(const LAS f32x4*)(prm + 8 * lane + 4), lb0 = *(const LAS f32x4*)(prm + 512 + 8 * lane), lb1 = *(const LAS f32x4*)(prm + 512 + 8 * lane + 4);
                    const float lgv[8] = {lg0[0], lg0[1], lg0[2], lg0[3], lg1[0], lg1[1], lg1[2], lg1[3]}, lbv[8] = {lb0[0], lb0[1], lb0[2], lb0[3], lb1[0], lb1[1], lb1[2], lb1[3]};
                    float s3 = 0.f;
#pragma unroll
                    for (int j = 0; j < 8; ++j) { const float y = v[j] * rstd * lgv[j] + lbv[j]; const float z = y * __builtin_amdgcn_rcpf(1.0f + __builtin_amdgcn_exp2f(-y * LOG2E)); v[j] = z; s3 += z * z; }
                    const float rc = 1.0f / sqrtf(wave_sum_dpp(s3) * (1.0f / 512.0f) + RMS_EPS);
                    v4u w; w.x = pk2(v[0] * rc, v[1] * rc); w.y = pk2(v[2] * rc, v[3] * rc); w.z = pk2(v[4] * rc, v[5] * rc); w.w = pk2(v[6] * rc, v[7] * rc);
                    *(v4u*)(MIX + (size_t)tok * D + 512 + 8 * lane) = w; }
                LDS_WAIT(); __builtin_amdgcn_s_barrier(); asm volatile("" ::: "memory");
            }
#undef GLU_CVT
        }
    }
    xcd_barrier(bar);

    {
        const int grp = ((int)blockIdx.x >> 3) % 3;
        EpiRes E{XN, X1B, b_out, RA};
        {
            DenseSched S{(const char*)Wout_t, T / 256, D / 256, G, (int)blockIdx.x, 2048, 0, grp};
            pg8::gemm_phase<EpiRes, DenseSched, false>(lds, lds + EPI_OFF, (const char*)MIX, 2048, S, E);
        }
        {
            PHASE_IDS();
            __syncthreads();
            LAS unsigned* scr = (LAS unsigned*)(lds + wave * 16384);
            const int gw = vcu * NWAVES + wave, NGW = G * NWAVES;
            constexpr int NIT = 8192;
            f32x4 va[16], vb[16];
            int it = gw;
            W8Item ia = w8_item(8191 - (it < NIT ? it : 0), w1, w2, W1_t, W2_t), ib = ia;
            if (it < NIT) w8_load(ia, va, lane);
            while (it < NIT) {
                const int itb = it + NGW;
                if (itb < NIT) { ib = w8_item(8191 - itb, w1, w2, W1_t, W2_t); w8_load(ib, vb, lane); }
                w8_store(ia, va, scr, lane);
                if (itb >= NIT) break;
                const int ita = itb + NGW;
                if (ita < NIT) { ia = w8_item(8191 - ita, w1, w2, W1_t, W2_t); w8_load(ia, va, lane); }
                w8_store(ib, vb, scr, lane);
                it = ita;
            }
            __syncthreads();
        }
        {
            DenseSched S{(const char*)Wout_t, T / 256, D / 256, G, (int)blockIdx.x, 2048, grp, 1 << 30};
            pg8::gemm_phase<EpiRes, DenseSched, false>(lds, lds + EPI_OFF, (const char*)MIX, 2048, S, E);
        }
    }
    xcd_barrier(bar);

    {
        PHASE_IDS();
        if (wave < 4) __builtin_amdgcn_global_load_lds((const unsigned*)((const char*)g_ffn + wave * 1024 + lane * 16), (LAS unsigned*)(lds + P4_G_OFF + wave * 1024), 16, 0, 0);
#pragma unroll
        for (int i = 0; i < 16; ++i) __builtin_amdgcn_global_load_lds((const unsigned*)((const char*)WrHi + (size_t)(wave * 16 + i) * 1024 + lane * 16), (LAS unsigned*)(lds + (wave * 16 + i) * 1024), 16, 0, 0);
        VM_WAIT(); __syncthreads();
    }
    for (int unit = blockIdx.x; unit < T / 128; unit += G) {
        PHASE_IDS();
        const int i16 = lane & 15, g = lane >> 4;
        if (tid < 32) t_lcnt[tid] = 0;
        __syncthreads();
        const int tok = unit * 128 + wave * 16 + i16;
        const bf16* xr = X1B + (size_t)tok * D + 8 * g;
        float ss = 0.f;
#pragma unroll 8
        for (int s = 0; s < 32; ++s) { const v4u a = *(const v4u*)(xr + 32 * s);
            const float a0 = bf_lo(a.x), a1 = bf_hi(a.x), a2 = bf_lo(a.y), a3 = bf_hi(a.y), a4 = bf_lo(a.z), a5 = bf_hi(a.z), a6 = bf_lo(a.w), a7 = bf_hi(a.w);
            ss += (a0 * a0 + a1 * a1) + (a2 * a2 + a3 * a3) + (a4 * a4 + a5 * a5) + (a6 * a6 + a7 * a7); }
        ss += __shfl_xor(ss, 16); ss += __shfl_xor(ss, 32);
        const float rstd = 1.0f / sqrtf(ss * (1.0f / D) + RMS_EPS);
        f32x4 acc0 = (f32x4){0.f, 0.f, 0.f, 0.f}, acc1 = acc0;
        {
        unsigned char* hrow = XN8 + (size_t)tok * D + 8 * g;
        const bf16* wh0 = WrHi + lane * 8; const bf16* wl0 = WrLo + lane * 8;
        for (int s8 = 0; s8 < 4; ++s8) {
            v4u xc[8];
#pragma unroll
            for (int q = 0; q < 8; ++q) xc[q] = *(const v4u*)(xr + 32 * (8 * s8 + q));
            __builtin_amdgcn_sched_barrier(0);
#pragma unroll
            for (int q = 0; q < 8; ++q) { const int s = 8 * s8 + q; const v4u xa = xc[q];
            const f32x4 a = (f32x4){bf_lo(xa.x), bf_hi(xa.x), bf_lo(xa.y), bf_hi(xa.y)} * rstd * *(const LAS f32x4*)((const LAS float*)(lds + P4_G_OFF) + 8 * g + 32 * s), b = (f32x4){bf_lo(xa.z), bf_hi(xa.z), bf_lo(xa.w), bf_hi(xa.w)} * rstd * *(const LAS f32x4*)((const LAS float*)(lds + P4_G_OFF) + 8 * g + 32 * s + 4);
            v4u hp; hp.x = pk2(a[0], a[1]); hp.y = pk2(a[2], a[3]); hp.z = pk2(b[0], b[1]); hp.w = pk2(b[2], b[3]);
            v4u lp; lp.x = pk2(a[0] - bf_lo(hp.x), a[1] - bf_hi(hp.x)); lp.y = pk2(a[2] - bf_lo(hp.y), a[3] - bf_hi(hp.y)); lp.z = pk2(b[0] - bf_lo(hp.z), b[1] - bf_hi(hp.z)); lp.w = pk2(b[2] - bf_lo(hp.w), b[3] - bf_hi(hp.w));
            const bf16x8 hh = __builtin_bit_cast(bf16x8, hp), hl = __builtin_bit_cast(bf16x8, lp);
            const LAS unsigned char* wf = lds + lane * 16; const bf16x8 whA = *(const LAS bf16x8*)(wf + (0 * 32 + s) * 1024), whB = *(const LAS bf16x8*)(wf + (1 * 32 + s) * 1024), wlA = *(const LAS bf16x8*)(wf + (2 * 32 + s) * 1024), wlB = *(const LAS bf16x8*)(wf + (3 * 32 + s) * 1024);
            acc0 = __builtin_amdgcn_mfma_f32_16x16x32_bf16(whA, hh, acc0, 0, 0, 0); acc0 = __builtin_amdgcn_mfma_f32_16x16x32_bf16(whA, hl, acc0, 0, 0, 0); acc0 = __builtin_amdgcn_mfma_f32_16x16x32_bf16(wlA, hh, acc0, 0, 0, 0);
            acc1 = __builtin_amdgcn_mfma_f32_16x16x32_bf16(whB, hh, acc1, 0, 0, 0); acc1 = __builtin_amdgcn_mfma_f32_16x16x32_bf16(whB, hl, acc1, 0, 0, 0); acc1 = __builtin_amdgcn_mfma_f32_16x16x32_bf16(wlB, hh, acc1, 0, 0, 0); }
        }
        }
        {
            unsigned char* hrow = XN8 + (size_t)tok * D + 8 * g;
            const float rs8 = rstd * H_SCALE;
            for (int s8 = 0; s8 < 4; ++s8) {
                v4u xc[8];
#pragma unroll
                for (int q = 0; q < 8; ++q) xc[q] = *(const v4u*)(xr + 32 * (8 * s8 + q));
                __builtin_amdgcn_sched_barrier(0);
#pragma unroll
                for (int q2 = 0; q2 < 4; ++q2) { v2u h8[2];
#pragma unroll
                    for (int qq = 0; qq < 2; ++qq) { const int q = 2 * q2 + qq, s = 8 * s8 + q; const v4u xa = xc[q];
                    const f32x4 a = (f32x4){bf_lo(xa.x), bf_hi(xa.x), bf_lo(xa.y), bf_hi(xa.y)} * rs8 * *(const LAS f32x4*)((const LAS float*)(lds + P4_G_OFF) + 8 * g + 32 * s), b = (f32x4){bf_lo(xa.z), bf_hi(xa.z), bf_lo(xa.w), bf_hi(xa.w)} * rs8 * *(const LAS f32x4*)((const LAS float*)(lds + P4_G_OFF) + 8 * g + 32 * s + 4);
                    h8[qq].x = pk4_fp8(a[0], a[1], a[2], a[3]); h8[qq].y = pk4_fp8(b[0], b[1], b[2], b[3]); }
                    const auto rx = __builtin_amdgcn_permlane16_swap(h8[0].x, h8[1].x, false, false), ry = __builtin_amdgcn_permlane16_swap(h8[0].y, h8[1].y, false, false);
                    v4u o4; o4.x = rx[0]; o4.y = ry[0]; o4.z = rx[1]; o4.w = ry[1];
                    *(v4u*)(hrow - 8 * g + 32 * (8 * s8 + 2 * q2 + (g & 1)) + 8 * (g & ~1)) = o4; }
            }
        }
        LAS float* sc = (LAS float*)(lds + EPI_OFF + wave * 2112);
#pragma unroll
        for (int r = 0; r < 4; ++r) { sc[i16 * 33 + 4 * g + r] = acc0[r] + b_router[4 * g + r]; sc[i16 * 33 + 16 + 4 * g + r] = acc1[r] + b_router[16 + 4 * g + r]; }
        LDS_WAIT(); asm volatile("" ::: "memory");
        int idx[4], rank[4]; float gate[4];
        if (lane < 16) {
            float v[32];
#pragma unroll
            for (int e = 0; e < 32; ++e) v[e] = sc[lane * 33 + e];
            float val[4];
#pragma unroll
            for (int k = 0; k < 4; ++k) { float best = -INFINITY; int bi = 0;
#pragma unroll
                for (int e = 0; e < 32; ++e) if (v[e] > best) { best = v[e]; bi = e; }
                val[k] = best; idx[k] = bi;
#pragma unroll
                for (int e = 0; e < 32; ++e) v[e] = (e == bi) ? -INFINITY : v[e]; }
            float den = 0.f;
#pragma unroll
            for (int k = 0; k < 4; ++k) { gate[k] = __expf(val[k] - val[0]); den += gate[k]; }
            const float rden = 1.0f / den;
#pragma unroll
            for (int k = 0; k < 4; ++k) { gate[k] *= rden; rank[k] = atomicAdd((int*)(t_lcnt + idx[k]), 1); }
        }
        __syncthreads();
        if (tid < 32) { const int c = t_lcnt[tid]; t_gbase[tid] = c ? (int)__hip_atomic_fetch_add(gcnt + 16 * tid, (unsigned)c, __ATOMIC_RELAXED, __HIP_MEMORY_SCOPE_AGENT) : 0; }
        __syncthreads();
        if (lane < 16) {
            const int tk = unit * 128 + wave * 16 + lane;
#pragma unroll
            for (int k = 0; k < 4; ++k) { const int pos = t_gbase[idx[k]] + rank[k]; ltok[idx[k] * LIST_CAP + pos] = tk * 4 + k; lgate[idx[k] * LIST_CAP + pos] = gate[k]; }
        }
        __syncthreads();
    }
    xcd_barrier(bar);

    if (threadIdx.x < 32) t_cnt[threadIdx.x] = (int)__hip_atomic_load(gcnt + 16 * threadIdx.x, __ATOMIC_RELAXED, __HIP_MEMORY_SCOPE_AGENT);
    __syncthreads();
    if (threadIdx.x == 0) { int s = 0; for (int e = 0; e < 32; ++e) { t_rbs[e] = s; s += (t_cnt[e] + 255) >> 8; } t_rbs[32] = s; }
    __syncthreads();
    const int NB = __builtin_amdgcn_readfirstlane(t_rbs[32]);

    {
        MoeSched<true> S{(const char*)W1_t, (size_t)2048 * 1024, ltok, t_rbs, t_cnt, NB, 8, G, (int)blockIdx.x, 1024, -1};
        EpiSwiglu E{ACT, b1p};
        pg8::gemm_phase<EpiSwiglu, MoeSched<true>, true>(lds, lds + EPI_OFF, (const char*)XN8, 1024, S, E);
    }
    xcd_barrier(bar);

    {
        MoeSched<false> S{(const char*)W2_t, (size_t)1024 * 1024, ltok, t_rbs, t_cnt, NB, 4, G, (int)blockIdx.x, 1024, (NB * 4 > (int)blockIdx.x) ? (NB * 4 - (int)blockIdx.x + G - 1) / G : 0};
        EpiMoeOut E{YB, b2, ltok, lgate};
        pg8::gemm_phase<EpiMoeOut, MoeSched<false>, true, false>(lds, lds + EPI_OFF, (const char*)ACT, 1024, S, E);
    }
    xcd_barrier(bar);

    {
        PHASE_IDS();
        const int gw = vcu * NWAVES + wave, NGW = G * NWAVES;
        f32x4 gfin[4];
#pragma unroll
        for (int j = 0; j < 4; ++j) gfin[j] = *((const f32x4*)g_final + lane + 64 * j);
        for (int m0 = 2 * gw; m0 < T; m0 += 2 * NGW) {
            v2u xw_[2][4]; unsigned yw[2][4][4];
#pragma unroll
            for (int q = 0; q < 2; ++q) { const GAS v2u* xr = (const GAS v2u*)(X1B + (size_t)(m0 + q) * D) + lane;
#pragma unroll
                for (int j = 0; j < 4; ++j) xw_[q][j] = __builtin_nontemporal_load(xr + 64 * j);
#pragma unroll
                for (int k = 0; k < 4; ++k) { const GAS unsigned* yr = (const GAS unsigned*)(YB + ((size_t)(m0 + q) * 4 + k) * D) + lane;
#pragma unroll
                    for (int j = 0; j < 4; ++j) yw[q][k][j] = __builtin_nontemporal_load(yr + 64 * j); } }
#pragma unroll
            for (int q = 0; q < 2; ++q) {
                f32x4 v[4];
#pragma unroll
                for (int j = 0; j < 4; ++j) v[j] = (f32x4){bf_lo(xw_[q][j].x), bf_hi(xw_[q][j].x), bf_lo(xw_[q][j].y), bf_hi(xw_[q][j].y)};
#pragma unroll
                for (int k = 0; k < 4; ++k)
#pragma unroll
                    for (int j = 0; j < 4; ++j) { const f32x2 lo = __builtin_amdgcn_cvt_pk_f32_fp8((int)yw[q][k][j], false), hi = __builtin_amdgcn_cvt_pk_f32_fp8((int)yw[q][k][j], true);
                        v[j].x += lo.x * (1.0f / Y_SCALE); v[j].y += lo.y * (1.0f / Y_SCALE); v[j].z += hi.x * (1.0f / Y_SCALE); v[j].w += hi.y * (1.0f / Y_SCALE); }
                float s = 0.f;
#pragma unroll
                for (int j = 0; j < 4; ++j) s += (v[j].x * v[j].x + v[j].y * v[j].y) + (v[j].z * v[j].z + v[j].w * v[j].w);
                const float rstd = 1.0f / sqrtf(wave_sum_dpp(s) * (1.0f / D) + RMS_EPS);
                GAS f32x4* xw = (GAS f32x4*)(out + (size_t)(m0 + q) * D) + lane;
#pragma unroll
                for (int j = 0; j < 4; ++j) __builtin_nontemporal_store(v[j] * rstd * gfin[j], xw + 64 * j);
            }
        }
    }
}

extern "C" void kernel_launch(void* const* d_in, const int* in_sizes, int n_in, void* d_out, int out_size, void* d_ws, size_t ws_size, hipStream_t stream) {
    static int grid = 0;
    if (grid == 0) {
        if (n_in != 21 || in_sizes[0] != T * D || out_size != T * D || ws_size < WS_END) { fprintf(stderr, "kernel_launch: unexpected shapes (n_in %d, in0 %d, out %d, ws %zu)\n", n_in, n_in > 0 ? in_sizes[0] : -1, out_size, ws_size); grid = -1; return; }
        int dev = 0, cus = 0, per_cu = 0;
        if (hipGetDevice(&dev) != hipSuccess || hipDeviceGetAttribute(&cus, hipDeviceAttributeMultiprocessorCount, dev) != hipSuccess) { grid = -1; return; }
        if (hipFuncSetAttribute((const void*)hymba_fwd, hipFuncAttributeMaxDynamicSharedMemorySize, LDS_BYTES) != hipSuccess) { fprintf(stderr, "kernel_launch: hipFuncSetAttribute failed\n"); grid = -1; return; }
        if (hipOccupancyMaxActiveBlocksPerMultiprocessor(&per_cu, (const void*)hymba_fwd, NWAVES * 64, LDS_BYTES) != hipSuccess || per_cu < 1)
            fprintf(stderr, "kernel_launch: occupancy query reports %d workgroups per CU\n", per_cu);
        (void)hipGetLastError();
        grid = cus;
    }
    if (grid < 0) return;
    if (hipMemsetAsync((char*)d_ws + WS_CTL, 0, CTL_ZERO_BYTES, stream) != hipSuccess) return;
    Args a{};
    for (int i = 0; i < 21; ++i) a.in[i] = (const float*)d_in[i];
    a.out = (float*)d_out; a.ws = (unsigned char*)d_ws;
    hipLaunchKernelGGL(hymba_fwd, dim3(grid), dim3(NWAVES * 64), LDS_BYTES, stream, a);
}
```
